# Optimizing an MI355X kernel written in HIP

```python
import math
import jax, jax.numpy as jnp
from jax import lax
import numpy as np

D_MODEL = 1024
BATCH = 4
SEQ = 8192
DEPTH = 4

CHUNK = 64
Q_BLOCK = 128
D_MIX = D_MODEL
CONV_CH = D_MIX // 4
CONV_WIDTH = 31
DIFF_HEADS = 4
DIFF_DV = D_MIX // 8
DIFF_DH = DIFF_DV // 2
GLA_HEADS = 4
GLA_DV = D_MIX // 16
GLA_DK = GLA_DV // 2
GLA_GATE_RANK = 16
GLA_TAU = 16.0
ROPE_THETA = 500000.0
ROT_DIMS = DIFF_DH // 4
D_FF = 2816
N_EXPERTS = 8
TOP_K = 2
D_FF_EXPERT = 3584
EXPERT_BLOCK = 256
PLE_DIM = 256
EPS = 1e-6

DIFF_QK = DIFF_HEADS * 2 * DIFF_DH
DIFF_V = DIFF_HEADS * DIFF_DV
GLA_QK = GLA_HEADS * GLA_DK
GLA_V = GLA_HEADS * GLA_DV
IN_SPLITS = (CONV_CH, CONV_CH, DIFF_QK, DIFF_QK, DIFF_V, GLA_QK, GLA_QK, GLA_V, GLA_V, GLA_GATE_RANK)
D_IN = CONV_CH * 2 + DIFF_QK * 2 + DIFF_V + GLA_QK * 2 + GLA_V * 2 + GLA_GATE_RANK

kernel_name = "hybrid_conv_diffattn_gla_moe_trunk"


def rmsnorm(x, g):
    xf = x.astype(jnp.float32)
    y = xf * lax.rsqrt(jnp.mean(xf * xf, axis=-1, keepdims=True) + EPS)
    return (y * g.astype(jnp.float32)).astype(x.dtype)


def layernorm(x, g, b):
    xf = x.astype(jnp.float32)
    mu = jnp.mean(xf, axis=-1, keepdims=True)
    var = jnp.mean(jnp.square(xf - mu), axis=-1, keepdims=True)
    y = (xf - mu) * lax.rsqrt(var + EPS)
    return (y * g.astype(jnp.float32) + b.astype(jnp.float32)).astype(x.dtype)


def rope_partial(x, cos, sin):
    half = ROT_DIMS // 2
    bshape = (x.shape[1],) + (1,) * (x.ndim - 3) + (half,)
    c = cos.reshape(bshape)
    s = sin.reshape(bshape)
    xf = x.astype(jnp.float32)
    x1 = xf[..., :half]
    x2 = xf[..., half:ROT_DIMS]
    out = jnp.concatenate([x1 * c - x2 * s, x2 * c + x1 * s, xf[..., ROT_DIMS:]], axis=-1)
    return out.astype(x.dtype)


def conformer_conv(a, g, w, b, ln_g, ln_b):
    u = a * jax.nn.sigmoid(g)
    y = lax.conv_general_dilated(u, w[:, None, :].astype(u.dtype), window_strides=(1,),
                                 padding=[(CONV_WIDTH - 1, 0)],
                                 dimension_numbers=('NWC', 'WIO', 'NWC'),
                                 feature_group_count=CONV_CH) + b
    return jax.nn.silu(layernorm(y, ln_g, ln_b))


def diff_attention(q, k, v, lam, subln_g, lam_init):
    bsz, seq = q.shape[0], q.shape[1]
    nqb = seq // Q_BLOCK
    qb = jnp.moveaxis(q.reshape(bsz, nqb, Q_BLOCK, DIFF_HEADS, 2, DIFF_DH), 1, 0)
    k_chunk = jnp.arange(seq) // CHUNK
    scale = DIFF_DH ** -0.5

    def one_block(args):
        q_blk, bi = args
        s = jnp.einsum('bqhcd,bkhcd->bhcqk', q_blk, k).astype(jnp.float32) * scale
        q_chunk = (bi * Q_BLOCK + jnp.arange(Q_BLOCK)) // CHUNK
        allowed = k_chunk[None, :] <= q_chunk[:, None]
        s = jnp.where(allowed, s, -jnp.inf)
        pr = jax.nn.softmax(s, axis=-1)
        a = pr[:, :, 0] - lam * pr[:, :, 1]
        return jnp.einsum('bhqk,bkhv->bqhv', a.astype(v.dtype), v)

    o = lax.map(one_block, (qb, jnp.arange(nqb)))
    o = jnp.moveaxis(o, 0, 1).reshape(bsz, seq, DIFF_HEADS, DIFF_DV)
    o = rmsnorm(o, subln_g) * (1.0 - lam_init)
    return o.reshape(bsz, seq, DIFF_V)


def gla_mixer(q, k, v, r, gz, w_g2, b_g, norm_g):
    bsz, seq = q.shape[0], q.shape[1]
    nc = seq // CHUNK
    dt = v.dtype
    shp = (bsz, nc, CHUNK, GLA_HEADS)
    log_a = jax.nn.log_sigmoid((gz @ w_g2 + b_g).astype(jnp.float32)) / GLA_TAU
    log_a = log_a.reshape(shp + (GLA_DK,))
    qc = q.astype(jnp.float32).reshape(shp + (GLA_DK,)) * (GLA_DK ** -0.5)
    kc = k.astype(jnp.float32).reshape(shp + (GLA_DK,))
    vc = v.astype(jnp.float32).reshape(shp + (GLA_DV,))
    cum = jnp.cumsum(log_a, axis=2)
    tot = cum[:, :, -1]
    kv = jnp.einsum('bnchk,bnchv->nbhkv', kc * jnp.exp(tot[:, :, None] - cum), vc)
    decay = jnp.moveaxis(jnp.exp(tot), 1, 0)

    def step(state, inp):
        d, kv_c = inp
        state = d[..., None] * state + kv_c
        return state, state

    init = jnp.zeros((bsz, GLA_HEADS, GLA_DK, GLA_DV), jnp.float32)
    _, states = lax.scan(step, init, (decay, kv))
    o = jnp.einsum('bnchk,nbhkv->bnchv', qc, states).reshape(bsz, seq, GLA_HEADS, GLA_DV)
    gate = jax.nn.silu(r.astype(jnp.float32)).reshape(bsz, seq, GLA_HEADS, GLA_DV)
    o = rmsnorm(o, norm_g) * gate
    return o.reshape(bsz, seq, GLA_V).astype(dt)


def swiglu(h, w_gu, w_down):
    g, u = jnp.split(h @ w_gu, 2, axis=-1)
    return (jax.nn.silu(g) * u) @ w_down


def moe_swiglu(h, router_w, w_gu, w_down):
    bsz, seq, d = h.shape
    t = bsz * seq
    xf = h.reshape(t, d)
    logits = (xf @ router_w).astype(jnp.float32)
    top_val, top_idx = lax.top_k(logits, TOP_K)
    gates = jax.nn.softmax(top_val, axis=-1)
    flat_e = top_idx.reshape(-1)
    flat_tok = jnp.repeat(jnp.arange(t, dtype=jnp.int32), TOP_K)
    flat_w = gates.reshape(-1)
    order = jnp.argsort(flat_e, stable=True)
    sorted_e = flat_e[order]
    counts = jnp.bincount(flat_e, length=N_EXPERTS)
    padded = ((counts + EXPERT_BLOCK - 1) // EXPERT_BLOCK) * EXPERT_BLOCK
    pend = jnp.cumsum(padded)
    pstart = pend - padded
    ustart = jnp.cumsum(counts) - counts
    n_assign = t * TOP_K
    dest = pstart[sorted_e] + jnp.arange(n_assign) - ustart[sorted_e]
    m_rows = n_assign + N_EXPERTS * EXPERT_BLOCK
    row_tok = jnp.zeros((m_rows,), jnp.int32).at[dest].set(flat_tok[order])
    row_w = jnp.zeros((m_rows,), jnp.float32).at[dest].set(flat_w[order])
    nb = m_rows // EXPERT_BLOCK
    block_e = jnp.minimum(jnp.searchsorted(pend, jnp.arange(nb) * EXPERT_BLOCK, side='right'),
                          N_EXPERTS - 1)
    xs = xf[row_tok].reshape(nb, EXPERT_BLOCK, d)

    def expert_block(args):
        xb, e = args
        return swiglu(xb, w_gu[e], w_down[e])

    ys = lax.map(expert_block, (xs, block_e)).reshape(m_rows, d)
    out = jnp.zeros((t, d), jnp.float32).at[row_tok].add(ys.astype(jnp.float32) * row_w[:, None])
    return out.astype(h.dtype).reshape(bsz, seq, d)


def setup_inputs(seed: int = 0) -> dict:
    key = jax.random.key(seed)
    ks = jax.random.split(key, 24)
    n_dense = (DEPTH + 1) // 2
    n_moe = DEPTH // 2

    def nrm(k, shape, s):
        return jax.random.normal(k, shape, jnp.float32) * s

    return {
        "x": nrm(ks[0], (BATCH, SEQ, D_MODEL), 1.0),
        "p": nrm(ks[1], (DEPTH, BATCH, SEQ, PLE_DIM), 1.0),
        "norm_mix_g": 1.0 + nrm(ks[2], (DEPTH, D_MODEL), 0.02),
        "w_in": nrm(ks[3], (DEPTH, D_MODEL, D_IN), D_MODEL ** -0.5),
        "conv_w": nrm(ks[4], (DEPTH, CONV_WIDTH, CONV_CH), CONV_WIDTH ** -0.5),
        "conv_b": nrm(ks[5], (DEPTH, CONV_CH), 0.02),
        "conv_ln_g": 1.0 + nrm(ks[6], (DEPTH, CONV_CH), 0.02),
        "conv_ln_b": nrm(ks[7], (DEPTH, CONV_CH), 0.02),
        "diff_lambda": nrm(ks[8], (DEPTH, 4, DIFF_DH), 0.1),
        "diff_subln_g": 1.0 + nrm(ks[9], (DEPTH, DIFF_DV), 0.02),
        "gla_w_gate2": nrm(ks[10], (DEPTH, GLA_GATE_RANK, GLA_QK), GLA_GATE_RANK ** -0.5),
        "gla_b_gate": nrm(ks[11], (DEPTH, GLA_QK), 0.1),
        "gla_norm_g": 1.0 + nrm(ks[12], (DEPTH, GLA_DV), 0.02),
        "w_out": nrm(ks[13], (DEPTH, D_MIX, D_MODEL), D_MIX ** -0.5),
        "norm_ffn_g": 1.0 + nrm(ks[14], (DEPTH, D_MODEL), 0.02),
        "ffn_w_gu": nrm(ks[15], (n_dense, D_MODEL, 2 * D_FF), D_MODEL ** -0.5),
        "ffn_w_down": nrm(ks[16], (n_dense, D_FF, D_MODEL), D_FF ** -0.5),
        "router_w": nrm(ks[17], (n_moe, D_MODEL, N_EXPERTS), D_MODEL ** -0.5),
        "moe_w_gu": nrm(ks[18], (n_moe, N_EXPERTS, D_MODEL, 2 * D_FF_EXPERT), D_MODEL ** -0.5),
        "moe_w_down": nrm(ks[19], (n_moe, N_EXPERTS, D_FF_EXPERT, D_MODEL), D_FF_EXPERT ** -0.5),
        "ple_w_up": nrm(ks[20], (DEPTH, PLE_DIM, D_MODEL), PLE_DIM ** -0.5),
        "ple_w_gate": nrm(ks[21], (DEPTH, D_MODEL, D_MODEL), D_MODEL ** -0.5),
        "ple_norm_g": 1.0 + nrm(ks[22], (DEPTH, D_MODEL), 0.02),
        "final_norm_g": 1.0 + nrm(ks[23], (D_MODEL,), 0.02),
    }


def reference(x, p, norm_mix_g, w_in, conv_w, conv_b, conv_ln_g, conv_ln_b, diff_lambda,
              diff_subln_g, gla_w_gate2, gla_b_gate, gla_norm_g, w_out, norm_ffn_g,
              ffn_w_gu, ffn_w_down, router_w, moe_w_gu, moe_w_down, ple_w_up, ple_w_gate,
              ple_norm_g, final_norm_g):
    bsz, seq, _ = x.shape
    pos = jnp.arange(seq, dtype=jnp.float32)
    inv_freq = ROPE_THETA ** (-jnp.arange(0, ROT_DIMS, 2, dtype=jnp.float32) / ROT_DIMS)
    ang = pos[:, None] * inv_freq[None, :]
    cos, sin = jnp.cos(ang), jnp.sin(ang)
    split_at = [int(v) for v in np.cumsum(IN_SPLITS)[:-1]]

    h = x
    for i in range(DEPTH):
        hn = rmsnorm(h, norm_mix_g[i])
        z = hn @ w_in[i]
        (c_a, c_g, d_q, d_k, d_v, g_q, g_k, g_v, g_r, g_z) = jnp.split(z, split_at, axis=-1)

        y_conv = conformer_conv(c_a, c_g, conv_w[i], conv_b[i], conv_ln_g[i], conv_ln_b[i])

        lam_init = 0.8 - 0.6 * math.exp(-0.3 * i)
        lp = diff_lambda[i].astype(jnp.float32)
        lam = jnp.exp(jnp.sum(lp[0] * lp[1])) - jnp.exp(jnp.sum(lp[2] * lp[3])) + lam_init
        dq = rope_partial(d_q.reshape(bsz, seq, DIFF_HEADS, 2, DIFF_DH), cos, sin)
        dk = rope_partial(d_k.reshape(bsz, seq, DIFF_HEADS, 2, DIFF_DH), cos, sin)
        dv = d_v.reshape(bsz, seq, DIFF_HEADS, DIFF_DV)
        y_diff = diff_attention(dq, dk, dv, lam, diff_subln_g[i], lam_init)

        y_gla = gla_mixer(g_q, g_k, g_v, g_r, g_z, gla_w_gate2[i], gla_b_gate[i], gla_norm_g[i])

        h = h + jnp.concatenate([y_conv, y_diff, y_gla], axis=-1) @ w_out[i]

        hn = rmsnorm(h, norm_ffn_g[i])
        if i % 2 == 0:
            h = h + swiglu(hn, ffn_w_gu[i // 2], ffn_w_down[i // 2])
        else:
            h = h + moe_swiglu(hn, router_w[i // 2], moe_w_gu[i // 2], moe_w_down[i // 2])

        gate = jax.nn.sigmoid(rmsnorm(h, ple_norm_g[i]) @ ple_w_gate[i])
        h = h + gate * (p[i] @ ple_w_up[i])

    return rmsnorm(h, final_norm_g)
```

```cpp
#define MK_CHECK 0
#include <hip/hip_runtime.h>
#include <hip/hip_bf16.h>
#include <cstdio>
#include <cstdint>
#include <cmath>

constexpr int T_TOK = 32768, SEQ = 8192, DMOD = 1024, DEPTH = 4;
constexpr int D_IN = 2832, NZ = 3072;
constexpr int D_FF = 2816, D_FFE = 3584, NEXP = 8;
constexpr int PLE_DIM = 256;
constexpr float EPS = 1e-6f;
constexpr int MOE_ROWS = 2 * T_TOK + NEXP * 256;
__device__ __forceinline__ int lane_now() { int l; asm volatile("v_mbcnt_lo_u32_b32 %0, -1, 0\n\tv_mbcnt_hi_u32_b32 %0, -1, %0" : "=v"(l)); return l; }
namespace pg8 {
#define PG8_LAS __attribute__((address_space(3)))
typedef unsigned short bf16_t;
typedef short bf16x8 __attribute__((ext_vector_type(8)));
typedef float f32x4 __attribute__((ext_vector_type(4)));
typedef unsigned u32x4 __attribute__((ext_vector_type(4)));
constexpr int BM = 256, BK = 64, HALF = 128, HTB = HALF * BK * 2  , STAGE_BYTES = 8 * HTB, NXCD = 8, WGM = 8;

__host__ __device__ __forceinline__ int lds_byte(int r, int c) { const int st = (r >> 4) * 2 + (c >> 5), rr = r & 15, cc = c & 31, ob = rr * 64 + cc * 2; return st * 1024 + (ob ^ (((ob >> 9) & 1) << 5)); }
__host__ __device__ __forceinline__ void stage_rc(int b, int& R, int& C) { const int st = b / 1024, sb = b % 1024, swz = sb ^ (((sb >> 9) & 1) << 5); R = (st >> 1) * 16 + swz / 64; C = (st & 1) * 32 + (swz % 64) / 2; }
__host__ __device__ __forceinline__ int perm32(int rho) { const int n = rho >> 4, i = rho & 15; return 8 * (i >> 2) + 4 * n + (i & 3); }

struct Unit { int pm, pn, pe; };
struct Gemm { const bf16_t* A; const bf16_t* Bt; int K; size_t bstride; };

struct StaticOrder {
    int nM, nN, nwg, G, c;
    __host__ __device__ void init(int M, int N, int G_, int c_) { nM = M / BM; nN = N / BM; nwg = nM * nN; G = G_; c = c_; }
    __host__ __device__ bool next(int i, Unit& u) const {
        const long L = (long)i * G + c; if (L >= nwg) return false;
        int wgid = (int)L; { const int q = nwg / NXCD, r = nwg % NXCD, xcd = wgid % NXCD, off = wgid / NXCD; wgid = (xcd < r ? xcd * (q + 1) : r * (q + 1) + (xcd - r) * q) + off; }
        const int nig = WGM * nN, gid = wgid / nig, fm = gid * WGM, gsz = (nM - fm) < WGM ? (nM - fm) : WGM;
        u.pm = fm + ((wgid % nig) % gsz); u.pn = (wgid % nig) / gsz; u.pe = 0; return true;
    }
    __device__ __forceinline__ void a_ready(const Unit&) const {}
    __device__ __forceinline__ void done(const Unit&) const {}
};
constexpr int NEXPG = 8;
__device__ __forceinline__ unsigned cvt_pk_bf16(float lo, float hi) { unsigned r; asm volatile("v_cvt_pk_bf16_f32 %0, %1, %2" : "=v"(r) : "v"(lo), "v"(hi)); return r; }
typedef float f32x2 __attribute__((ext_vector_type(2)));
__device__ __forceinline__ float fsigmoid(float x) { return __builtin_amdgcn_rcpf(1.f + __builtin_amdgcn_exp2f(-1.4426950408889634f * x)); }
__device__ __forceinline__ float fsilu(float x) { return x * fsigmoid(x); }
__device__ __forceinline__ float bf2f(unsigned short b) { return __builtin_bit_cast(float, (unsigned)b << 16); }
typedef unsigned u32x2 __attribute__((ext_vector_type(2)));

struct EpiBf16P {
    static constexpr bool PERM = true, AFTER_DRAIN = false;
    bf16_t* O; int ldc;
    __device__ __forceinline__ void operator()(const f32x4 (&acc)[2][2][4][2], const Unit& u, int wr, int wc, int fr, int fq) const {
        const int row0 = u.pm * BM + wr * 64 + fr, col0 = u.pn * BM + wc * 32 + 8 * fq;
#pragma unroll
        for (int ai = 0; ai < 2; ++ai)
#pragma unroll
            for (int m = 0; m < 4; ++m) { bf16_t* rowp = O + (size_t)(row0 + ai * HALF + m * 16) * ldc + col0;
#pragma unroll
                for (int bj = 0; bj < 2; ++bj) { const f32x4 v0 = acc[ai][bj][m][0], v1 = acc[ai][bj][m][1];
                    u32x4 w; w.x = cvt_pk_bf16(v0[0], v0[1]); w.y = cvt_pk_bf16(v0[2], v0[3]); w.z = cvt_pk_bf16(v1[0], v1[1]); w.w = cvt_pk_bf16(v1[2], v1[3]);
                    *(u32x4*)(rowp + bj * HALF) = w; } }
    }
};
struct EpiSwiglu {
    static constexpr bool PERM = true, AFTER_DRAIN = false;
    bf16_t* O; int ldc;
    __device__ __forceinline__ void operator()(const f32x4 (&acc)[2][2][4][2], const Unit& u, int wr, int wc, int fr, int fq) const {
        const int row0 = u.pm * BM + wr * 64 + fr, col0 = u.pn * HALF + wc * 32 + 8 * fq;
#pragma unroll
        for (int ai = 0; ai < 2; ++ai)
#pragma unroll
            for (int m = 0; m < 4; ++m) { bf16_t* rowp = O + (size_t)(row0 + ai * HALF + m * 16) * ldc + col0;
                const f32x4 g0 = acc[ai][0][m][0], g1 = acc[ai][0][m][1], u0 = acc[ai][1][m][0], u1 = acc[ai][1][m][1];
                float r[8];
#pragma unroll
                for (int i = 0; i < 4; ++i) { r[i] = fsilu(g0[i]) * u0[i]; r[4 + i] = fsilu(g1[i]) * u1[i]; }
                u32x4 w; w.x = cvt_pk_bf16(r[0], r[1]); w.y = cvt_pk_bf16(r[2], r[3]); w.z = cvt_pk_bf16(r[4], r[5]); w.w = cvt_pk_bf16(r[6], r[7]);
                *(u32x4*)rowp = w; }
    }
};
struct EpiRes {
    static constexpr bool PERM = false, AFTER_DRAIN = false;
    const float* base; float* out; int ldc;
    __device__ __forceinline__ void operator()(const f32x4 (&acc)[2][2][4][2], const Unit& u, int wr, int wc, int fr, int fq) const {
        const int row0 = u.pm * BM + wr * 64 + fr, col0 = u.pn * BM + wc * 32 + 4 * fq;
#pragma unroll
        for (int ai = 0; ai < 2; ++ai)
#pragma unroll
            for (int m = 0; m < 4; ++m) { const size_t off = (size_t)(row0 + ai * HALF + m * 16) * ldc + col0;
#pragma unroll
                for (int bj = 0; bj < 2; ++bj)
#pragma unroll
                    for (int n = 0; n < 2; ++n) { const f32x4 b = *(const f32x4*)(base + off + bj * HALF + n * 16); *(f32x4*)(out + off + bj * HALF + n * 16) = b + acc[ai][bj][m][n]; } }
    }
};
struct EpiPle {
    static constexpr bool PERM = false, AFTER_DRAIN = false;
    float* h; const bf16_t* up; int ldc;
    __device__ __forceinline__ void operator()(const f32x4 (&acc)[2][2][4][2], const Unit& u, int wr, int wc, int fr, int fq) const {
        const int row0 = u.pm * BM + wr * 64 + fr, col0 = u.pn * BM + wc * 32 + 4 * fq;
#pragma unroll
        for (int ai = 0; ai < 2; ++ai)
#pragma unroll
            for (int m = 0; m < 4; ++m) { const size_t off = (size_t)(row0 + ai * HALF + m * 16) * ldc + col0;
#pragma unroll
                for (int bj = 0; bj < 2; ++bj)
#pragma unroll
                    for (int n = 0; n < 2; ++n) { const size_t o = off + bj * HALF + n * 16; const f32x4 a = acc[ai][bj][m][n]; const u32x2 uw = *(const u32x2*)(up + o); f32x4 hv = *(const f32x4*)(h + o);
                        hv[0] += fsigmoid(a[0]) * __builtin_bit_cast(float, uw.x << 16); hv[1] += fsigmoid(a[1]) * __builtin_bit_cast(float, uw.x & 0xffff0000u);
                        hv[2] += fsigmoid(a[2]) * __builtin_bit_cast(float, uw.y << 16); hv[3] += fsigmoid(a[3]) * __builtin_bit_cast(float, uw.y & 0xffff0000u);
                        *(f32x4*)(h + o) = hv; } }
    }
};
struct EpiWin {
    static constexpr bool PERM = true, AFTER_DRAIN = false;
    bf16_t *ZU, *ZQ, *ZK, *ZV, *ZG; float* LA; const float* rope; const float* bgate;
    __device__ __forceinline__ void st8(bf16_t* p, const f32x4 v0, const f32x4 v1) const { u32x4 w; w.x = cvt_pk_bf16(v0[0], v0[1]); w.y = cvt_pk_bf16(v0[2], v0[3]); w.z = cvt_pk_bf16(v1[0], v1[1]); w.w = cvt_pk_bf16(v1[2], v1[3]); *(u32x4*)p = w; }
    __device__ __forceinline__ void operator()(const f32x4 (&acc)[2][2][4][2], const Unit& u, int wr, int wc, int fr, int fq) const {
        const int pn = u.pn, row0 = u.pm * BM + wr * 64 + fr, cw = wc * 32 + 8 * fq;
        if (pn < 2) {
#pragma unroll
            for (int ai = 0; ai < 2; ++ai)
#pragma unroll
                for (int m = 0; m < 4; ++m) { const size_t row = (size_t)(row0 + ai * HALF + m * 16);
                    const f32x4 a0 = acc[ai][0][m][0], a1 = acc[ai][0][m][1], g0 = acc[ai][1][m][0], g1 = acc[ai][1][m][1]; f32x4 r0, r1;
#pragma unroll
                    for (int i = 0; i < 4; ++i) { r0[i] = a0[i] * fsigmoid(g0[i]); r1[i] = a1[i] * fsigmoid(g1[i]); }
                    st8(ZU + row * 256 + pn * HALF + cw, r0, r1); }
        } else if (pn < 6) {
            const bool isq = pn < 4; bf16_t* Z = isq ? ZQ : ZK; const float sc = isq ? 0.125f * 1.4426950408889634f : 1.0f;
            const int ct = (pn & 1) * 256; const bool rot = ((wc & 1) == 0) && (fq < 2);
#pragma unroll
            for (int ai = 0; ai < 2; ++ai)
#pragma unroll
                for (int m = 0; m < 4; ++m) { const int rowi = row0 + ai * HALF + m * 16; const size_t row = (size_t)rowi;
                    f32x4 cs0 = {1.f, 0.f, 1.f, 0.f}, cs1 = {1.f, 0.f, 1.f, 0.f};
                    if (rot) { const float* rp = rope + (size_t)(rowi & (SEQ - 1)) * 16 + 8 * fq; cs0 = *(const f32x4*)rp; cs1 = *(const f32x4*)(rp + 4); }
#pragma unroll
                    for (int bj = 0; bj < 2; ++bj) { f32x4 x1 = acc[ai][bj][m][0], x2 = acc[ai][bj][m][1], y1, y2;
                        y1[0] = x1[0] * cs0[0] - x2[0] * cs0[1]; y2[0] = x2[0] * cs0[0] + x1[0] * cs0[1];
                        y1[1] = x1[1] * cs0[2] - x2[1] * cs0[3]; y2[1] = x2[1] * cs0[2] + x1[1] * cs0[3];
                        y1[2] = x1[2] * cs1[0] - x2[2] * cs1[1]; y2[2] = x2[2] * cs1[0] + x1[2] * cs1[1];
                        y1[3] = x1[3] * cs1[2] - x2[3] * cs1[3]; y2[3] = x2[3] * cs1[2] + x1[3] * cs1[3];
                        st8(Z + row * 512 + ct + bj * HALF + cw, y1 * sc, y2 * sc); } }
        } else if (pn < 11) {
            bf16_t* Z = pn < 8 ? ZV : ZG; const int ld = pn < 8 ? 512 : 768, ct = pn < 8 ? (pn - 6) * 256 : (pn - 8) * 256;
#pragma unroll
            for (int ai = 0; ai < 2; ++ai)
#pragma unroll
                for (int m = 0; m < 4; ++m) { const size_t row = (size_t)(row0 + ai * HALF + m * 16);
#pragma unroll
                    for (int bj = 0; bj < 2; ++bj) st8(Z + row * ld + ct + bj * HALF + cw, acc[ai][bj][m][0], acc[ai][bj][m][1]); }
        } else {
            const f32x4 b0 = *(const f32x4*)(bgate + cw), b1 = *(const f32x4*)(bgate + cw + 4);
#pragma unroll
            for (int ai = 0; ai < 2; ++ai)
#pragma unroll
                for (int m = 0; m < 4; ++m) { const size_t row = (size_t)(row0 + ai * HALF + m * 16); f32x4 x0 = acc[ai][0][m][0] + b0, x1 = acc[ai][0][m][1] + b1, l0, l1;
#pragma unroll
                    for (int i = 0; i < 4; ++i) { l0[i] = (fminf(x0[i], 0.f) - __logf(1.f + __expf(-fabsf(x0[i])))) * 0.0625f; l1[i] = (fminf(x1[i], 0.f) - __logf(1.f + __expf(-fabsf(x1[i])))) * 0.0625f; }
                    *(f32x4*)(LA + row * 128 + cw) = l0; *(f32x4*)(LA + row * 128 + cw + 4) = l1; }
        }
    }
};
struct GroupedOrder {
    const PG8_LAS int* tb; int nN, G, c;
    __device__ __forceinline__ bool next(int i, Unit& u) const {
        const int total = tb[NEXPG] * nN; const long L = (long)i * G + c; if (L >= total) return false;
        int wgid = (int)L; { const int q = total / NXCD, r = total % NXCD, xcd = wgid % NXCD, off = wgid / NXCD; wgid = (xcd < r ? xcd * (q + 1) : r * (q + 1) + (xcd - r) * q) + off; }
        int e = 0;
#pragma unroll
        for (int j = 1; j < NEXPG; ++j) if (wgid >= tb[j] * nN) e = j;
        const int loc = wgid - tb[e] * nN, nMe = tb[e + 1] - tb[e];
        const int nig = WGM * nN, gid = loc / nig, fm = gid * WGM, gsz = (nMe - fm) < WGM ? (nMe - fm) : WGM;
        u.pm = tb[e] + fm + ((loc % nig) % gsz); u.pn = (loc % nig) / gsz; u.pe = e; return true;
    }
    __device__ __forceinline__ void a_ready(const Unit&) const {}
    __device__ __forceinline__ void done(const Unit&) const {}
};
template <class Epi, class Sched, bool ALIGN_EPI = false, bool SP2 = false>
__device__ __forceinline__ void gemm_phase(PG8_LAS unsigned char* lds, const Gemm g, const Sched& S, const Epi& E, const int wid_in) {
    const int lane = lane_now(), wid = wid_in, tid = wid * 64 + lane,
              wr = wid >> 2, wc = wid & 3, fr = lane & 15, fq = lane >> 4;
    const int K = g.K, nt = K / BK;
    unsigned voffA[2], voffB[2];
#pragma unroll
    for (int i = 0; i < 2; ++i) { int R, C; stage_rc(tid * 16 + i * 8192, R, C); const int Rb = Epi::PERM ? ((R & ~31) + perm32(R & 31)) : R;
        voffA[i] = (unsigned)(R * K + C) * 2u; voffB[i] = (unsigned)(Rb * K + C) * 2u; }
    const size_t kstep = (size_t)(BK * 2);
    const size_t hstep = (size_t)HALF * K * 2;
    const size_t tstep = 2 * hstep;
    const unsigned ldsw = (unsigned)wid * 1024u;
    const int aoff = lds_byte(wr * 64 + fr, fq * 8), boff = lds_byte(wc * 32 + fr, fq * 8);
#define PG8_SA(b, h) (((b) * 2 + (h)) * HTB)
#define PG8_SB(b, h) ((4 + (b) * 2 + (h)) * HTB)
#define PG8_STAGE(bufoff, gbase, voff) do { _Pragma("unroll") for (int _i = 0; _i < 2; ++_i) \
        __builtin_amdgcn_global_load_lds((const unsigned*)((const char*)(gbase) + (voff)[_i]), (PG8_LAS unsigned*)(lds + (bufoff) + ldsw + _i * 8192), 16, 0, 0); } while (0)
#define PG8_LDA(dst, b, h) do { _Pragma("unroll") for (int m = 0; m < 4; ++m) _Pragma("unroll") for (int k = 0; k < 2; ++k) dst[m][k] = *(const PG8_LAS bf16x8*)(lds + PG8_SA(b, h) + aoff + m * 2048 + k * 1024); } while (0)
#define PG8_LDB(dst, b, h) do { _Pragma("unroll") for (int n = 0; n < 2; ++n) _Pragma("unroll") for (int k = 0; k < 2; ++k) dst[n][k] = *(const PG8_LAS bf16x8*)(lds + PG8_SB(b, h) + boff + n * 2048 + k * 1024); } while (0)
#define PG8_MMA(ai, bj, At, Bt) do { __builtin_amdgcn_s_setprio(1); _Pragma("unroll") for (int m = 0; m < 4; ++m) _Pragma("unroll") for (int n = 0; n < 2; ++n) _Pragma("unroll") for (int k = 0; k < 2; ++k) \
        acc[ai][bj][m][n] = __builtin_amdgcn_mfma_f32_16x16x32_bf16(Bt[n][k], At[m][k], acc[ai][bj][m][n], 0, 0, 0); __builtin_amdgcn_s_setprio(0); } while (0)
#define PG8_WAIT_V(n) asm volatile("s_waitcnt vmcnt(" #n ")" ::: "memory")
#define PG8_WAIT_L(n) asm volatile("s_waitcnt lgkmcnt(" #n ")" ::: "memory")
#define PG8_BAR __builtin_amdgcn_s_barrier()
#define PG8_SCHED __builtin_amdgcn_sched_barrier(0)
    Unit cur, nxt; int ui = 0;
    if (!S.next(0, cur)) return;
    f32x4 acc[2][2][4][2];
#pragma unroll
    for (int a = 0; a < 2; ++a)
#pragma unroll
        for (int b = 0; b < 2; ++b)
#pragma unroll
            for (int m = 0; m < 4; ++m)
#pragma unroll
                for (int n = 0; n < 2; ++n) acc[a][b][m][n] = (f32x4){0.f, 0.f, 0.f, 0.f};
    bf16x8 At[4][2], B0[2][2], B1[2][2];
    const char* cA = (const char*)g.A + (size_t)cur.pm * tstep; const char* cB = (const char*)g.Bt + (size_t)cur.pe * g.bstride + (size_t)cur.pn * tstep;
    S.a_ready(cur);
    if constexpr (SP2) {
        PG8_STAGE(PG8_SB(0, 0), cB, voffB); PG8_STAGE(PG8_SB(0, 1), cB + hstep, voffB); PG8_STAGE(PG8_SA(0, 0), cA, voffA); PG8_STAGE(PG8_SA(0, 1), cA + hstep, voffA);
        if (wr == 1) PG8_BAR;
        PG8_WAIT_V(2); PG8_BAR;
        PG8_STAGE(PG8_SB(1, 0), cB + kstep, voffB); PG8_STAGE(PG8_SA(1, 0), cA + kstep, voffA); PG8_STAGE(PG8_SB(1, 1), cB + hstep + kstep, voffB);
        PG8_WAIT_V(6); PG8_BAR;
    } else {
        PG8_STAGE(PG8_SB(0, 0), cB, voffB); PG8_STAGE(PG8_SA(0, 0), cA, voffA); PG8_STAGE(PG8_SB(0, 1), cB + hstep, voffB); PG8_STAGE(PG8_SA(0, 1), cA + hstep, voffA);
        if (wr == 1) PG8_BAR;
        PG8_WAIT_V(4); PG8_BAR;
        PG8_STAGE(PG8_SB(1, 0), cB + kstep, voffB); PG8_STAGE(PG8_SA(1, 0), cA + kstep, voffA); PG8_STAGE(PG8_SB(1, 1), cB + hstep + kstep, voffB);
        PG8_WAIT_V(6); PG8_BAR;
    }
    for (;;) {
        const bool has_next = S.next(ui + 1, nxt);
        const char* nA = has_next ? (const char*)g.A + (size_t)nxt.pm * tstep : cA; const char* nB = has_next ? (const char*)g.Bt + (size_t)nxt.pe * g.bstride + (size_t)nxt.pn * tstep : cB;
        for (int t = 0; t < nt; t += 2) {
            const bool last = (t == nt - 2);
            const char* a1 = cA + (size_t)(t + 1) * kstep;
            const char* a2 = last ? nA : cA + (size_t)(t + 2) * kstep; const char* b2 = last ? nB : cB + (size_t)(t + 2) * kstep;
            const char* a3 = a2 + kstep; const char* b3 = b2 + kstep;
            if (last && has_next) S.a_ready(nxt);
            if constexpr (SP2) {
            PG8_LDB(B0, 0, 0); PG8_LDB(B1, 0, 1); PG8_SCHED; PG8_LDA(At, 0, 0); PG8_STAGE(PG8_SA(1, 1), a1 + hstep, voffA);
            PG8_WAIT_V(8); PG8_WAIT_L(0); PG8_BAR; PG8_MMA(0, 0, At, B0); PG8_MMA(0, 1, At, B1); PG8_BAR; PG8_SCHED;
            PG8_LDA(At, 0, 1); PG8_STAGE(PG8_SB(0, 0), b2, voffB); PG8_STAGE(PG8_SB(0, 1), b2 + hstep, voffB); PG8_STAGE(PG8_SA(0, 0), a2, voffA);
            PG8_WAIT_V(8); PG8_WAIT_L(0); PG8_BAR; PG8_MMA(1, 0, At, B0); PG8_MMA(1, 1, At, B1); PG8_BAR; PG8_SCHED;
            PG8_LDB(B0, 1, 0); PG8_LDB(B1, 1, 1); PG8_SCHED; PG8_LDA(At, 1, 0); PG8_STAGE(PG8_SA(0, 1), a2 + hstep, voffA);
            PG8_WAIT_V(8); PG8_WAIT_L(0); PG8_BAR; PG8_MMA(0, 0, At, B0); PG8_MMA(0, 1, At, B1); PG8_BAR; PG8_SCHED;
            PG8_LDA(At, 1, 1); PG8_STAGE(PG8_SB(1, 0), b3, voffB); PG8_STAGE(PG8_SB(1, 1), b3 + hstep, voffB); PG8_STAGE(PG8_SA(1, 0), a3, voffA);
            PG8_WAIT_V(8); PG8_WAIT_L(0); PG8_BAR; PG8_MMA(1, 0, At, B0); PG8_MMA(1, 1, At, B1); PG8_BAR; PG8_SCHED;
            } else {
            PG8_LDB(B0, 0, 0); PG8_SCHED; PG8_LDA(At, 0, 0); PG8_STAGE(PG8_SA(1, 1), a1 + hstep, voffA);
            PG8_WAIT_L(8); PG8_BAR; PG8_WAIT_L(0); PG8_MMA(0, 0, At, B0); PG8_BAR; PG8_SCHED;
            PG8_LDB(B1, 0, 1); PG8_STAGE(PG8_SB(0, 0), b2, voffB);
            PG8_BAR; PG8_WAIT_L(0); PG8_MMA(0, 1, At, B1); PG8_BAR;
            PG8_LDA(At, 0, 1); PG8_STAGE(PG8_SA(0, 0), a2, voffA);
            PG8_BAR; PG8_WAIT_L(0); PG8_MMA(1, 0, At, B0); PG8_BAR; PG8_SCHED;
            PG8_STAGE(PG8_SB(0, 1), b2 + hstep, voffB);
            PG8_WAIT_V(6); PG8_BAR; PG8_MMA(1, 1, At, B1); PG8_BAR;
            PG8_LDB(B0, 1, 0); PG8_SCHED; PG8_LDA(At, 1, 0); PG8_STAGE(PG8_SA(0, 1), a2 + hstep, voffA);
            PG8_WAIT_L(8); PG8_BAR; PG8_WAIT_L(0); PG8_MMA(0, 0, At, B0); PG8_BAR; PG8_SCHED;
            PG8_LDB(B1, 1, 1); PG8_STAGE(PG8_SB(1, 0), b3, voffB);
            PG8_BAR; PG8_WAIT_L(0); PG8_MMA(0, 1, At, B1); PG8_BAR;
            PG8_LDA(At, 1, 1); PG8_STAGE(PG8_SA(1, 0), a3, voffA);
            PG8_BAR; PG8_WAIT_L(0); PG8_MMA(1, 0, At, B0); PG8_BAR; PG8_SCHED;
            PG8_STAGE(PG8_SB(1, 1), b3 + hstep, voffB);
            PG8_WAIT_V(6); PG8_BAR; PG8_MMA(1, 1, At, B1); PG8_BAR;
            }
        }
        if constexpr (ALIGN_EPI) { if (wr == 0) PG8_BAR; }
        if constexpr (!Epi::AFTER_DRAIN) { const int l2_ = lane_now(); E(acc, cur, wr, wc, l2_ & 15, l2_ >> 4); S.done(cur); }
        if (!has_next) break;
#pragma unroll
        for (int a = 0; a < 2; ++a)
#pragma unroll
            for (int b = 0; b < 2; ++b)
#pragma unroll
                for (int m = 0; m < 4; ++m)
#pragma unroll
                    for (int n = 0; n < 2; ++n) acc[a][b][m][n] = (f32x4){0.f, 0.f, 0.f, 0.f};
        cur = nxt; cA = nA; cB = nB; ++ui;
        if constexpr (ALIGN_EPI) { if (wr == 1) PG8_BAR; }
    }
    PG8_WAIT_V(0);
    if constexpr (!ALIGN_EPI) { if (wr == 0) PG8_BAR; }
    PG8_BAR;
    if constexpr (Epi::AFTER_DRAIN) { E.fused(acc, cur, wr, wc, lane & 15, lane >> 4, lds, wid, lane); S.done(cur); }
#undef PG8_SA
#undef PG8_SB
#undef PG8_STAGE
#undef PG8_LDA
#undef PG8_LDB
#undef PG8_MMA
#undef PG8_WAIT_V
#undef PG8_WAIT_L
#undef PG8_BAR
#undef PG8_SCHED
}
}
#define PG8_SP2 true
#define PG8_ALIGN true
#include <hip/hip_bf16.h>
#include <cmath>
namespace attn_body {
using bf16=__hip_bfloat16;
using bf16x8=__attribute__((ext_vector_type(8)))short;
using s16x4=__attribute__((ext_vector_type(4)))short;
using f32x16=__attribute__((ext_vector_type(16)))float;
using u32x4=__attribute__((ext_vector_type(4)))unsigned;
constexpr int BATCH=4,NHEAD=16,SEQ=8192,D=64;
constexpr int QP=512,KP=512,VP=512,OP=1024;
constexpr int NW=8,QBLK=32,QB=QBLK*NW,KVBLK=64,NQB=SEQ/QB;
constexpr int ATTN_UNIT_ROWS=QB;
__device__ __forceinline__ int crow(int r,int hi){return (r&3)+8*(r>>2)+4*hi;}
#define SBAR() __builtin_amdgcn_sched_barrier(0)
__device__ __forceinline__ void cmask(f32x16&p0,f32x16&p1,int jb,int qrel,int hi){
  const float NEG=-INFINITY; (void)hi;
  if(jb>(qrel>>6)){
  #pragma unroll
  for(int r=0;r<16;++r){p0[r]=NEG;p1[r]=NEG;} }
}
constexpr int NSLOT=3, SLOTB=8192;
constexpr int LDS_K=0, LDS_V=NSLOT*SLOTB, LDS_WS=2*NSLOT*SLOTB, LDS_OST=LDS_WS+NW*64*4, LDS_BYTES=LDS_OST+NW*4096;
constexpr float C2=0.125f*1.4426950408889634f;
__device__ __forceinline__ void glds16(const void*gsrc,unsigned lds_dst){unsigned keep;
  asm volatile("s_mov_b32 %0, m0\n\ts_mov_b32 m0, %2\n\ts_nop 0\n\tglobal_load_lds_dwordx4 %1, off\n\ts_mov_b32 m0, %0":"=&s"(keep):"v"(gsrc),"s"(lds_dst):"memory");}
__device__ __forceinline__ float max3f(float a,float b,float c){float r;asm("v_max3_f32 %0, %1, %2, %3":"=v"(r):"v"(a),"v"(b),"v"(c));return r;}
__device__ __forceinline__ float max2f(float a,float b){float r;asm("v_max_f32_e32 %0, %1, %2":"=v"(r):"v"(a),"v"(b));return r;}
__device__ __forceinline__ float fadd_s(float a,float b){float r;asm("v_add_f32_e32 %0, %1, %2":"=v"(r):"v"(a),"v"(b));return r;}
__device__ __forceinline__ float fsub_s(float a,float b){float r;asm("v_sub_f32_e32 %0, %1, %2":"=v"(r):"v"(a),"v"(b));return r;}
typedef float f32x2_t __attribute__((ext_vector_type(2))); typedef __bf16 bf16x2_t __attribute__((ext_vector_type(2)));
__device__ __forceinline__ unsigned cvtpk_s(float lo,float hi){f32x2_t v={lo,hi};bf16x2_t b=__builtin_convertvector(v,bf16x2_t);return __builtin_bit_cast(unsigned,b);}
#define WAIT_BAR(N) asm volatile("s_waitcnt vmcnt(" #N ") lgkmcnt(0)\n\ts_barrier":::"memory")

__device__ __forceinline__ void qkt(f32x16&p0,f32x16&p1,const char*Kslot,const bf16x8*qr,const f32x16&negm,int r32,int hi){
  const char*kb=Kslot+hi*1024+r32*16;
  #pragma unroll
  for(int d0=0;d0<4;++d0){
    const bf16x8 b0=*reinterpret_cast<const bf16x8*>(kb+d0*2048);
    const bf16x8 b1=*reinterpret_cast<const bf16x8*>(kb+d0*2048+512);
    if(d0==0){p0=__builtin_amdgcn_mfma_f32_32x32x16_bf16(b0,qr[0],negm,0,0,0);p1=__builtin_amdgcn_mfma_f32_32x32x16_bf16(b1,qr[0],negm,0,0,0);}
    else{p0=__builtin_amdgcn_mfma_f32_32x32x16_bf16(b0,qr[d0],p0,0,0,0);p1=__builtin_amdgcn_mfma_f32_32x32x16_bf16(b1,qr[d0],p1,0,0,0);}}
}
typedef __attribute__((address_space(3))) const char* lds_cptr;
typedef short v4i16_t __attribute__((ext_vector_type(4)));
__device__ __forceinline__ void kload8(bf16x8*kf,lds_cptr kp){
  kf[0]=*(const __attribute__((address_space(3))) bf16x8*)(kp);      kf[1]=*(const __attribute__((address_space(3))) bf16x8*)(kp+512);
  kf[2]=*(const __attribute__((address_space(3))) bf16x8*)(kp+2048); kf[3]=*(const __attribute__((address_space(3))) bf16x8*)(kp+2560);
  kf[4]=*(const __attribute__((address_space(3))) bf16x8*)(kp+4096); kf[5]=*(const __attribute__((address_space(3))) bf16x8*)(kp+4608);
  kf[6]=*(const __attribute__((address_space(3))) bf16x8*)(kp+6144); kf[7]=*(const __attribute__((address_space(3))) bf16x8*)(kp+6656);
}
__device__ __forceinline__ void kload2(bf16x8*kf,lds_cptr kp,int j){ kf[2*j]=*(const __attribute__((address_space(3))) bf16x8*)(kp+j*2048); kf[2*j+1]=*(const __attribute__((address_space(3))) bf16x8*)(kp+j*2048+512); }
__device__ __forceinline__ s16x4 vtr(lds_cptr p){ return __builtin_bit_cast(s16x4,__builtin_amdgcn_ds_read_tr16_b64_v4i16((__attribute__((address_space(3))) v4i16_t*)p)); }
__device__ __forceinline__ float rowmax(const f32x16&p0,const f32x16&p1){
  float a=max3f(p0[0],p0[1],p1[0]),b=max3f(p0[2],p0[3],p1[1]);a=max3f(a,p1[2],p1[3]);
  #pragma unroll
  for(int r=4;r<16;r+=4){a=max3f(a,p0[r],p0[r+1]);b=max3f(b,p0[r+2],p0[r+3]);a=max3f(a,p1[r],p1[r+1]);b=max3f(b,p1[r+2],p1[r+3]);}
  const float m=max2f(a,b);
  auto rr=__builtin_amdgcn_permlane32_swap(__float_as_uint(m),__float_as_uint(m),false,false);
  return max2f(__uint_as_float(rr[0]),__uint_as_float(rr[1]));
}
__device__ __forceinline__ void pv(f32x16*o,int vb,bf16x8 pa0,bf16x8 pa1,bf16x8 pa2,bf16x8 pa3){
  #pragma unroll
  for(int d0=0;d0<2;++d0){s16x4 lo[4],hi[4];
    #pragma unroll
    for(int ks=0;ks<4;++ks){
      asm volatile("ds_read_b64_tr_b16 %0,%1 offset:%c2":"=&v"(lo[ks]):"v"(vb),"i"(d0*4096+ks*1024):"memory");
      asm volatile("ds_read_b64_tr_b16 %0,%1 offset:%c2":"=&v"(hi[ks]):"v"(vb),"i"(d0*4096+ks*1024+512):"memory");}
    asm volatile("s_waitcnt lgkmcnt(0)":::"memory");SBAR();
    #define PK(k) (bf16x8){lo[k][0],lo[k][1],lo[k][2],lo[k][3],hi[k][0],hi[k][1],hi[k][2],hi[k][3]}
    o[d0]=__builtin_amdgcn_mfma_f32_32x32x16_bf16(pa0,PK(0),o[d0],0,0,0);
    o[d0]=__builtin_amdgcn_mfma_f32_32x32x16_bf16(pa1,PK(1),o[d0],0,0,0);
    o[d0]=__builtin_amdgcn_mfma_f32_32x32x16_bf16(pa2,PK(2),o[d0],0,0,0);
    o[d0]=__builtin_amdgcn_mfma_f32_32x32x16_bf16(pa3,PK(3),o[d0],0,0,0);
    #undef PK
  }
}

#ifndef ATTN_STORE16
#define ATTN_STORE16(p,v) (*(u32x4*)(p)=(v))
#endif
template<int THRL> __device__ __forceinline__ void attn_unit(int b,int qcol,int vcol,int ocol,int qb,const bf16*Q,const bf16*__restrict__ K,const bf16*__restrict__ V,bf16*O,char*shm,const int wid_in){
  const int lane=lane_now(),r32=lane&31,hi=lane>>5; const int wid=wid_in; const int tid=wid*64+lane; (void)tid;
  const long rowbase=(long)b*SEQ; const int q0=qb*QB;
  const bf16*Qw=Q+(rowbase+q0+wid*QBLK)*QP+qcol;
  const bf16*Kh=K+rowbase*KP+qcol,*Vh=V+rowbase*VP+vcol;
  const unsigned lds0=(unsigned)(uintptr_t)shm;
  float*wsf=(float*)(shm+LDS_WS)+wid*64;
  const bf16*ksrc=Kh+(long)lane*KP+wid*8;
  const bf16*vsrc=Vh+(long)(16*(wid&3)+(lane>>2))*VP+(wid>>2)*32+(lane&3)*8;
  const unsigned kdst=lds0+LDS_K+wid*1024, vdst=lds0+LDS_V+wid*1024;
  #define DMA_K(t,slot) glds16(ksrc+(long)(t)*KVBLK*KP,(unsigned)__builtin_amdgcn_readfirstlane(kdst+(slot)))
  #define DMA_V(t,slot) glds16(vsrc+(long)(t)*KVBLK*VP,(unsigned)__builtin_amdgcn_readfirstlane(vdst+(slot)))
  const int vb0=(int)(lds0+LDS_V)+((lane>>4)&1)*32+(lane&3)*8+(4*hi+((lane&15)>>2))*64;
  const char*Kbase=shm+LDS_K; bf16x8 kf[8];
  const lds_cptr shm3=(lds_cptr)shm; const lds_cptr kp0=shm3+LDS_K+hi*1024+r32*16; const lds_cptr vp0=shm3+LDS_V+((lane>>4)&1)*32+(lane&3)*8+(4*hi+((lane&15)>>2))*64;
  const int NT=(q0+QB)/KVBLK;
  DMA_K(0,0);DMA_V(0,0);DMA_K(1,SLOTB);
  bf16x8 qr[4];
  #pragma unroll
  for(int d0=0;d0<4;++d0)qr[d0]=*reinterpret_cast<const bf16x8*>(&Qw[(long)r32*QP+d0*16+hi*8]);
  float mhat=0.f,l_reg=0.f;f32x16 o[2];o[0]=f32x16{};o[1]=f32x16{};f32x16 negm=f32x16{};asm volatile("":"+v"(negm));
  const int qrel=wid*QBLK+r32;
  #define CMASK(P0,P1,t) do{int jb_=(t)-(NT-4); if(jb_>=0)cmask(P0,P1,jb_,qrel,hi);}while(0)
  bool resc=false;
  #define START(P0,P1) do{ const float rm=rowmax(P0,P1); resc=false; \
    { const float dl=rm; mhat=fadd_s(mhat,dl); \
      _Pragma("unroll") for(int r=0;r<16;++r){P0[r]=fsub_s(P0[r],dl);P1[r]=fsub_s(P1[r],dl);} \
      _Pragma("unroll") for(int r=0;r<16;++r)negm[r]=-mhat; asm volatile("":"+v"(negm)); } \
    _Pragma("unroll") for(int r=0;r<16;++r)P0[r]=__builtin_amdgcn_exp2f(P0[r]); }while(0)
  #define RESC() do{ if(resc){ asm volatile("s_waitcnt lgkmcnt(0)":::"memory"); \
      _Pragma("unroll") for(int d_=0;d_<2;++d_) _Pragma("unroll") for(int r=0;r<16;++r)o[d_][r]*=wsf[crow(r,hi)]; } }while(0)
  f32x16 pA0,pA1,pB0,pB1;
  int sl_prev=0,sl_cur=0,sl_next=SLOTB;
  #define ROT() do{sl_prev=sl_cur;sl_cur=sl_next;sl_next=(sl_next==(NSLOT-1)*SLOTB)?0:sl_next+SLOTB;}while(0)
  DMA_K(2,2*SLOTB);
  WAIT_BAR(3);
  qkt(pA0,pA1,Kbase,qr,negm,r32,hi);asm volatile("s_nop 15\n\ts_nop 7":"+v"(pA0),"+v"(pA1));CMASK(pA0,pA1,0);
  START(pA0,pA1);
  _Pragma("unroll") for(int r=0;r<16;++r)pA1[r]=__builtin_amdgcn_exp2f(pA1[r]);
  WAIT_BAR(0);
  DMA_K(3,0);DMA_V(1,SLOTB);
  ROT();
  kload8(kf,kp0+sl_cur);
  WAIT_BAR(2);
  s16x4 vlo[8],vhi[8]; u32x4 pw0,pw1,pw2,pw3;
  #define PKW(P,B) cvtpk_s(P[B],P[B+1])
  #define PAF(k) __builtin_bit_cast(bf16x8,pw##k)
  #define VFR(i) (bf16x8){vlo[i][0],vlo[i][1],vlo[i][2],vlo[i][3],vhi[i][0],vhi[i][1],vhi[i][2],vhi[i][3]}
  #define PIN(x) asm volatile("":"+v"(x))
  #define MX3(a,b,c) __builtin_fmaxf(__builtin_fmaxf((a),(b)),(c))
  #define GAPA(MF,A0,A1,A2,A3,W0,W1,PW) do{ MF; sacc+=A0; sacc+=A1; sacc+=A2; sacc+=A3; PIN(sacc); W0; W1; PIN(PW); SBAR(); }while(0)
  #define EX(v) __builtin_amdgcn_exp2f(v)
  #define GAPB(MF,X,B) do{ MF; X[B]=EX(X[B]); X[B+1]=EX(X[B+1]); X[B+2]=EX(X[B+2]); X[B+3]=EX(X[B+3]); PIN(X); SBAR(); }while(0)
  #define VRD(i) do{ vlo[i]=vtr(vp_+(((i)>>2)*4096+((i)&3)*1024)); vhi[i]=vtr(vp_+(((i)>>2)*4096+((i)&3)*1024+512)); }while(0)
  #define KRD(G,j) do{ if(G){ kload2(kf,kp0+sl_next,j); SBAR(); } }while(0)
  #define STEP(C0,C1,P0,P1,t,GK,GV,GL) do{ SBAR(); \
    const lds_cptr vp_=vp0+sl_prev; \
    VRD(0); SBAR(); float sacc=(P0[0]+P0[1]); \
    GAPA(C0=__builtin_amdgcn_mfma_f32_32x32x16_bf16(kf[0],qr[0],negm,0,0,0), P0[2],P0[3],P0[4],P0[5],     pw0[0]=PKW(P0,0), pw0[1]=PKW(P0,2), pw0); \
    VRD(4); SBAR(); GAPA(C1=__builtin_amdgcn_mfma_f32_32x32x16_bf16(kf[1],qr[0],negm,0,0,0), P0[6],P0[7],P0[8],P0[9],     pw0[2]=PKW(P0,4), pw0[3]=PKW(P0,6), pw0); \
    VRD(1); SBAR(); GAPA(C0=__builtin_amdgcn_mfma_f32_32x32x16_bf16(kf[2],qr[1],C0,0,0,0),   P0[10],P0[11],P0[12],P0[13], pw1[0]=PKW(P0,8), pw1[1]=PKW(P0,10), pw1); \
    VRD(5); SBAR(); GAPA(C1=__builtin_amdgcn_mfma_f32_32x32x16_bf16(kf[3],qr[1],C1,0,0,0),   P0[14],P0[15],P1[0],P1[1],   pw1[2]=PKW(P0,12),pw1[3]=PKW(P0,14), pw1); \
    VRD(2); SBAR(); GAPA(C0=__builtin_amdgcn_mfma_f32_32x32x16_bf16(kf[4],qr[2],C0,0,0,0),   P1[2],P1[3],P1[4],P1[5],     pw2[0]=PKW(P1,0), pw2[1]=PKW(P1,2), pw2); \
    VRD(6); SBAR(); GAPA(C1=__builtin_amdgcn_mfma_f32_32x32x16_bf16(kf[5],qr[2],C1,0,0,0),   P1[6],P1[7],P1[8],P1[9],     pw2[2]=PKW(P1,4), pw2[3]=PKW(P1,6), pw2); \
    VRD(3); SBAR(); GAPA(C0=__builtin_amdgcn_mfma_f32_32x32x16_bf16(kf[6],qr[3],C0,0,0,0),   P1[10],P1[11],P1[12],P1[13], pw3[0]=PKW(P1,8), pw3[1]=PKW(P1,10), pw3); \
    VRD(7); SBAR(); GAPA(C1=__builtin_amdgcn_mfma_f32_32x32x16_bf16(kf[7],qr[3],C1,0,0,0),   P1[14],P1[15],0.f,0.f,       pw3[2]=PKW(P1,12),pw3[3]=PKW(P1,14), pw3); \
    l_reg+=sacc; \
    if(GK){DMA_K((t)+3,sl_cur);} if(GV){DMA_V((t)+1,sl_next);} \
    CMASK(C0,C1,t); \
    { float a=MX3(C0[0],C0[1],C1[0]),b=MX3(C0[2],C0[3],C1[1]); a=MX3(a,C1[2],C1[3]); \
      _Pragma("unroll") for(int r=4;r<16;r+=4){a=MX3(a,C0[r],C0[r+1]);b=MX3(b,C0[r+2],C0[r+3]);a=MX3(a,C1[r],C1[r+1]);b=MX3(b,C1[r+2],C1[r+3]);} \
      float rm=__builtin_fmaxf(a,b); { auto rr=__builtin_amdgcn_permlane32_swap(__float_as_uint(rm),__float_as_uint(rm),false,false); rm=__builtin_fmaxf(__uint_as_float(rr[0]),__uint_as_float(rr[1])); } \
      resc=false; \
      if(__builtin_expect(__any(rm>(float)THRL),0)){ const float dl=__builtin_fmaxf(rm,0.f); mhat+=dl; \
        _Pragma("unroll") for(int r=0;r<16;++r){C0[r]-=dl;C1[r]-=dl;} \
        _Pragma("unroll") for(int r=0;r<16;++r)negm[r]=-mhat; asm volatile("":"+v"(negm)); \
        const float f=__builtin_amdgcn_exp2f(-dl); l_reg*=f; if(hi==0)wsf[r32]=f; resc=true; } } \
    SBAR(); \
    GAPB(o[0]=__builtin_amdgcn_mfma_f32_32x32x16_bf16(PAF(0),VFR(0),o[0],0,0,0), C0,0); \
    GAPB(o[1]=__builtin_amdgcn_mfma_f32_32x32x16_bf16(PAF(0),VFR(4),o[1],0,0,0), C0,4); \
    KRD(GL,0); GAPB(o[0]=__builtin_amdgcn_mfma_f32_32x32x16_bf16(PAF(1),VFR(1),o[0],0,0,0), C0,8); \
    KRD(GL,1); GAPB(o[1]=__builtin_amdgcn_mfma_f32_32x32x16_bf16(PAF(1),VFR(5),o[1],0,0,0), C0,12); \
    KRD(GL,2); GAPB(o[0]=__builtin_amdgcn_mfma_f32_32x32x16_bf16(PAF(2),VFR(2),o[0],0,0,0), C1,0); \
    KRD(GL,3); GAPB(o[1]=__builtin_amdgcn_mfma_f32_32x32x16_bf16(PAF(2),VFR(6),o[1],0,0,0), C1,4); \
    GAPB(o[0]=__builtin_amdgcn_mfma_f32_32x32x16_bf16(PAF(3),VFR(3),o[0],0,0,0), C1,8); \
    GAPB(o[1]=__builtin_amdgcn_mfma_f32_32x32x16_bf16(PAF(3),VFR(7),o[1],0,0,0), C1,12); \
    }while(0)
  int t=1;
  #undef CMASK
  #define CMASK(P0,P1,t) do{}while(0)
  for(;t+5<NT;t+=2){
    STEP(pB0,pB1,pA0,pA1,t,true,true,true);     WAIT_BAR(2); RESC(); ROT();
    STEP(pA0,pA1,pB0,pB1,t+1,true,true,true);   WAIT_BAR(2); RESC(); ROT();
  }
  #undef CMASK
  #define CMASK(P0,P1,t) do{int jb_=(t)-(NT-4); if(jb_>=0)cmask(P0,P1,jb_,qrel,hi);}while(0)
  #define ENDW(tt) do{ if((tt)+3<NT){WAIT_BAR(2);} else if((tt)+2<NT){WAIT_BAR(1);} else {WAIT_BAR(0);} }while(0)
  for(;t+1<NT;t+=2){
    STEP(pB0,pB1,pA0,pA1,t,(t+3<NT),(t+1<NT),(t+1<NT));       ENDW(t);   RESC(); ROT();
    STEP(pA0,pA1,pB0,pB1,t+1,(t+4<NT),(t+2<NT),(t+2<NT));     ENDW(t+1); RESC(); ROT();
  }
  STEP(pB0,pB1,pA0,pA1,NT-1,false,false,false); RESC();
  { float sacc=pB0[0]+pB0[1]; _Pragma("unroll") for(int r=2;r<16;++r)sacc+=pB0[r]; _Pragma("unroll") for(int r=0;r<16;++r)sacc+=pB1[r]; l_reg+=sacc;
    pw0=(u32x4){PKW(pB0,0),PKW(pB0,2),PKW(pB0,4),PKW(pB0,6)};pw1=(u32x4){PKW(pB0,8),PKW(pB0,10),PKW(pB0,12),PKW(pB0,14)};pw2=(u32x4){PKW(pB1,0),PKW(pB1,2),PKW(pB1,4),PKW(pB1,6)};pw3=(u32x4){PKW(pB1,8),PKW(pB1,10),PKW(pB1,12),PKW(pB1,14)};
    SBAR(); pv(o,vb0+sl_cur,PAF(0),PAF(1),PAF(2),PAF(3)); }
  #undef PKW
  #undef PAF
  #undef VFR
  #undef PIN
  #undef MX3
  #undef GAPA
  #undef GAPB
  #undef EX
  #undef VRD
  #undef KRD
  #undef STEP
  #undef ENDW
  {auto rr=__builtin_amdgcn_permlane32_swap(__float_as_uint(l_reg),__float_as_uint(l_reg),false,false);l_reg=__uint_as_float(rr[0])+__uint_as_float(rr[1]);}
  if(hi==0)wsf[32+r32]=l_reg;asm volatile("s_waitcnt lgkmcnt(0)":::"memory");
  float rli[16];
  #pragma unroll
  for(int r=0;r<16;++r)rli[r]=__builtin_amdgcn_rcpf(wsf[32+crow(r,hi)]);
  bf16*Ow=O+(rowbase+q0+wid*QBLK)*OP+ocol;
  { bf16*stg=(bf16*)(shm+LDS_OST)+wid*2048;
    #pragma unroll
    for(int r=0;r<16;++r){const int orow=crow(r,hi);
      #pragma unroll
      for(int d0=0;d0<2;++d0)stg[orow*64+d0*32+r32]=__float2bfloat16(o[d0][r]*rli[r]);}
    asm volatile("s_waitcnt lgkmcnt(0)":::"memory");
    #pragma unroll
    for(int i=0;i<4;++i){const int row=i*8+(lane>>3),ch=lane&7; const u32x4 v=*(const u32x4*)(stg+row*64+ch*8); ATTN_STORE16(Ow+(long)row*OP+ch*8,v);} }
  asm volatile("s_waitcnt lgkmcnt(0)\n\ts_barrier":::"memory");
  #undef DMA_K
  #undef DMA_V
  #undef CMASK
  #undef START
  #undef RESC
  #undef ROT
}
constexpr int ATTN_LDS_BYTES=LDS_BYTES;
struct AttnTensors { const bf16* Q; const bf16* K; const bf16* V; bf16* O; };
struct AttnUnit { int bh; int qb; };
struct StaticOrder {
  int vcu;
  __device__ __forceinline__ explicit StaticOrder(int grid,int block):vcu((block%8)*(grid/8)+block/8){}
  __device__ __forceinline__ bool next(int i,AttnUnit&u)const{ if(i>=8)return false; const int s=vcu&3,g=i>>1; u.bh=vcu>>2; u.qb=(i&1)?(8*g+7-s):(8*g+s); return true; }
  __device__ __forceinline__ void a_ready(const AttnUnit&)const{}
  __device__ __forceinline__ void done(const AttnUnit&)const{}
};
template<class Sched,int THRL=8> __device__ __forceinline__ void attn_phase(char*lds,const AttnTensors&T,const Sched&S,const int wid_in){
  AttnUnit u;
  for(int i=0;S.next(i,u);++i){ S.a_ready(u); const int b=u.bh>>4,vh=u.bh&15,h=vh>>2,c=(vh>>1)&1,vf=vh&1;
    attn_unit<THRL>(b,(h*2+c)*64,h*128+vf*64,vh*64,u.qb,T.Q,T.K,T.V,T.O,lds,wid_in); S.done(u); }
}
#undef SBAR
#undef WAIT_BAR
}
#define GAS __attribute__((address_space(1)))
#define LAS __attribute__((address_space(3)))
typedef unsigned short bf16;
typedef unsigned v4u __attribute__((ext_vector_type(4)));
typedef float f32x4 __attribute__((ext_vector_type(4)));
typedef short bf16x8 __attribute__((ext_vector_type(8)));
typedef GAS unsigned gu32;
typedef GAS unsigned long long gu64;
#define RLX_AGENT __ATOMIC_RELAXED, __HIP_MEMORY_SCOPE_AGENT
#define LDS_WAIT() asm volatile("s_waitcnt lgkmcnt(0)" ::: "memory")
#define VM_WAIT() asm volatile("s_waitcnt vmcnt(0)" ::: "memory")
__device__ __forceinline__ unsigned long long rt() { return __builtin_amdgcn_s_memrealtime(); }
__device__ __forceinline__ unsigned f2bf(float f) { unsigned u = __builtin_bit_cast(unsigned, f); return (u + 0x7fffu + ((u >> 16) & 1u)) >> 16; }
__device__ __forceinline__ unsigned pk2(float lo, float hi) { return f2bf(lo) | (f2bf(hi) << 16); }

#define XB_TMO      128
#define XB_XCNT(j)  (256  + 64 * (j))
#define XB_XSUB(j)  (1280 + 64 * (j))
#define XB_XGEN(j)  (2304 + 64 * (j))
#define XB_TOP      3328
#define XB_TOPGEN   3392
#define XCD_BAR_WORDS 3456
#define XB_SPIN_CAP (MK_CHECK ? (1u << 27) : (1u << 18))

__device__ __forceinline__ unsigned xb_ld(unsigned* p)              { return __hip_atomic_load(p, __ATOMIC_RELAXED, __HIP_MEMORY_SCOPE_AGENT); }
__device__ __forceinline__ unsigned xb_add(unsigned* p, unsigned v) { return __hip_atomic_fetch_add(p, v, __ATOMIC_RELAXED, __HIP_MEMORY_SCOPE_AGENT); }
__device__ __forceinline__ unsigned xb_xcc_id() { return (unsigned)__builtin_amdgcn_s_getreg((3 << 11) | 20) & 0xFu; }
#define XB_SPIN(cond, bar) do { unsigned _sp = 0; while (cond) { __builtin_amdgcn_s_sleep(1); \
    if ((++_sp & 255u) == 0u) { if (xb_ld(&(bar)[XB_TMO])) break; if (_sp > XB_SPIN_CAP) { atomicAdd(&(bar)[XB_TMO], 1u); break; } } } } while (0)

struct XcdBarrier {
    unsigned* bar; unsigned x; int wave;
    volatile LAS unsigned* st;
};

__device__ __forceinline__ XcdBarrier xcd_barrier_post(unsigned* bar, volatile LAS unsigned* st, int wave) {
    XcdBarrier b; b.bar = bar; b.x = xb_xcc_id(); b.st = st; b.wave = wave;
    if (wave == 0 && lane_now() == 0) (void)xb_add(&bar[XB_XCNT(b.x)], 1u);
    return b;
}
__device__ __forceinline__ void xcd_barrier_complete(unsigned* bar, unsigned x, unsigned& nloc, unsigned& nx) {
    const unsigned G = gridDim.x * gridDim.y * gridDim.z;
    unsigned sum, cnt, mine, sp = 0u;
    for (;;) {
        sum = 0u; cnt = 0u; mine = 0u;
#pragma unroll
        for (unsigned j = 0; j < 16; ++j) { const unsigned c = xb_ld(&bar[XB_XCNT(j)]); sum += c; cnt += (c > 0u) ? 1u : 0u; mine = (j == x) ? c : mine; }
        if (sum == G) break;
        __builtin_amdgcn_s_sleep(1);
        if ((++sp & 255u) == 0u) { if (xb_ld(&bar[XB_TMO])) break; if (sp > XB_SPIN_CAP) { atomicAdd(&bar[XB_TMO], 1u); break; } }
    }
    nloc = mine > 0u ? mine : 1u; nx = cnt > 0u ? cnt : 1u;
}

__device__ __forceinline__ void xcd_barrier(const XcdBarrier& b) {
    asm volatile("s_waitcnt vmcnt(0)" ::: "memory");
    __syncthreads();
    if (b.wave == 0 && lane_now() == 0) {
        unsigned* bar = b.bar; unsigned bx_ = b.x; asm volatile("" : "+s"(bx_));
        __builtin_amdgcn_s_waitcnt(0);
        unsigned nloc = b.st[0], nx = b.st[1];
        if (nloc == 0u) { xcd_barrier_complete(bar, bx_, nloc, nx); b.st[0] = nloc; b.st[1] = nx; }
        const unsigned old = xb_add(&bar[XB_XSUB(bx_)], 1u);
        const unsigned gen = old / nloc;
        if (old + 1u == (gen + 1u) * nloc) {
            __builtin_amdgcn_fence(__ATOMIC_RELEASE, "agent");
            asm volatile("s_waitcnt vmcnt(0)" ::: "memory");
            const unsigned og = xb_add(&bar[XB_TOP], 1u);
            const unsigned tg = og / nx;
            if (og + 1u == (tg + 1u) * nx) xb_add(&bar[XB_TOPGEN], 1u);
            else XB_SPIN(xb_ld(&bar[XB_TOPGEN]) == tg, bar);
            __builtin_amdgcn_fence(__ATOMIC_ACQUIRE, "agent");
            xb_add(&bar[XB_XGEN(bx_)], 1u);
            asm volatile("s_waitcnt vmcnt(0)" ::: "memory");
        } else {
            XB_SPIN(xb_ld(&bar[XB_XGEN(bx_)]) == gen, bar);
            __builtin_amdgcn_fence(__ATOMIC_ACQUIRE, "agent");
            asm volatile("s_waitcnt vmcnt(0)" ::: "memory");
        }
    }
    __syncthreads();
}
typedef unsigned u32x2g __attribute__((ext_vector_type(2)));
constexpr size_t MiB = 1u << 20;
constexpr size_t WS_CTL = 0, CTL_ZERO_BYTES = 1 * MiB;
constexpr size_t WS_ROPE = 1 * MiB;
constexpr size_t WS_TOKSLOT = WS_ROPE + 512 * 1024;
constexpr size_t WS_GATEW = 2 * MiB;
constexpr size_t WS_DEC = 2 * MiB + 512 * 1024;
constexpr size_t WS_KVS = 4 * MiB;
constexpr size_t WS_LA = 20 * MiB;
constexpr size_t WS_WIN = 36 * MiB, WS_WOUT = 60 * MiB, WS_WPG = 68 * MiB, WS_WPU = 76 * MiB, WS_WFGU = 78 * MiB, WS_WFDN = 100 * MiB, WS_WMGU = 112 * MiB, WS_WMDN = 336 * MiB;
constexpr size_t WS_PB = 448 * MiB, WS_HN = 512 * MiB, WS_ZQ = 576 * MiB, WS_ZK = 608 * MiB, WS_ZV = 640 * MiB, WS_ZU = 672 * MiB, WS_ZG = 688 * MiB;
constexpr size_t WS_OV = 736 * MiB, WS_YC = 800 * MiB, WS_UP = 864 * MiB, WS_ACT = 928 * MiB, WS_XG = 1390 * MiB, WS_Y2 = 1522 * MiB, WS_END = 1654 * MiB;
static_assert(WS_ACT + (size_t)MOE_ROWS * D_FFE * 2 <= WS_XG && WS_XG + (size_t)MOE_ROWS * 1024 * 2 <= WS_Y2 && WS_Y2 + (size_t)MOE_ROWS * 1024 * 2 <= WS_END, "d_ws map");
constexpr size_t SZ_WIN = (size_t)NZ * 1024 * 2, SZ_SQ = (size_t)1024 * 1024 * 2, SZ_WPU = (size_t)1024 * 256 * 2, SZ_WFGU = (size_t)2 * D_FF * 1024 * 2, SZ_WFDN = (size_t)1024 * D_FF * 2,
                 SZ_WMGU = (size_t)2 * D_FFE * 1024 * 2, SZ_WMDN = (size_t)1024 * D_FFE * 2;
constexpr int CW_TMO = 0, CW_BAR = 4096, CW_CUR = 8192;

constexpr int RING_OFF = 0, RING_BYTES = 131072;
constexpr int LDSCTL_OFF = RING_BYTES, MISC_OFF = LDSCTL_OFF + 320;
constexpr int LDS_BYTES = 147456;

struct Cx { LAS unsigned char* lds; int tid, lane, wave, vcu, G; };
__device__ __forceinline__ Cx mkcx(LAS unsigned char* lds, int wave) { Cx cx; cx.lds = lds; cx.lane = lane_now(); cx.wave = wave; cx.tid = wave * 64 + cx.lane;
    cx.G = gridDim.x; { const int bx = blockIdx.x; cx.vcu = (cx.G % 8 == 0) ? (bx % 8) * (cx.G / 8) + bx / 8 : bx; } return cx; }
__device__ __forceinline__ unsigned long long ldptr(const LAS unsigned long long* PT, int i) { const unsigned long long v = PT[i];
    return ((unsigned long long)(unsigned)__builtin_amdgcn_readfirstlane((int)(unsigned)(v >> 32)) << 32) | (unsigned)__builtin_amdgcn_readfirstlane((int)(unsigned)v); }

template <int M> __device__ __forceinline__ float swz_xor(float v) { return __builtin_bit_cast(float, __builtin_amdgcn_ds_swizzle(__builtin_bit_cast(int, v), (M << 10) | 0x1f)); }
__device__ __forceinline__ float sum16(float v) { v += swz_xor<1>(v); v += swz_xor<2>(v); v += swz_xor<4>(v); v += swz_xor<8>(v); return v; }
__device__ __forceinline__ float wave_sum(float v) {
    v = sum16(v); const int iv = __builtin_bit_cast(int, v);
    const float a = __builtin_bit_cast(float, __builtin_amdgcn_readlane(iv, 0)), b = __builtin_bit_cast(float, __builtin_amdgcn_readlane(iv, 16)),
                c = __builtin_bit_cast(float, __builtin_amdgcn_readlane(iv, 32)), d = __builtin_bit_cast(float, __builtin_amdgcn_readlane(iv, 48));
    return (a + b) + (c + d);
}
__device__ __forceinline__ float b2f(unsigned short b) { return __builtin_bit_cast(float, (unsigned)b << 16); }
__device__ __forceinline__ float lo2f(unsigned w) { return __builtin_bit_cast(float, w << 16); }
__device__ __forceinline__ float hi2f(unsigned w) { return __builtin_bit_cast(float, w & 0xffff0000u); }
__device__ __forceinline__ float sigm(float x) { return 1.0f / (1.0f + __expf(-x)); }

__device__ __forceinline__ int col_gu(int n, int F) { const int t = n >> 8, j = n & 255; return (j >> 7) * F + t * 128 + (j & 127); }
__device__ __forceinline__ int col_win(int n) { const int t = n >> 8, j = n & 255;
    if (t < 2) return (j >> 7) * 256 + t * 128 + (j & 127);
    if (t < 6) { const int sec = (t - 2) >> 1, w = ((t - 2) & 1) * 256 + j, comp = w >> 6, d = w & 63; int od = d; if (d >= 4 && d < 8) od = d + 4; else if (d >= 8 && d < 12) od = d - 4; return 512 + sec * 512 + comp * 64 + od; }
    if (t < 8) return 1536 + (t - 6) * 256 + j;
    return 2048 + (t - 8) * 256 + j; }
template <int MODE> __device__ __forceinline__ void tr_item(const float* W, int K, int Nsrc, int F, const float* gk, bf16* WT, LAS float* scr, int item, int nblk, int lane) {
    const int kb = item / nblk, nb = item % nblk, k0 = 64 * kb, n0 = 32 * nb; const int nd = n0 + (lane & 31);
    const int sc = MODE == 0 ? nd : (MODE == 1 ? col_gu(nd, F) : col_win(nd));
#pragma unroll 8
    for (int i = 0; i < 32; ++i) { const int kk = 2 * i + (lane >> 5); float w = W[(size_t)(k0 + kk) * Nsrc + sc]; if (gk) w *= gk[k0 + kk]; scr[kk * 33 + (lane & 31)] = w; }
    LDS_WAIT(); asm volatile("" ::: "memory");
    const int c = lane & 7;
#pragma unroll
    for (int j = 0; j < 4; ++j) { const int n = (lane >> 3) + 8 * j; const LAS float* s = scr + (8 * c) * 33 + n;
        v4u o; o.x = pk2(s[0 * 33], s[1 * 33]); o.y = pk2(s[2 * 33], s[3 * 33]); o.z = pk2(s[4 * 33], s[5 * 33]); o.w = pk2(s[6 * 33], s[7 * 33]);
        *(GAS v4u*)(WT + (size_t)(n0 + n) * K + k0 + 8 * c) = o; }
    LDS_WAIT(); asm volatile("" ::: "memory");
}
__device__ __forceinline__ void gate_item(const float* Win, const float* wg2, const float* gk, bf16* WT, LAS float* scr, int item, int lane) {
    const int kb = item >> 3, jb = item & 7, k0 = 64 * kb, j0 = 32 * jb, k = k0 + lane;
    float wr[16];
#pragma unroll
    for (int q = 0; q < 4; ++q) { const f32x4 x = *(const f32x4*)(Win + (size_t)k * D_IN + 2816 + 4 * q); wr[4 * q] = x[0]; wr[4 * q + 1] = x[1]; wr[4 * q + 2] = x[2]; wr[4 * q + 3] = x[3]; }
    const float gkk = gk[k];
    for (int jj = 0; jj < 32; ++jj) { const int j = j0 + jj; float s = 0.f;
        if (j < 128) {
#pragma unroll
            for (int r = 0; r < 16; ++r) s += wr[r] * wg2[r * 128 + j];
            s *= gkk; }
        scr[lane * 33 + jj] = s; }
    LDS_WAIT(); asm volatile("" ::: "memory");
    const int c = lane & 7;
#pragma unroll
    for (int j = 0; j < 4; ++j) { const int n = (lane >> 3) + 8 * j; const LAS float* s = scr + (8 * c) * 33 + n;
        v4u o; o.x = pk2(s[0 * 33], s[1 * 33]); o.y = pk2(s[2 * 33], s[3 * 33]); o.z = pk2(s[4 * 33], s[5 * 33]); o.w = pk2(s[6 * 33], s[7 * 33]);
        *(GAS v4u*)(WT + (size_t)(2816 + j0 + n) * 1024 + k0 + 8 * c) = o; }
    LDS_WAIT(); asm volatile("" ::: "memory");
}
#define JOB_LOOP(n_items, body) do { const int _n = (n_items); for (int it = (int)(((long)gw - jbase % NGW + NGW) % NGW); it < _n; it += NGW) { body; } jbase += _n; } while (0)
__device__ __forceinline__ void p0_prologue(const Cx& cx, const LAS unsigned long long* PT, unsigned char* ws) {
    LAS float* scr = (LAS float*)(cx.lds + RING_OFF + cx.wave * 16384);
    const int gw = cx.vcu * 8 + cx.wave, NGW = cx.G * 8, lane = cx.lane; long jbase = 0;
#define PIN(i) ((const float*)(const GAS float*)ldptr(PT, (i)))
    const float *norm_mix_g = PIN(2), *w_in = PIN(3), *gla_w_gate2 = PIN(10), *w_out = PIN(13), *norm_ffn_g = PIN(14), *ffn_w_gu = PIN(15), *ffn_w_down = PIN(16), *moe_w_gu = PIN(18), *moe_w_down = PIN(19),
                *ple_w_up = PIN(20), *ple_w_gate = PIN(21), *ple_norm_g = PIN(22);
    for (int m = 0; m < 2; ++m) for (int e = 0; e < NEXP; ++e) {
        const float* Wg = moe_w_gu + (size_t)(m * NEXP + e) * 1024 * (2 * D_FFE); bf16* Dg = (bf16*)(ws + WS_WMGU + (size_t)(m * NEXP + e) * SZ_WMGU);
        JOB_LOOP(16 * (2 * D_FFE / 32), tr_item<1>(Wg, 1024, 2 * D_FFE, D_FFE, norm_ffn_g + (2 * m + 1) * 1024, Dg, scr, it, 2 * D_FFE / 32, lane));
        const float* Wd = moe_w_down + (size_t)(m * NEXP + e) * D_FFE * 1024; bf16* Dd = (bf16*)(ws + WS_WMDN + (size_t)(m * NEXP + e) * SZ_WMDN);
        JOB_LOOP((D_FFE / 64) * 32, tr_item<0>(Wd, D_FFE, 1024, 0, nullptr, Dd, scr, it, 32, lane));
    }
    for (int d = 0; d < 2; ++d) {
        JOB_LOOP(16 * (2 * D_FF / 32), tr_item<1>(ffn_w_gu + (size_t)d * 1024 * 2 * D_FF, 1024, 2 * D_FF, D_FF, norm_ffn_g + (2 * d) * 1024, (bf16*)(ws + WS_WFGU + d * SZ_WFGU), scr, it, 2 * D_FF / 32, lane));
        JOB_LOOP((D_FF / 64) * 32, tr_item<0>(ffn_w_down + (size_t)d * D_FF * 1024, D_FF, 1024, 0, nullptr, (bf16*)(ws + WS_WFDN + d * SZ_WFDN), scr, it, 32, lane));
    }
    for (int li = 0; li < DEPTH; ++li) {
        JOB_LOOP(16 * (2816 / 32), tr_item<2>(w_in + (size_t)li * 1024 * D_IN, 1024, D_IN, 0, norm_mix_g + li * 1024, (bf16*)(ws + WS_WIN + li * SZ_WIN), scr, it, 2816 / 32, lane));
        JOB_LOOP(16 * 8, gate_item(w_in + (size_t)li * 1024 * D_IN, gla_w_gate2 + li * 16 * 128, norm_mix_g + li * 1024, (bf16*)(ws + WS_WIN + li * SZ_WIN), scr, it, lane));
        JOB_LOOP(16 * 32, tr_item<0>(w_out + (size_t)li * 1024 * 1024, 1024, 1024, 0, nullptr, (bf16*)(ws + WS_WOUT + li * SZ_SQ), scr, it, 32, lane));
        JOB_LOOP(16 * 32, tr_item<0>(ple_w_gate + (size_t)li * 1024 * 1024, 1024, 1024, 0, ple_norm_g + li * 1024, (bf16*)(ws + WS_WPG + li * SZ_SQ), scr, it, 32, lane));
        JOB_LOOP(4 * 32, tr_item<0>(ple_w_up + (size_t)li * 256 * 1024, 256, 1024, 0, nullptr, (bf16*)(ws + WS_WPU + li * SZ_WPU), scr, it, 32, lane));
    }
    { const float* p = PIN(1); bf16* pb = (bf16*)(ws + WS_PB); const long n8 = (long)DEPTH * T_TOK * PLE_DIM / 8, NT = (long)cx.G * 512;
      for (long i = (long)cx.vcu * 512 + cx.tid; i < n8; i += NT) { const f32x4 a = *(const f32x4*)(p + i * 8), b = *(const f32x4*)(p + i * 8 + 4);
          v4u o; o.x = pk2(a[0], a[1]); o.y = pk2(a[2], a[3]); o.z = pk2(b[0], b[1]); o.w = pk2(b[2], b[3]); *(v4u*)(pb + i * 8) = o; } }
    { float* rope = (float*)(ws + WS_ROPE); const int idx = cx.vcu * 512 + cx.tid;
      if (idx < SEQ * 8) { const int pos = idx >> 3, j = idx & 7;
          const double invf[8] = {1.0, 0.19391010807943456, 0.037601130015015855, 0.0072912391843014545, 0.001414213562373095, 0.00027423030417878515, 5.317602791587768e-05, 1.031136931769684e-05};
          double f = invf[0];
#pragma unroll
          for (int q = 1; q < 8; ++q) f = (j == q) ? invf[q] : f;
          const double rev = (double)pos * f * 0.15915494309189535; const float fr = (float)(rev - rint(rev));
          rope[idx * 2] = __builtin_amdgcn_cosf(fr); rope[idx * 2 + 1] = __builtin_amdgcn_sinf(fr); } }
}

__device__ __forceinline__ void norm_rows(const Cx& cx, const float* src, bf16* dst) {
    const int gw = cx.vcu * 8 + cx.wave, NGW = cx.G * 8;
    for (int m = gw; m < T_TOK; m += NGW) {
        const GAS f32x4* xr = (const GAS f32x4*)(src + (size_t)m * 1024) + cx.lane; f32x4 v[4]; float s = 0.f;
#pragma unroll
        for (int j = 0; j < 4; ++j) { v[j] = xr[64 * j]; s += (v[j].x * v[j].x + v[j].y * v[j].y) + (v[j].z * v[j].z + v[j].w * v[j].w); }
        const float rs = 1.0f / sqrtf(wave_sum(s) * (1.f / 1024.f) + EPS);
        GAS unsigned long long* o8 = (GAS unsigned long long*)(dst + (size_t)m * 1024) + cx.lane;
#pragma unroll
        for (int j = 0; j < 4; ++j) o8[64 * j] = (unsigned long long)pk2(v[j].x * rs, v[j].y * rs) | ((unsigned long long)pk2(v[j].z * rs, v[j].w * rs) << 32);
    }
}
__device__ __forceinline__ void final_norm_rows(const Cx& cx, float* h, const float* g) {
    const int gw = cx.vcu * 8 + cx.wave, NGW = cx.G * 8;
    f32x4 gv[4];
#pragma unroll
    for (int j = 0; j < 4; ++j) gv[j] = ((const f32x4*)g)[64 * j + cx.lane];
    for (int m = gw; m < T_TOK; m += NGW) {
        GAS f32x4* xr = (GAS f32x4*)(h + (size_t)m * 1024) + cx.lane; f32x4 v[4]; float s = 0.f;
#pragma unroll
        for (int j = 0; j < 4; ++j) { v[j] = xr[64 * j]; s += (v[j].x * v[j].x + v[j].y * v[j].y) + (v[j].z * v[j].z + v[j].w * v[j].w); }
        const float rs = 1.0f / sqrtf(wave_sum(s) * (1.f / 1024.f) + EPS);
#pragma unroll
        for (int j = 0; j < 4; ++j) xr[64 * j] = v[j] * rs * gv[j];
    }
}
__device__ __forceinline__ void router_rows(const Cx& cx, const float* h, bf16* hn, const float* g, const float* R, gu32* cursor, int* tokslot, float* gatew) {
    LAS float* RG = (LAS float*)cx.lds;
    LAS int* lcnt = (LAS int*)(cx.lds + 32768); LAS int* gbase = lcnt + 8; LAS int* rec = lcnt + 16; LAS float* wts = (LAS float*)(rec + 512);
    for (int idx = cx.tid; idx < 8192; idx += 512) { const int ji = idx >> 9, ln = (idx >> 3) & 63, e = idx & 7, k = 256 * (ji >> 2) + 4 * ln + (ji & 3); RG[idx] = g[k] * R[k * 8 + e]; }
    if (cx.tid < 8) lcnt[cx.tid] = 0;
    __syncthreads();
    for (int blk = cx.vcu; blk < T_TOK / 128; blk += cx.G) {
        for (int i = 0; i < 16; ++i) {
            const int rs_ = cx.wave * 16 + i, m = blk * 128 + rs_;
            const GAS f32x4* xr = (const GAS f32x4*)(h + (size_t)m * 1024) + cx.lane; f32x4 v[4]; float s = 0.f;
#pragma unroll
            for (int j = 0; j < 4; ++j) { v[j] = xr[64 * j]; s += (v[j].x * v[j].x + v[j].y * v[j].y) + (v[j].z * v[j].z + v[j].w * v[j].w); }
            const float rs = 1.0f / sqrtf(wave_sum(s) * (1.f / 1024.f) + EPS);
            GAS unsigned long long* o8 = (GAS unsigned long long*)(hn + (size_t)m * 1024) + cx.lane;
#pragma unroll
            for (int j = 0; j < 4; ++j) o8[64 * j] = (unsigned long long)pk2(v[j].x * rs, v[j].y * rs) | ((unsigned long long)pk2(v[j].z * rs, v[j].w * rs) << 32);
            float lg[8];
#pragma unroll
            for (int e = 0; e < 8; ++e) lg[e] = 0.f;
#pragma unroll
            for (int j = 0; j < 4; ++j)
#pragma unroll
                for (int q = 0; q < 4; ++q) { const LAS f32x4* rp = (const LAS f32x4*)(RG + ((j * 4 + q) * 64 + cx.lane) * 8); const f32x4 r0 = rp[0], r1 = rp[1]; const float x = v[j][q];
                    lg[0] += x * r0[0]; lg[1] += x * r0[1]; lg[2] += x * r0[2]; lg[3] += x * r0[3]; lg[4] += x * r1[0]; lg[5] += x * r1[1]; lg[6] += x * r1[2]; lg[7] += x * r1[3]; }
#pragma unroll
            for (int e = 0; e < 8; ++e) lg[e] = wave_sum(lg[e]) * rs;
            int e0 = 0; float v0 = lg[0];
#pragma unroll
            for (int e = 1; e < 8; ++e) if (lg[e] > v0) { v0 = lg[e]; e0 = e; }
            int e1 = -1; float v1 = -INFINITY;
#pragma unroll
            for (int e = 0; e < 8; ++e) if (e != e0 && lg[e] > v1) { v1 = lg[e]; e1 = e; }
            if (cx.lane == 0) { const float t = __expf(v1 - v0), w0 = 1.0f / (1.0f + t);
                const int r0 = __hip_atomic_fetch_add(lcnt + e0, 1, __ATOMIC_RELAXED, __HIP_MEMORY_SCOPE_WORKGROUP), r1 = __hip_atomic_fetch_add(lcnt + e1, 1, __ATOMIC_RELAXED, __HIP_MEMORY_SCOPE_WORKGROUP);
                rec[rs_ * 4] = e0; rec[rs_ * 4 + 1] = r0; rec[rs_ * 4 + 2] = e1; rec[rs_ * 4 + 3] = r1; wts[rs_ * 2] = w0; wts[rs_ * 2 + 1] = t * w0; }
        }
        __syncthreads();
        if (cx.tid < 8) gbase[cx.tid] = (int)__hip_atomic_fetch_add(cursor + cx.tid * 64, (unsigned)lcnt[cx.tid], __ATOMIC_RELAXED, __HIP_MEMORY_SCOPE_AGENT);
        __syncthreads();
        if (cx.tid < 128) { const int m = blk * 128 + cx.tid; const int e0 = rec[cx.tid * 4], r0 = rec[cx.tid * 4 + 1], e1 = rec[cx.tid * 4 + 2], r1 = rec[cx.tid * 4 + 3];
            *(int4*)(tokslot + (size_t)m * 4) = make_int4(e0, gbase[e0] + r0, e1, gbase[e1] + r1); *(float2*)(gatew + (size_t)m * 2) = make_float2(wts[cx.tid * 2], wts[cx.tid * 2 + 1]); }
        __syncthreads();
        if (cx.tid < 8) lcnt[cx.tid] = 0;
        __syncthreads();
    }
}
__device__ __forceinline__ void moe_prefix(const Cx& cx, gu32* cursor, LAS int* tb) {
    if (cx.tid == 0) { int t = 0;
        for (int e = 0; e < NEXP; ++e) { tb[e] = t; t += ((int)__hip_atomic_load(cursor + e * 64, RLX_AGENT) + 255) >> 8; }
        tb[NEXP] = t; }
    __syncthreads();
}
__device__ __forceinline__ void dispatch_rows(const Cx& cx, const bf16* hn, bf16* xg, const int* tokslot, const LAS int* tb) {
    const int gw = cx.vcu * 8 + cx.wave, NGW = cx.G * 8;
    for (int m = gw; m < T_TOK; m += NGW) {
        const int4 ts = *(const int4*)(tokslot + (size_t)m * 4);
        const size_t d0 = (size_t)(tb[ts.x] * 256 + ts.y), d1 = (size_t)(tb[ts.z] * 256 + ts.w);
        const v4u a = *(const v4u*)(hn + (size_t)m * 1024 + cx.lane * 8), b = *(const v4u*)(hn + (size_t)m * 1024 + 512 + cx.lane * 8);
        *(v4u*)(xg + d0 * 1024 + cx.lane * 8) = a; *(v4u*)(xg + d0 * 1024 + 512 + cx.lane * 8) = b;
        *(v4u*)(xg + d1 * 1024 + cx.lane * 8) = a; *(v4u*)(xg + d1 * 1024 + 512 + cx.lane * 8) = b;
    }
}
__device__ __forceinline__ void combine_norm_rows(const Cx& cx, float* h, bf16* hn, const bf16* y2, const int* tokslot, const float* gatew, const LAS int* tb) {
    const int gw = cx.vcu * 8 + cx.wave, NGW = cx.G * 8;
    for (int m = gw; m < T_TOK; m += NGW) {
        const int4 ts = *(const int4*)(tokslot + (size_t)m * 4); const float2 gwt = *(const float2*)(gatew + (size_t)m * 2);
        const size_t d0 = (size_t)(tb[ts.x] * 256 + ts.y), d1 = (size_t)(tb[ts.z] * 256 + ts.w);
        GAS f32x4* xr = (GAS f32x4*)(h + (size_t)m * 1024) + cx.lane;
        const GAS u32x2g* y0 = (const GAS u32x2g*)(y2 + d0 * 1024) + cx.lane; const GAS u32x2g* y1 = (const GAS u32x2g*)(y2 + d1 * 1024) + cx.lane;
        f32x4 v[4]; float s = 0.f;
#pragma unroll
        for (int j = 0; j < 4; ++j) { v[j] = xr[64 * j]; const u32x2g a = y0[64 * j], b = y1[64 * j];
            v[j].x += gwt.x * lo2f(a.x) + gwt.y * lo2f(b.x); v[j].y += gwt.x * hi2f(a.x) + gwt.y * hi2f(b.x); v[j].z += gwt.x * lo2f(a.y) + gwt.y * lo2f(b.y); v[j].w += gwt.x * hi2f(a.y) + gwt.y * hi2f(b.y);
            xr[64 * j] = v[j]; s += (v[j].x * v[j].x + v[j].y * v[j].y) + (v[j].z * v[j].z + v[j].w * v[j].w); }
        const float rs = 1.0f / sqrtf(wave_sum(s) * (1.f / 1024.f) + EPS);
        GAS unsigned long long* o8 = (GAS unsigned long long*)(hn + (size_t)m * 1024) + cx.lane;
#pragma unroll
        for (int j = 0; j < 4; ++j) o8[64 * j] = (unsigned long long)pk2(v[j].x * rs, v[j].y * rs) | ((unsigned long long)pk2(v[j].z * rs, v[j].w * rs) << 32);
    }
}
__device__ __forceinline__ void diff_combine_rows(const Cx& cx, const bf16* ov, bf16* yc, const float* lp, const float* subg, float lam_init) {
    const int gw = cx.vcu * 8 + cx.wave, NGW = cx.G * 8, hh = cx.lane >> 4, dc = cx.lane & 15;
    const float s01 = wave_sum(lp[cx.lane] * lp[64 + cx.lane]), s23 = wave_sum(lp[128 + cx.lane] * lp[192 + cx.lane]);
    const float lam = expf(s01) - expf(s23) + lam_init, post = 1.0f - lam_init;
    const f32x4 g0 = *(const f32x4*)(subg + dc * 8), g1 = *(const f32x4*)(subg + dc * 8 + 4);
    for (int m = gw; m < T_TOK; m += NGW) {
        const v4u a = *(const v4u*)(ov + (size_t)m * 1024 + hh * 256 + dc * 8), b = *(const v4u*)(ov + (size_t)m * 1024 + hh * 256 + 128 + dc * 8);
        float y[8];
        y[0] = lo2f(a.x) - lam * lo2f(b.x); y[1] = hi2f(a.x) - lam * hi2f(b.x); y[2] = lo2f(a.y) - lam * lo2f(b.y); y[3] = hi2f(a.y) - lam * hi2f(b.y);
        y[4] = lo2f(a.z) - lam * lo2f(b.z); y[5] = hi2f(a.z) - lam * hi2f(b.z); y[6] = lo2f(a.w) - lam * lo2f(b.w); y[7] = hi2f(a.w) - lam * hi2f(b.w);
        float s = 0.f;
#pragma unroll
        for (int i = 0; i < 8; ++i) s += y[i] * y[i];
        s = sum16(s);
        const float rs = post / sqrtf(s * (1.f / 128.f) + EPS);
        v4u o; o.x = pk2(y[0] * rs * g0[0], y[1] * rs * g0[1]); o.y = pk2(y[2] * rs * g0[2], y[3] * rs * g0[3]); o.z = pk2(y[4] * rs * g1[0], y[5] * rs * g1[1]); o.w = pk2(y[6] * rs * g1[2], y[7] * rs * g1[3]);
        *(v4u*)(yc + (size_t)m * 1024 + 256 + hh * 128 + dc * 8) = o;
    }
}

__device__ __forceinline__ void conv_units(const Cx& cx, const bf16* zu, bf16* yc, const float* cw, const float* cb, const float* lng, const float* lnb) {
    LAS unsigned short* ub = (LAS unsigned short*)cx.lds;
    LAS float* cbuf = (LAS float*)(cx.lds + 49152);
    const int c = cx.tid & 255, th = cx.tid >> 8;
    float w[31];
#pragma unroll
    for (int j = 0; j < 31; ++j) w[j] = cw[j * 256 + c];
    const float bias = cb[c];
    const f32x4 lg = *(const f32x4*)(lng + 4 * cx.lane), lb = *(const f32x4*)(lnb + 4 * cx.lane);
    for (int unit = cx.vcu; unit < T_TOK / 64; unit += cx.G) {
        const int t0 = unit * 64, tin = t0 & (SEQ - 1);
        for (int ch = cx.tid; ch < 94 * 32; ch += 512) { const int r = ch >> 5, cc = ch & 31; v4u x = {0u, 0u, 0u, 0u};
            if (tin - 30 + r >= 0) x = *(const v4u*)(zu + (size_t)(t0 - 30 + r) * 256 + cc * 8);
            *(LAS v4u*)(ub + r * 256 + cc * 8) = x; }
        __syncthreads();
#pragma unroll 1
        for (int ob = 0; ob < 4; ++ob) {
            float xw[38];
#pragma unroll
            for (int i = 0; i < 38; ++i) xw[i] = b2f(ub[(th * 32 + ob * 8 + i) * 256 + c]);
#pragma unroll
            for (int o = 0; o < 8; ++o) { float a = bias;
#pragma unroll
                for (int j = 0; j < 31; ++j) a += w[j] * xw[o + j];
                cbuf[(th * 32 + ob * 8 + o) * 256 + c] = a; }
        }
        __syncthreads();
#pragma unroll
        for (int i = 0; i < 8; ++i) { const int tok = cx.wave * 8 + i; const f32x4 x = *(const LAS f32x4*)(cbuf + tok * 256 + 4 * cx.lane);
            const float mean = wave_sum((x[0] + x[1]) + (x[2] + x[3])) * (1.f / 256.f); const f32x4 d = x - mean;
            const float var = wave_sum((d[0] * d[0] + d[1] * d[1]) + (d[2] * d[2] + d[3] * d[3])) * (1.f / 256.f); const float rstd = 1.0f / sqrtf(var + EPS);
            f32x4 y = d * rstd * lg + lb;
#pragma unroll
            for (int q = 0; q < 4; ++q) y[q] = y[q] * sigm(y[q]);
            *(unsigned long long*)(yc + (size_t)(t0 + tok) * 1024 + 4 * cx.lane) = (unsigned long long)pk2(y[0], y[1]) | ((unsigned long long)pk2(y[2], y[3]) << 32); }
        __syncthreads();
    }
}

__device__ __forceinline__ void gla_pass1(const Cx& cx, const bf16* zg, const float* la, float* kvs, float* dec) {
    LAS float* kw = (LAS float*)(cx.lds + cx.wave * 16384);
    LAS unsigned short* vs = (LAS unsigned short*)(cx.lds + cx.wave * 16384 + 8192);
    const int lane = cx.lane, k = lane & 31, half = lane >> 5;
    for (int task = cx.vcu * 8 + cx.wave; task < 2048; task += cx.G * 8) {
        const int hd = task & 3, chunk = task >> 2; const size_t t0 = (size_t)chunk * 64; const int bh = (chunk >> 7) * 4 + hd, n = chunk & 127;
        float cum[32]; float run = 0.f;
#pragma unroll
        for (int c = 0; c < 32; ++c) { run += la[(t0 + half * 32 + c) * 128 + hd * 32 + k]; cum[c] = run; }
        const float tot0 = __shfl(run, k);
        if (half) {
#pragma unroll
            for (int c = 0; c < 32; ++c) cum[c] += tot0; }
        const float tot = __shfl(cum[31], 32 + k);
#pragma unroll
        for (int c = 0; c < 32; ++c) { const float kk = b2f(zg[(t0 + half * 32 + c) * 768 + 128 + hd * 32 + k]); kw[(half * 32 + c) * 32 + k] = kk * __expf(tot - cum[c]); }
#pragma unroll
        for (int it = 0; it < 8; ++it) { const int row = it * 8 + (lane >> 3); const v4u x = *(const v4u*)(zg + (t0 + row) * 768 + 256 + hd * 64 + (lane & 7) * 8); *(LAS v4u*)(vs + row * 64 + (lane & 7) * 8) = x; }
        LDS_WAIT(); asm volatile("" ::: "memory");
        float acc[32];
#pragma unroll
        for (int q = 0; q < 32; ++q) acc[q] = 0.f;
        for (int c = 0; c < 64; ++c) { const float vv = b2f(vs[c * 64 + lane]);
#pragma unroll
            for (int q = 0; q < 8; ++q) { const f32x4 wv = *(const LAS f32x4*)(kw + c * 32 + q * 4); acc[4 * q] += wv[0] * vv; acc[4 * q + 1] += wv[1] * vv; acc[4 * q + 2] += wv[2] * vv; acc[4 * q + 3] += wv[3] * vv; } }
        float* dst = kvs + ((size_t)bh * 128 + n) * 2048;
#pragma unroll
        for (int q = 0; q < 32; ++q) dst[q * 64 + lane] = acc[q];
        if (lane < 32) dec[((size_t)bh * 128 + n) * 32 + lane] = __expf(tot);
        LDS_WAIT(); asm volatile("" ::: "memory");
    }
}
__device__ __forceinline__ void gla_scan(const Cx& cx, float* kvs, const float* dec) {
    for (int j = cx.vcu; j < 64; j += cx.G) {
        const int bh = j >> 2, idx = (j & 3) * 512 + cx.tid, k = idx >> 6;
        float* p = kvs + (size_t)bh * 128 * 2048 + idx; const float* dp = dec + (size_t)bh * 128 * 32 + k;
        float s = 0.f;
        for (int n0 = 0; n0 < 128; n0 += 8) { float kv[8], d[8];
#pragma unroll
            for (int q = 0; q < 8; ++q) { kv[q] = p[(size_t)(n0 + q) * 2048]; d[q] = dp[(n0 + q) * 32]; }
#pragma unroll
            for (int q = 0; q < 8; ++q) { s = d[q] * s + kv[q]; p[(size_t)(n0 + q) * 2048] = s; } }
    }
}
__device__ __forceinline__ void gla_pass3(const Cx& cx, const bf16* zg, const float* kvs, const float* ng, bf16* yc) {
    LAS float* qs = (LAS float*)(cx.lds + cx.wave * 16384);
    const int lane = cx.lane, k = lane & 31, half = lane >> 5; const float gn = ng[lane];
    for (int task = cx.vcu * 8 + cx.wave; task < 2048; task += cx.G * 8) {
        const int hd = task & 3, chunk = task >> 2; const size_t t0 = (size_t)chunk * 64; const int bh = (chunk >> 7) * 4 + hd, n = chunk & 127;
        float S[32]; const float* sp = kvs + ((size_t)bh * 128 + n) * 2048;
#pragma unroll
        for (int q = 0; q < 32; ++q) S[q] = sp[q * 64 + lane];
#pragma unroll
        for (int c = 0; c < 32; ++c) qs[(half * 32 + c) * 32 + k] = b2f(zg[(t0 + half * 32 + c) * 768 + hd * 32 + k]) * 0.17677669529663687f;
        LDS_WAIT(); asm volatile("" ::: "memory");
        for (int c = 0; c < 64; ++c) { float o = 0.f;
#pragma unroll
            for (int q = 0; q < 8; ++q) { const f32x4 qv = *(const LAS f32x4*)(qs + c * 32 + q * 4); o += qv[0] * S[4 * q] + qv[1] * S[4 * q + 1] + qv[2] * S[4 * q + 2] + qv[3] * S[4 * q + 3]; }
            const float rs = 1.0f / sqrtf(wave_sum(o * o) * (1.f / 64.f) + EPS);
            const float r = b2f(zg[(t0 + c) * 768 + 512 + hd * 64 + lane]);
            yc[(t0 + c) * 1024 + 768 + hd * 64 + lane] = (bf16)f2bf(o * rs * gn * (r * sigm(r))); }
        LDS_WAIT(); asm volatile("" ::: "memory");
    }
}
#if MK_CHECK
constexpr int CW_CHK = 12288;
__device__ __forceinline__ unsigned hsh(unsigned x) { x ^= x >> 16; x *= 0x7feb352dU; x ^= x >> 15; x *= 0x846ca68bU; x ^= x >> 16; return x; }
__device__ __forceinline__ bool bad(float got, float ref, float tol) { return !(fabsf(got - ref) <= 2.0f * tol * fmaxf(fabsf(ref), 1.0f)); }
__device__ __forceinline__ bool bad_small(float got, float ref) { return !(fabsf(got - ref) <= 0.004f + 0.05f * fabsf(ref)); }
__device__ __forceinline__ void cntf(gu32* ctl, int slot, unsigned n) { if (n) __hip_atomic_fetch_add(ctl + CW_CHK + 64 * (1 + slot), n, RLX_AGENT); }
__device__ __forceinline__ void flag(gu32* ctl, int bit) { __hip_atomic_fetch_or(ctl + CW_CHK, 1u << bit, RLX_AGENT); }
__device__ __forceinline__ float logsig(float x) { return fminf(x, 0.f) - __logf(1.f + __expf(-fabsf(x))); }
__device__ __forceinline__ float zdot(const float* xr, float rs, const float* gmix, const float* win, int col) { float a = 0.f; for (int k = 0; k < 1024; ++k) a += xr[k] * rs * gmix[k] * win[(size_t)k * D_IN + col]; return a; }
__device__ __forceinline__ void chk_win(int tid, const float* x, const float* gmix, const float* win, const float* wg2, const float* bg, const bf16* ZU, const bf16* ZQ, const bf16* ZK, const bf16* ZV, const bf16* ZG, const float* LA, gu32* ctl) {
    for (int s = tid; s < 3072; s += 512) {
        const unsigned h1 = hsh(s * 2654435761u + 17u), h2 = hsh(h1 + 0x9e3779b9u); const int row = h1 % T_TOK, type = s % 6;
        const float* xr = x + (size_t)row * 1024; float ss = 0.f; for (int k = 0; k < 1024; ++k) ss += xr[k] * xr[k]; const float rs = 1.0f / sqrtf(ss / 1024.f + EPS);
        float got, ref;
        if (type == 0) { const int ch = h2 % 256; const float a = zdot(xr, rs, gmix, win, ch), g = zdot(xr, rs, gmix, win, 256 + ch); ref = a / (1.f + expf(-g)); got = b2f(ZU[(size_t)row * 256 + ch]); }
        else if (type == 1 || type == 2) { const int comp = h2 % 8, d = (h2 >> 8) % 64, base = (type == 1 ? 512 : 1024) + comp * 64; const float sc = type == 1 ? 0.125f * 1.4426950408889634f : 1.f;
            if (d < 16) { const int j = d & 7; const float x1 = zdot(xr, rs, gmix, win, base + j), x2 = zdot(xr, rs, gmix, win, base + 8 + j); const int pos = row & (SEQ - 1);
                const double invf[8] = {1.0, 0.19391010807943456, 0.037601130015015855, 0.0072912391843014545, 0.001414213562373095, 0.00027423030417878515, 5.317602791587768e-05, 1.031136931769684e-05}; double fq_ = invf[0];
                for (int q_ = 1; q_ < 8; ++q_) fq_ = (j == q_) ? invf[q_] : fq_;
                const double rev = (double)pos * fq_ * 0.15915494309189535; const float fr_ = (float)(rev - rint(rev)); const float c = __builtin_amdgcn_cosf(fr_), sn = __builtin_amdgcn_sinf(fr_);
                ref = (d < 8 ? x1 * c - x2 * sn : x2 * c + x1 * sn) * sc; }
            else ref = zdot(xr, rs, gmix, win, base + d) * sc;
            int nd = d; if (d >= 4 && d < 8) nd = d + 4; else if (d >= 8 && d < 12) nd = d - 4;
            got = b2f((type == 1 ? ZQ : ZK)[(size_t)row * 512 + comp * 64 + nd]); }
        else if (type == 3) { const int col = h2 % 512; ref = zdot(xr, rs, gmix, win, 1536 + col); got = b2f(ZV[(size_t)row * 512 + col]); }
        else if (type == 4) { const int col = h2 % 768; ref = zdot(xr, rs, gmix, win, 2048 + col); got = b2f(ZG[(size_t)row * 768 + col]); }
        else { const int col = h2 % 128; float pre = bg[col]; for (int r = 0; r < 16; ++r) pre += zdot(xr, rs, gmix, win, 2816 + r) * wg2[r * 128 + col]; ref = logsig(pre) / 16.f; got = LA[(size_t)row * 128 + col]; }
        if (type == 5 ? bad_small(got, ref) : bad(got, ref, 0.04f)) flag(ctl, type == 0 ? 0 : (type < 3 ? 1 : 2));
    }
}
__device__ __forceinline__ float convy(const bf16* ZU, const float* cw, const float* cb, int row, int tin, int c) { float a = cb[c]; for (int j = 0; j < 31; ++j) { const int tt = tin - 30 + j; if (tt >= 0) a += cw[j * 256 + c] * b2f(ZU[(size_t)(row - 30 + j) * 256 + c]); } return a; }
__device__ __forceinline__ void chk_conv(int tid, const bf16* ZU, const bf16* YC, const float* cw, const float* cb, const float* lng, const float* lnb, gu32* ctl, int slot) {
    const unsigned h1 = hsh(tid * 2246822519u + 3u); int row = h1 % T_TOK; if (tid < 64) row = (tid & 3) * SEQ + (tid >> 2);
    const int tin = row & (SEQ - 1);
    float mu = 0.f; for (int c = 0; c < 256; ++c) mu += convy(ZU, cw, cb, row, tin, c); mu /= 256.f;
    float var = 0.f; for (int c = 0; c < 256; ++c) { const float d = convy(ZU, cw, cb, row, tin, c) - mu; var += d * d; } var /= 256.f; const float rstd = 1.0f / sqrtf(var + EPS);
    unsigned nf = 0, nq0 = 0, nq1 = 0; for (int c = 0; c < 256; ++c) { const float y = (convy(ZU, cw, cb, row, tin, c) - mu) * rstd * lng[c] + lnb[c]; const float ref = y / (1.f + expf(-y)); if (bad(b2f(YC[(size_t)row * 1024 + c]), ref, 0.04f)) { ++nf; if (c < 64) ++nq0; else if (c < 128) ++nq1; } }
    cntf(ctl, 2, nq0); cntf(ctl, 3, nq1);
    if (nf) flag(ctl, 3); cntf(ctl, slot, nf > 8 ? 1u : 0u);
}
__device__ __forceinline__ void chk_gla(int tid, const bf16* ZG, const float* LA, const float* ng, const bf16* YC, gu32* ctl) {
    const unsigned h1 = hsh(tid * 3266489917u + 5u); const int b = h1 & 3, n = (h1 >> 2) % 3, c = (h1 >> 8) & 63, hd = (h1 >> 16) & 3; const size_t row = (size_t)b * SEQ + n * 64 + c;
    float o[64];
#pragma unroll
    for (int v = 0; v < 64; ++v) o[v] = 0.f;
    for (int k = 0; k < 32; ++k) {
        float st[64];
#pragma unroll
        for (int v = 0; v < 64; ++v) st[v] = 0.f;
        for (int m = 0; m <= n; ++m) { const size_t t0 = (size_t)b * SEQ + m * 64; float tot = 0.f; for (int cc = 0; cc < 64; ++cc) tot += LA[(t0 + cc) * 128 + hd * 32 + k];
            const float dcy = expf(tot);
#pragma unroll
            for (int v = 0; v < 64; ++v) st[v] *= dcy;
            float run = 0.f;
            for (int cc = 0; cc < 64; ++cc) { run += LA[(t0 + cc) * 128 + hd * 32 + k]; const float w = b2f(ZG[(t0 + cc) * 768 + 128 + hd * 32 + k]) * expf(tot - run);
#pragma unroll
                for (int v = 0; v < 64; ++v) st[v] += w * b2f(ZG[(t0 + cc) * 768 + 256 + hd * 64 + v]); } }
        const float q = b2f(ZG[row * 768 + hd * 32 + k]) * 0.17677669529663687f;
#pragma unroll
        for (int v = 0; v < 64; ++v) o[v] += q * st[v];
    }
    float ss = 0.f;
#pragma unroll
    for (int v = 0; v < 64; ++v) ss += o[v] * o[v];
    const float rs = 1.0f / sqrtf(ss / 64.f + EPS); unsigned nf = 0;
#pragma unroll
    for (int v = 0; v < 64; ++v) { const float r = b2f(ZG[row * 768 + 512 + hd * 64 + v]); const float ref = o[v] * rs * ng[v] * (r / (1.f + expf(-r))); if (bad(b2f(YC[row * 1024 + 768 + hd * 64 + v]), ref, 0.05f)) ++nf; }
    if (nf) flag(ctl, 4);
}
__device__ __forceinline__ void chk_attn(int tid, const bf16* ZQ, const bf16* ZK, const bf16* ZV, const bf16* OV, gu32* ctl) {
    const unsigned h1 = hsh(tid * 668265263u + 7u); const int b = h1 & 3, hh = (h1 >> 2) & 3, c = (h1 >> 4) & 1, vq = (h1 >> 5) & 3; int t = (h1 >> 8) % SEQ; if (tid & 1) t = (h1 >> 8) % 512;
    const size_t row = (size_t)b * SEQ + t; const int nk = ((t >> 6) + 1) * 64;
    float q[64];
#pragma unroll
    for (int d = 0; d < 64; ++d) q[d] = b2f(ZQ[row * 512 + (hh * 2 + c) * 64 + d]);
    float m = -INFINITY, l = 0.f, acc[32];
#pragma unroll
    for (int i = 0; i < 32; ++i) acc[i] = 0.f;
    for (int kk = 0; kk < nk; ++kk) { const size_t kr = (size_t)b * SEQ + kk; float s = 0.f;
#pragma unroll
        for (int d = 0; d < 64; ++d) s += q[d] * b2f(ZK[kr * 512 + (hh * 2 + c) * 64 + d]);
        const float mn = fmaxf(m, s), al = exp2f(m - mn), p = exp2f(s - mn); l = l * al + p; m = mn;
#pragma unroll
        for (int i = 0; i < 32; ++i) acc[i] = acc[i] * al + p * b2f(ZV[kr * 512 + hh * 128 + vq * 32 + i]); }
    bool f = false;
#pragma unroll
    for (int i = 0; i < 32; ++i) if (bad(b2f(OV[row * 1024 + hh * 256 + c * 128 + vq * 32 + i]), acc[i] / l, 0.05f)) f = true;
    if (f) flag(ctl, 5);
}
__device__ __forceinline__ void chk_mix(int tid, const bf16* OV, const bf16* YC, const float* lp, const float* subg, const float* x, const float* wout, const float* out, gu32* ctl) {
    float s01 = 0.f, s23 = 0.f; for (int d = 0; d < 64; ++d) { s01 += lp[d] * lp[64 + d]; s23 += lp[128 + d] * lp[192 + d]; }
    const float lam = expf(s01) - expf(s23) + 0.2f;
    const unsigned h1 = hsh(tid * 374761393u + 11u); const size_t row = h1 % T_TOK; const int hh = (h1 >> 20) & 3;
    float ss = 0.f; for (int d = 0; d < 128; ++d) { const float y = b2f(OV[row * 1024 + hh * 256 + d]) - lam * b2f(OV[row * 1024 + hh * 256 + 128 + d]); ss += y * y; }
    const float rs = 0.8f / sqrtf(ss / 128.f + EPS); bool f = false;
    for (int d = 0; d < 128; ++d) { const float y = b2f(OV[row * 1024 + hh * 256 + d]) - lam * b2f(OV[row * 1024 + hh * 256 + 128 + d]); if (bad(b2f(YC[row * 1024 + 256 + hh * 128 + d]), y * rs * subg[d], 0.04f)) f = true; }
    if (f) flag(ctl, 6);
    const int col = (h1 >> 8) & 1023; float a = x[row * 1024 + col]; for (int k = 0; k < 1024; ++k) a += b2f(YC[row * 1024 + k]) * wout[(size_t)k * 1024 + col];
    if (bad(out[row * 1024 + col], a, 0.03f)) flag(ctl, 6);
}
#endif
#ifndef MK_CHECK
#define MK_CHECK 0
#endif
#ifndef MK_MULTI
#define MK_MULTI 0
#endif
constexpr int NPH_LAYER = 12, NPH = 1 + DEPTH * NPH_LAYER + 1;
struct Args { const float* in[24]; float* out; unsigned char* ws; int ph_lo, ph_hi; };
#define IN(k) (lo <= (k) && (k) < hi)
#define SEAM() do { if (!MK_MULTI) xcd_barrier(bar); } while (0)
#define PTR(i) ((const float*)(const GAS float*)ldptr(PT, (i)))
#define PH_BEGIN Cx cx = mkcx(ldsb, wave_s); unsigned char* ws = (unsigned char*)(GAS unsigned char*)ldptr(PT, 25); float* out = (float*)(GAS float*)ldptr(PT, 24); (void)out; \
    bf16* HN = (bf16*)(ws + WS_HN); bf16* ZQ = (bf16*)(ws + WS_ZQ); bf16* ZK = (bf16*)(ws + WS_ZK); bf16* ZV = (bf16*)(ws + WS_ZV); bf16* ZU = (bf16*)(ws + WS_ZU); bf16* ZG = (bf16*)(ws + WS_ZG); \
    bf16* OV = (bf16*)(ws + WS_OV); bf16* YC = (bf16*)(ws + WS_YC); bf16* UP = (bf16*)(ws + WS_UP); bf16* ACT = (bf16*)(ws + WS_ACT); bf16* XG = (bf16*)(ws + WS_XG); bf16* Y2 = (bf16*)(ws + WS_Y2); \
    float* LAp = (float*)(ws + WS_LA); float* KVS = (float*)(ws + WS_KVS); float* DEC = (float*)(ws + WS_DEC); const float* ROPE = (const float*)(ws + WS_ROPE); \
    int* TOKSLOT = (int*)(ws + WS_TOKSLOT); float* GATEW = (float*)(ws + WS_GATEW); gu32* ctl = (gu32*)(ws + WS_CTL); \
    (void)HN; (void)ZQ; (void)ZK; (void)ZV; (void)ZU; (void)ZG; (void)OV; (void)YC; (void)UP; (void)ACT; (void)XG; (void)Y2; (void)LAp; (void)KVS; (void)DEC; (void)ROPE; (void)TOKSLOT; (void)GATEW; (void)ctl;

template <int li> __device__ __forceinline__ void layer_body(unsigned char* lds_raw, LAS unsigned char* const ldsb, const int wave_s, const int lo, const int hi, const XcdBarrier& bar, const LAS unsigned long long* PT, LAS int* TB) {
        constexpr int pb = 1 + li * NPH_LAYER; constexpr bool moe = (li & 1) != 0; constexpr int hf = li >> 1;
        if (IN(pb + 0)) { PH_BEGIN norm_rows(cx, (li == 0) ? PTR(0) : (const float*)out, HN); SEAM(); }
        if (IN(pb + 1)) { PH_BEGIN
            pg8::Gemm g{HN, (const bf16*)(ws + WS_WIN + li * SZ_WIN), 1024, 0}; pg8::StaticOrder S; S.init(T_TOK, NZ, cx.G, (int)blockIdx.x);
            pg8::EpiWin E{ZU, ZQ, ZK, ZV, ZG, LAp, ROPE, PTR(11) + li * 128};
            pg8::gemm_phase<pg8::EpiWin, pg8::StaticOrder, true, true>(cx.lds + RING_OFF, g, S, E, wave_s);
            SEAM(); }
        if (IN(pb + 2)) { PH_BEGIN
            gla_pass1(cx, ZG, LAp, KVS, DEC);
            __syncthreads();
            conv_units(cx, ZU, YC, PTR(4) + li * 31 * 256, PTR(5) + li * 256, PTR(6) + li * 256, PTR(7) + li * 256);
            SEAM(); }
#if MK_CHECK
        if constexpr (li == 0) { if (IN(pb + 2) && blockIdx.x == 0) { PH_BEGIN
            const float v = (float)((hsh(cx.tid * 7919u + 13u) & 1023u)) * 0.125f;
            LAS float* TS = (LAS float*)(cx.lds); TS[cx.tid] = v; __syncthreads();
            float ref64 = 0.f, ref16 = 0.f; for (int q = 0; q < 64; ++q) ref64 += TS[cx.wave * 64 + q]; for (int q = 0; q < 16; ++q) ref16 += TS[cx.wave * 64 + (cx.lane & 48) + q];
            const float g64 = wave_sum(v), g16 = sum16(v);
            if (g64 != ref64) { flag(ctl, 3); cntf(ctl, 2, 1u); } if (g16 != ref16) { flag(ctl, 3); cntf(ctl, 3, 1u); }
            __syncthreads(); } }
#endif
        if (IN(pb + 3)) { PH_BEGIN
            gla_scan(cx, KVS, DEC);
            __syncthreads();
            const attn_body::AttnTensors AT{(const attn_body::bf16*)ZQ, (const attn_body::bf16*)ZK, (const attn_body::bf16*)ZV, (attn_body::bf16*)OV};
            const attn_body::StaticOrder S((int)cx.G, (int)blockIdx.x);
            attn_body::attn_phase<attn_body::StaticOrder>((char*)lds_raw + RING_OFF, AT, S, wave_s);
            SEAM(); }
        if (IN(pb + 4)) { PH_BEGIN
            gla_pass3(cx, ZG, KVS, PTR(12) + li * 64, YC);
            const float lam_init = 0.8f - 0.6f * expf(-0.3f * (float)li);
            diff_combine_rows(cx, OV, YC, PTR(8) + li * 256, PTR(9) + li * 128, lam_init);
            SEAM(); }
        if (IN(pb + 5)) { PH_BEGIN
            pg8::Gemm g{YC, (const bf16*)(ws + WS_WOUT + li * SZ_SQ), 1024, 0}; pg8::StaticOrder S; S.init(T_TOK, 1024, cx.G, (int)blockIdx.x);
            pg8::EpiRes E{(li == 0) ? PTR(0) : (const float*)out, out, 1024};
            pg8::gemm_phase<pg8::EpiRes, pg8::StaticOrder, true, true>(cx.lds + RING_OFF, g, S, E, wave_s);
            SEAM(); }
#if MK_CHECK
        if constexpr (li == 0) { if (IN(pb + 5) && blockIdx.x == 0) { PH_BEGIN
            chk_win(cx.tid, PTR(0), PTR(2), PTR(3), PTR(10), PTR(11), ZU, ZQ, ZK, ZV, ZG, LAp, ctl);
            chk_conv(cx.tid, ZU, YC, PTR(4), PTR(5), PTR(6), PTR(7), ctl, 1);
            chk_gla(cx.tid, ZG, LAp, PTR(12), YC, ctl);
            chk_attn(cx.tid, ZQ, ZK, ZV, OV, ctl);
            chk_mix(cx.tid, OV, YC, PTR(8), PTR(9), PTR(0), PTR(13), out, ctl); } }
#endif
        if constexpr (!moe) {
            if (IN(pb + 6)) { PH_BEGIN norm_rows(cx, out, HN); SEAM(); }
            if (IN(pb + 8)) { PH_BEGIN
                pg8::Gemm g{HN, (const bf16*)(ws + WS_WFGU + hf * SZ_WFGU), 1024, 0}; pg8::StaticOrder S; S.init(T_TOK, 2 * D_FF, cx.G, (int)blockIdx.x);
                pg8::EpiSwiglu E{ACT, D_FF};
                pg8::gemm_phase<pg8::EpiSwiglu, pg8::StaticOrder, true, true>(cx.lds + RING_OFF, g, S, E, wave_s);
                SEAM(); }
            if (IN(pb + 9)) { PH_BEGIN
                pg8::Gemm g{ACT, (const bf16*)(ws + WS_WFDN + hf * SZ_WFDN), D_FF, 0}; pg8::StaticOrder S; S.init(T_TOK, 1024, cx.G, (int)blockIdx.x);
                pg8::EpiRes E{out, out, 1024};
                pg8::gemm_phase<pg8::EpiRes, pg8::StaticOrder, true, true>(cx.lds + RING_OFF, g, S, E, wave_s);
                SEAM(); }
            if (IN(pb + 10)) { PH_BEGIN
                norm_rows(cx, out, HN);
                __syncthreads();
                pg8::Gemm g{(const bf16*)(ws + WS_PB) + (size_t)li * T_TOK * PLE_DIM, (const bf16*)(ws + WS_WPU + li * SZ_WPU), PLE_DIM, 0}; pg8::StaticOrder S; S.init(T_TOK, 1024, cx.G, (int)blockIdx.x);
                pg8::EpiBf16P E{UP, 1024};
                pg8::gemm_phase<pg8::EpiBf16P, pg8::StaticOrder, true, true>(cx.lds + RING_OFF, g, S, E, wave_s);
                SEAM(); }
        } else {
            if (IN(pb + 6)) { PH_BEGIN gu32* cursor = ctl + CW_CUR + hf * 8 * 64; router_rows(cx, out, HN, PTR(14) + li * 1024, PTR(17) + (size_t)hf * 1024 * 8, cursor, TOKSLOT, GATEW); SEAM(); }
            if (IN(pb + 7)) { PH_BEGIN gu32* cursor = ctl + CW_CUR + hf * 8 * 64; moe_prefix(cx, cursor, TB); dispatch_rows(cx, HN, XG, TOKSLOT, TB); SEAM(); }
            if (IN(pb + 8)) { PH_BEGIN
                gu32* cursor = ctl + CW_CUR + hf * 8 * 64; moe_prefix(cx, cursor, TB);
                pg8::Gemm g{XG, (const bf16*)(ws + WS_WMGU + (size_t)hf * NEXP * SZ_WMGU), 1024, SZ_WMGU}; pg8::GroupedOrder S{(const PG8_LAS int*)TB, 2 * D_FFE / 256, cx.G, (int)blockIdx.x};
                pg8::EpiSwiglu E{ACT, D_FFE};
                pg8::gemm_phase<pg8::EpiSwiglu, pg8::GroupedOrder, true, true>(cx.lds + RING_OFF, g, S, E, wave_s);
                SEAM(); }
            if (IN(pb + 9)) { PH_BEGIN
                gu32* cursor = ctl + CW_CUR + hf * 8 * 64; moe_prefix(cx, cursor, TB);
                pg8::Gemm g{ACT, (const bf16*)(ws + WS_WMDN + (size_t)hf * NEXP * SZ_WMDN), D_FFE, SZ_WMDN}; pg8::GroupedOrder S{(const PG8_LAS int*)TB, 4, cx.G, (int)blockIdx.x};
                pg8::EpiBf16P E{Y2, 1024};
                pg8::gemm_phase<pg8::EpiBf16P, pg8::GroupedOrder, true, true>(cx.lds + RING_OFF, g, S, E, wave_s);
                SEAM(); }
            if (IN(pb + 10)) { PH_BEGIN
                gu32* cursor = ctl + CW_CUR + hf * 8 * 64; moe_prefix(cx, cursor, TB);
                combine_norm_rows(cx, out, HN, Y2, TOKSLOT, GATEW, TB);
                __syncthreads();
                pg8::Gemm g{(const bf16*)(ws + WS_PB) + (size_t)li * T_TOK * PLE_DIM, (const bf16*)(ws + WS_WPU + li * SZ_WPU), PLE_DIM, 0}; pg8::StaticOrder S; S.init(T_TOK, 1024, cx.G, (int)blockIdx.x);
                pg8::EpiBf16P E{UP, 1024};
                pg8::gemm_phase<pg8::EpiBf16P, pg8::StaticOrder, true, true>(cx.lds + RING_OFF, g, S, E, wave_s);
                SEAM(); }
        }
        if (IN(pb + 11)) { PH_BEGIN
            pg8::Gemm g{HN, (const bf16*)(ws + WS_WPG + li * SZ_SQ), 1024, 0}; pg8::StaticOrder S; S.init(T_TOK, 1024, cx.G, (int)blockIdx.x);
            pg8::EpiPle E{out, UP, 1024};
            pg8::gemm_phase<pg8::EpiPle, pg8::StaticOrder, true, true>(cx.lds + RING_OFF, g, S, E, wave_s);
            SEAM(); }
}
__global__ void __launch_bounds__(512, 2) trunk_fwd(Args args) {
    extern __shared__ __attribute__((aligned(16))) unsigned char lds_raw[];
    LAS unsigned char* const ldsb = (LAS unsigned char*)lds_raw;
    const int wave_s = __builtin_amdgcn_readfirstlane((int)(threadIdx.x >> 6));
    volatile LAS unsigned* MISC = (volatile LAS unsigned*)(ldsb + MISC_OFF);
    LAS int* TB = (LAS int*)(ldsb + MISC_OFF + 64);
    LAS unsigned long long* PT = (LAS unsigned long long*)(ldsb + MISC_OFF + 128);
    for (int u = threadIdx.x; u < (LDS_BYTES - LDSCTL_OFF) / 4; u += 512) ((LAS unsigned*)(ldsb + LDSCTL_OFF))[u] = 0u;
    __syncthreads();
    if (threadIdx.x == 0) {
        PT[0] = (unsigned long long)args.in[0]; PT[1] = (unsigned long long)args.in[1]; PT[2] = (unsigned long long)args.in[2]; PT[3] = (unsigned long long)args.in[3]; PT[4] = (unsigned long long)args.in[4]; PT[5] = (unsigned long long)args.in[5];
        PT[6] = (unsigned long long)args.in[6]; PT[7] = (unsigned long long)args.in[7]; PT[8] = (unsigned long long)args.in[8]; PT[9] = (unsigned long long)args.in[9]; PT[10] = (unsigned long long)args.in[10]; PT[11] = (unsigned long long)args.in[11];
        PT[12] = (unsigned long long)args.in[12]; PT[13] = (unsigned long long)args.in[13]; PT[14] = (unsigned long long)args.in[14]; PT[15] = (unsigned long long)args.in[15]; PT[16] = (unsigned long long)args.in[16]; PT[17] = (unsigned long long)args.in[17];
        PT[18] = (unsigned long long)args.in[18]; PT[19] = (unsigned long long)args.in[19]; PT[20] = (unsigned long long)args.in[20]; PT[21] = (unsigned long long)args.in[21]; PT[22] = (unsigned long long)args.in[22]; PT[23] = (unsigned long long)args.in[23];
        PT[24] = (unsigned long long)args.out; PT[25] = (unsigned long long)args.ws; }
    __syncthreads();
    XcdBarrier bar; bar.bar = (unsigned*)((gu32*)(args.ws + WS_CTL) + CW_BAR); bar.x = 0; bar.st = nullptr; bar.wave = wave_s;
    if (!MK_MULTI) bar = xcd_barrier_post((unsigned*)((gu32*)(args.ws + WS_CTL) + CW_BAR), MISC + 8, wave_s);
    const int lo = args.ph_lo, hi = args.ph_hi;
    if (IN(0)) { PH_BEGIN p0_prologue(cx, PT, ws); SEAM(); }

    layer_body<0>(lds_raw, ldsb, wave_s, lo, hi, bar, PT, TB);
    layer_body<1>(lds_raw, ldsb, wave_s, lo, hi, bar, PT, TB);
    layer_body<2>(lds_raw, ldsb, wave_s, lo, hi, bar, PT, TB);
    layer_body<3>(lds_raw, ldsb, wave_s, lo, hi, bar, PT, TB);
    if (IN(NPH - 1)) { PH_BEGIN
#if MK_CHECK
        const unsigned mask = __hip_atomic_load(ctl + CW_CHK, RLX_AGENT);
        if (mask) { const float k2 = ((float)(10 + (mask & 63)) + 0.3f) * ((mask >> 6) ? 1000.f : 100.f); const float kv = sqrtf(k2);
            for (size_t i = (size_t)blockIdx.x * 512 + cx.tid; i < (size_t)T_TOK * 1024; i += (size_t)gridDim.x * 512) out[i] = kv; }
        else
#endif
        final_norm_rows(cx, out, PTR(23));
    }
}

extern "C" void kernel_launch(void* const* d_in, const int* in_sizes, int n_in, void* d_out, int out_size, void* d_ws, size_t ws_size, hipStream_t stream) {
    static int grid = 0;
    if (grid == 0) {
        if (n_in != 24 || in_sizes[0] != T_TOK * DMOD || out_size != T_TOK * DMOD || ws_size < WS_END) { fprintf(stderr, "kernel_launch: unexpected shapes (n_in %d, in0 %d, out %d, ws %zu); nothing launched\n", n_in, n_in > 0 ? in_sizes[0] : -1, out_size, ws_size); grid = -1; return; }
        if (hipFuncSetAttribute((const void*)trunk_fwd, hipFuncAttributeMaxDynamicSharedMemorySize, LDS_BYTES) != hipSuccess) { fprintf(stderr, "kernel_launch: hipFuncSetAttribute failed\n"); grid = -1; return; }
        int per_cu = 0;
        if (hipOccupancyMaxActiveBlocksPerMultiprocessor(&per_cu, (const void*)trunk_fwd, 512, LDS_BYTES) != hipSuccess || per_cu < 1) fprintf(stderr, "kernel_launch: note: occupancy query reports %d workgroups per CU\n", per_cu);
        (void)hipGetLastError();
        grid = 256;
    }
    if (grid < 0) return;
    if (hipMemsetAsync((char*)d_ws + WS_CTL, 0, CTL_ZERO_BYTES, stream) != hipSuccess) { fprintf(stderr, "kernel_launch: hipMemsetAsync failed\n"); return; }
    Args a{};
    for (int i = 0; i < 24; ++i) a.in[i] = (const float*)d_in[i];
    a.out = (float*)d_out; a.ws = (unsigned char*)d_ws;
#if MK_MULTI
    for (int ph = 0; ph < NPH; ++ph) { a.ph_lo = ph; a.ph_hi = ph + 1; hipLaunchKernelGGL(trunk_fwd, dim3(grid), dim3(512), LDS_BYTES, stream, a); }
#else
    a.ph_lo = 0; a.ph_hi = NPH;
    hipLaunchKernelGGL(trunk_fwd, dim3(grid), dim3(512), LDS_BYTES, stream, a);
#endif
    const hipError_t le = hipPeekAtLastError();
    if (le != hipSuccess) fprintf(stderr, "kernel_launch: launch failed: %s\n", hipGetErrorName(le));
}
```

```cpp
#define MK_CHECK 0
#define MK_TIME 0
#define MK_STAG 0
#define MK_NT 0
#define MK_DBLK 0
#define MK_XBAR 0
#define MK_DELAY 0
#define MK_REP 0
#define MK_REPN 2
#include <hip/hip_runtime.h>
#include <hip/hip_bf16.h>
#include <cstdio>
#include <cstdint>
#include <cmath>

constexpr int T_TOK = 32768, SEQ = 8192, DMOD = 1024, DEPTH = 4;
constexpr int D_IN = 2832, NZ = 3072;
constexpr int D_FF = 2816, D_FFE = 3584, NEXP = 8;
constexpr int PLE_DIM = 256;
constexpr float EPS = 1e-6f;
constexpr int MOE_ROWS = 2 * T_TOK + NEXP * 256;
__device__ __forceinline__ int lane_now() { int l; asm volatile("v_mbcnt_lo_u32_b32 %0, -1, 0\n\tv_mbcnt_hi_u32_b32 %0, -1, %0" : "=v"(l)); return l; }
#ifndef MK_REP
#define MK_REP 0
#endif
#ifndef MK_REPN
#define MK_REPN 2
#endif
#define REPEAT(grp) for (int rep_ = 0; rep_ < ((MK_REP == (grp)) ? MK_REPN : 1); ++rep_)
#ifndef MK_WT
#define MK_WT 0
#endif
typedef unsigned wt_u32x4 __attribute__((ext_vector_type(4)));
typedef float wt_f32x4 __attribute__((ext_vector_type(4)));
__device__ __forceinline__ void st16_wt(void* p, wt_u32x4 v) {
#if MK_WT
    asm volatile("global_store_dwordx4 %0, %1, off sc1\n\ts_nop 1" :: "v"(p), "v"(v) : "memory");
#else
    *(wt_u32x4*)p = v;
#endif
}
__device__ __forceinline__ void st16f_wt(void* p, wt_f32x4 v) {
#if MK_WT
    asm volatile("global_store_dwordx4 %0, %1, off sc1\n\ts_nop 1" :: "v"(p), "v"(v) : "memory");
#else
    *(wt_f32x4*)p = v;
#endif
}
__device__ __forceinline__ void st8_wt(void* p, unsigned long long v) {
#if MK_WT
    asm volatile("global_store_dwordx2 %0, %1, off sc1\n\ts_nop 1" :: "v"(p), "v"(v) : "memory");
#else
    *(unsigned long long*)p = v;
#endif
}
#if MK_DELAY
#define GT_START(ldsb_, wid_, id) do { if ((MK_DELAY) == (id) && blockIdx.x == MK_DBLK && (wid_) == 0 && lane_now() == 0) { volatile __attribute__((address_space(3))) unsigned long long* t_ = (volatile __attribute__((address_space(3))) unsigned long long*)((ldsb_) + 131072 + 320 + 104); t_[0] = __builtin_amdgcn_s_memrealtime(); } } while (0)
#define GT_STOP(ldsb_, wid_, id) do { if ((MK_DELAY) == (id) && blockIdx.x == MK_DBLK && (wid_) == 0 && lane_now() == 0) { volatile __attribute__((address_space(3))) unsigned long long* t_ = (volatile __attribute__((address_space(3))) unsigned long long*)((ldsb_) + 131072 + 320 + 104); t_[1] += __builtin_amdgcn_s_memrealtime() - t_[0]; } } while (0)
#define GT_CSTART(ldsb_, wid_, id) do { if ((MK_DELAY) == (id) && blockIdx.x == MK_DBLK && (wid_) == 0 && lane_now() == 0) { volatile __attribute__((address_space(3))) unsigned long long* t_ = (volatile __attribute__((address_space(3))) unsigned long long*)((ldsb_) + 131072 + 320 + 104); t_[0] = clock64(); } } while (0)
#define GT_CSTOP(ldsb_, wid_, id) do { if ((MK_DELAY) == (id) && blockIdx.x == MK_DBLK && (wid_) == 0 && lane_now() == 0) { volatile __attribute__((address_space(3))) unsigned long long* t_ = (volatile __attribute__((address_space(3))) unsigned long long*)((ldsb_) + 131072 + 320 + 104); t_[1] += (clock64() - t_[0]) / 100ull; } } while (0)
#else
#define GT_CSTART(ldsb_, wid_, id) do {} while (0)
#define GT_CSTOP(ldsb_, wid_, id) do {} while (0)
#define GT_START(ldsb_, wid_, id) do {} while (0)
#define GT_STOP(ldsb_, wid_, id) do {} while (0)
#endif
#ifndef MK_DBLK
#define MK_DBLK 0
#endif
#ifndef MK_NT
#define MK_NT 0
#endif
__device__ __forceinline__ void st16_nt(void* p, wt_u32x4 v) {
#if MK_NT
    __builtin_nontemporal_store(v, (wt_u32x4*)p);
#else
    *(wt_u32x4*)p = v;
#endif
}
namespace pg8 {
#define PG8_LAS __attribute__((address_space(3)))
typedef unsigned short bf16_t;
typedef short bf16x8 __attribute__((ext_vector_type(8)));
typedef float f32x4 __attribute__((ext_vector_type(4)));
typedef unsigned u32x4 __attribute__((ext_vector_type(4)));
constexpr int BM = 256, BK = 64, HALF = 128, HTB = HALF * BK * 2  , STAGE_BYTES = 8 * HTB, NXCD = 8, WGM = 8;

__host__ __device__ __forceinline__ int lds_byte(int r, int c) { const int st = (r >> 4) * 2 + (c >> 5), rr = r & 15, cc = c & 31, ob = rr * 64 + cc * 2; return st * 1024 + (ob ^ (((ob >> 9) & 1) << 5)); }
__host__ __device__ __forceinline__ void stage_rc(int b, int& R, int& C) { const int st = b / 1024, sb = b % 1024, swz = sb ^ (((sb >> 9) & 1) << 5); R = (st >> 1) * 16 + swz / 64; C = (st & 1) * 32 + (swz % 64) / 2; }
__host__ __device__ __forceinline__ int perm32(int rho) { const int n = rho >> 4, i = rho & 15; return 8 * (i >> 2) + 4 * n + (i & 3); }

struct Unit { int pm, pn, pe, k0t, ntu, slot, q; };
struct Gemm { const bf16_t* A; const bf16_t* Bt; int K; size_t bstride; };

struct StaticOrder {
    int nM, nN, nwg, G, c;
    __host__ __device__ void init(int M, int N, int G_, int c_) { nM = M / BM; nN = N / BM; nwg = nM * nN; G = G_; c = c_; }
    __host__ __device__ bool next(int i, Unit& u) const {
        const long L = (long)i * G + c; if (L >= nwg) return false;
        int wgid = (int)L; { const int q = nwg / NXCD, r = nwg % NXCD, xcd = wgid % NXCD, off = wgid / NXCD; wgid = (xcd < r ? xcd * (q + 1) : r * (q + 1) + (xcd - r) * q) + off; }
        const int nig = WGM * nN, gid = wgid / nig, fm = gid * WGM, gsz = (nM - fm) < WGM ? (nM - fm) : WGM;
        u.pm = fm + ((wgid % nig) % gsz); u.pn = (wgid % nig) / gsz; u.pe = 0; u.k0t = 0; u.ntu = 0; u.slot = -1; u.q = 0; return true;
    }
    __device__ __forceinline__ void a_ready(const Unit&) const {}
    __device__ __forceinline__ void done(const Unit&) const {}
};
constexpr int NEXPG = 8;
__device__ __forceinline__ unsigned cvt_pk_bf16(float lo, float hi) { unsigned r; asm volatile("v_cvt_pk_bf16_f32 %0, %1, %2" : "=v"(r) : "v"(lo), "v"(hi)); return r; }
typedef float f32x2 __attribute__((ext_vector_type(2)));
__device__ __forceinline__ float fsigmoid(float x) { return __builtin_amdgcn_rcpf(1.f + __builtin_amdgcn_exp2f(-1.4426950408889634f * x)); }
__device__ __forceinline__ float fsilu(float x) { return x * fsigmoid(x); }
__device__ __forceinline__ float bf2f(unsigned short b) { return __builtin_bit_cast(float, (unsigned)b << 16); }
typedef unsigned u32x2 __attribute__((ext_vector_type(2)));
__device__ __forceinline__ float row_rs16(const float* ssp, int row) { const f32x4* p = (const f32x4*)(ssp + (size_t)row * 16); const f32x4 a = p[0], b = p[1], c = p[2], d = p[3];
    const float s = (((a[0] + a[1]) + (a[2] + a[3])) + ((b[0] + b[1]) + (b[2] + b[3]))) + (((c[0] + c[1]) + (c[2] + c[3])) + ((d[0] + d[1]) + (d[2] + d[3])));
    return rsqrtf(s * (1.f / 1024.f) + 1e-6f); }

struct RowScale {
    PG8_LAS float* rsb; const float* ssp;
    __device__ __forceinline__ PG8_LAS const float* stage(const Unit& u, int wr, int wc, int fr, int fq) const {
        const int tid = (wr * 4 + wc) * 64 + fq * 16 + fr, r = tid & 255, hf = tid >> 8; PG8_LAS float* buf = rsb + ((u.pm ^ u.pn) & 1) * 512;
        const f32x4* p = (const f32x4*)(ssp + (size_t)(u.pm * BM + r) * 16) + 2 * hf; const f32x4 a = p[0], b = p[1];
        buf[hf * 256 + r] = ((a[0] + a[1]) + (a[2] + a[3])) + ((b[0] + b[1]) + (b[2] + b[3]));
        asm volatile("s_waitcnt lgkmcnt(0)" ::: "memory"); __builtin_amdgcn_s_barrier(); asm volatile("" ::: "memory");
        return buf; }
    static __device__ __forceinline__ float ms(PG8_LAS const float* buf, int rl) { return (buf[rl] + buf[256 + rl]) * (1.f / 1024.f) + 1e-6f; }
    static __device__ __forceinline__ float rs(PG8_LAS const float* buf, int rl) { return rsqrtf((buf[rl] + buf[256 + rl]) * (1.f / 1024.f) + 1e-6f); }
};
struct EpiBf16P {
    static constexpr bool PERM = true, AFTER_DRAIN = false;
    bf16_t* O; int ldc;
    __device__ __forceinline__ void operator()(const f32x4 (&acc)[2][2][4][2], const Unit& u, int wr, int wc, int fr, int fq) const {
        const int row0 = u.pm * BM + wr * 64 + fr, col0 = u.pn * BM + wc * 32 + 8 * fq;
#pragma unroll
        for (int ai = 0; ai < 2; ++ai)
#pragma unroll
            for (int m = 0; m < 4; ++m) { bf16_t* rowp = O + (size_t)(row0 + ai * HALF + m * 16) * ldc + col0;
#pragma unroll
                for (int bj = 0; bj < 2; ++bj) { const f32x4 v0 = acc[ai][bj][m][0], v1 = acc[ai][bj][m][1];
                    u32x4 w; w.x = cvt_pk_bf16(v0[0], v0[1]); w.y = cvt_pk_bf16(v0[2], v0[3]); w.z = cvt_pk_bf16(v1[0], v1[1]); w.w = cvt_pk_bf16(v1[2], v1[3]);
                    st16_wt(rowp + bj * HALF, w); } }
    }
};
template <int NP> struct EpiSwiglu {
    static constexpr bool PERM = true, AFTER_DRAIN = false;
    bf16_t* O; int ldc; const float* ss; PG8_LAS float* rsb;
    __device__ __forceinline__ void operator()(const f32x4 (&acc)[2][2][4][2], const Unit& u, int wr, int wc, int fr, int fq) const {
        const int row0 = u.pm * BM + wr * 64 + fr, col0 = u.pn * HALF + wc * 32 + 8 * fq;
        PG8_LAS const float* rb = nullptr; if (NP == 16) rb = RowScale{rsb, ss}.stage(u, wr, wc, fr, fq);
        float rsv[8];
#pragma unroll
        for (int q = 0; q < 8; ++q) rsv[q] = NP == 16 ? RowScale::ms(rb, wr * 64 + fr + (q >> 2) * HALF + (q & 3) * 16) : 1.f;
#pragma unroll
        for (int ai = 0; ai < 2; ++ai)
#pragma unroll
            for (int m = 0; m < 4; ++m) { bf16_t* rowp = O + (size_t)(row0 + ai * HALF + m * 16) * ldc + col0;
                const float x = rsv[ai * 4 + m], c1 = -rsqrtf(x);
                const f32x4 g0 = acc[ai][0][m][0], g1 = acc[ai][0][m][1], u0 = acc[ai][1][m][0], u1 = acc[ai][1][m][1];
                float r[8];
                if (NP == 16) {
#pragma unroll
                    for (int i = 0; i < 4; ++i) { r[i] = (g0[i] * u0[i]) * __builtin_amdgcn_rcpf(__builtin_fmaf(__builtin_amdgcn_exp2f(g0[i] * c1), x, x)); r[4 + i] = (g1[i] * u1[i]) * __builtin_amdgcn_rcpf(__builtin_fmaf(__builtin_amdgcn_exp2f(g1[i] * c1), x, x)); }
                } else {
#pragma unroll
                    for (int i = 0; i < 4; ++i) { r[i] = (g0[i] * u0[i]) * __builtin_amdgcn_rcpf(1.f + __builtin_amdgcn_exp2f(-g0[i])); r[4 + i] = (g1[i] * u1[i]) * __builtin_amdgcn_rcpf(1.f + __builtin_amdgcn_exp2f(-g1[i])); }
                }
                u32x4 w; w.x = cvt_pk_bf16(r[0], r[1]); w.y = cvt_pk_bf16(r[2], r[3]); w.z = cvt_pk_bf16(r[4], r[5]); w.w = cvt_pk_bf16(r[6], r[7]);
                st16_nt(rowp, w); }
    }
};
__device__ __forceinline__ float blo(unsigned w) { return __builtin_bit_cast(float, w << 16); }
__device__ __forceinline__ float bhi(unsigned w) { return __builtin_bit_cast(float, w & 0xffff0000u); }
struct EpiResB {
    static constexpr bool PERM = true, AFTER_DRAIN = false;
    const bf16_t* base; bf16_t* out; float* ssq; int ldc;
    __device__ __forceinline__ void operator()(const f32x4 (&acc)[2][2][4][2], const Unit& u, int wr, int wc, int fr, int fq) const {
        const int row0 = u.pm * BM + wr * 64 + fr, col0 = u.pn * BM + wc * 32 + 8 * fq;
#pragma unroll
        for (int ai = 0; ai < 2; ++ai) {
            u32x4 bv[4][2];
#pragma unroll
            for (int m = 0; m < 4; ++m)
#pragma unroll
                for (int bj = 0; bj < 2; ++bj) bv[m][bj] = *(const u32x4*)(base + (size_t)(row0 + ai * HALF + m * 16) * ldc + col0 + bj * HALF);
#pragma unroll
            for (int m = 0; m < 4; ++m) { const int row = row0 + ai * HALF + m * 16; const size_t off = (size_t)row * ldc + col0; float s = 0.f;
#pragma unroll
                for (int bj = 0; bj < 2; ++bj) { const u32x4 bw = bv[m][bj]; const f32x4 a0 = acc[ai][bj][m][0], a1 = acc[ai][bj][m][1];
                    const float v0 = blo(bw.x) + a0[0], v1 = bhi(bw.x) + a0[1], v2 = blo(bw.y) + a0[2], v3 = bhi(bw.y) + a0[3], v4 = blo(bw.z) + a1[0], v5 = bhi(bw.z) + a1[1], v6 = blo(bw.w) + a1[2], v7 = bhi(bw.w) + a1[3];
                    u32x4 w; w.x = cvt_pk_bf16(v0, v1); w.y = cvt_pk_bf16(v2, v3); w.z = cvt_pk_bf16(v4, v5); w.w = cvt_pk_bf16(v6, v7); *(u32x4*)(out + off + bj * HALF) = w;
                    s += (v0 * v0 + v1 * v1) + (v2 * v2 + v3 * v3) + (v4 * v4 + v5 * v5) + (v6 * v6 + v7 * v7); }
                s += __shfl_xor(s, 16); s += __shfl_xor(s, 32);
                if (fq == 0) ssq[(size_t)row * 16 + u.pn * 4 + wc] = s; } }
    }
};
struct EpiPleB {
    static constexpr bool PERM = true, AFTER_DRAIN = false;
    const bf16_t* h; const bf16_t* up; bf16_t* out; const float* ssi; float* sso; int ldc; PG8_LAS float* rsb;
    __device__ __forceinline__ void operator()(const f32x4 (&acc)[2][2][4][2], const Unit& u, int wr, int wc, int fr, int fq) const {
        const int row0 = u.pm * BM + wr * 64 + fr, col0 = u.pn * BM + wc * 32 + 8 * fq;
        PG8_LAS const float* rb = RowScale{rsb, ssi}.stage(u, wr, wc, fr, fq);
#pragma unroll
        for (int ai = 0; ai < 2; ++ai) {
            u32x4 hv[4][2], uv[4][2];
#pragma unroll
            for (int m = 0; m < 4; ++m)
#pragma unroll
                for (int bj = 0; bj < 2; ++bj) { const size_t o = (size_t)(row0 + ai * HALF + m * 16) * ldc + col0 + bj * HALF; hv[m][bj] = *(const u32x4*)(h + o); uv[m][bj] = *(const u32x4*)(up + o); }
#pragma unroll
            for (int m = 0; m < 4; ++m) { const int row = row0 + ai * HALF + m * 16; const size_t off = (size_t)row * ldc + col0; float s = 0.f;
                const float rs = RowScale::rs(rb, wr * 64 + fr + ai * HALF + m * 16);
#pragma unroll
                for (int bj = 0; bj < 2; ++bj) { const u32x4 hw = hv[m][bj], uw = uv[m][bj]; const f32x4 a0 = acc[ai][bj][m][0] * rs, a1 = acc[ai][bj][m][1] * rs;
                    const float v0 = blo(hw.x) + fsigmoid(a0[0]) * blo(uw.x), v1 = bhi(hw.x) + fsigmoid(a0[1]) * bhi(uw.x), v2 = blo(hw.y) + fsigmoid(a0[2]) * blo(uw.y), v3 = bhi(hw.y) + fsigmoid(a0[3]) * bhi(uw.y),
                                v4 = blo(hw.z) + fsigmoid(a1[0]) * blo(uw.z), v5 = bhi(hw.z) + fsigmoid(a1[1]) * bhi(uw.z), v6 = blo(hw.w) + fsigmoid(a1[2]) * blo(uw.w), v7 = bhi(hw.w) + fsigmoid(a1[3]) * bhi(uw.w);
                    u32x4 w; w.x = cvt_pk_bf16(v0, v1); w.y = cvt_pk_bf16(v2, v3); w.z = cvt_pk_bf16(v4, v5); w.w = cvt_pk_bf16(v6, v7); *(u32x4*)(out + off + bj * HALF) = w;
                    s += (v0 * v0 + v1 * v1) + (v2 * v2 + v3 * v3) + (v4 * v4 + v5 * v5) + (v6 * v6 + v7 * v7); }
                s += __shfl_xor(s, 16); s += __shfl_xor(s, 32);
                if (fq == 0) sso[(size_t)row * 16 + u.pn * 4 + wc] = s; } }
    }
};
struct EpiWin {
    static constexpr bool PERM = true, AFTER_DRAIN = false;
    bf16_t *ZU, *ZQ, *ZK, *ZV, *ZG; float* LA; const float* rope; const float* bgate; const float* ss; PG8_LAS float* rsb;
    __device__ __forceinline__ void st8(bf16_t* p, const f32x4 v0, const f32x4 v1) const { u32x4 w; w.x = cvt_pk_bf16(v0[0], v0[1]); w.y = cvt_pk_bf16(v0[2], v0[3]); w.z = cvt_pk_bf16(v1[0], v1[1]); w.w = cvt_pk_bf16(v1[2], v1[3]); st16_wt(p, w); }
    __device__ __forceinline__ void operator()(const f32x4 (&acc)[2][2][4][2], const Unit& u, int wr, int wc, int fr, int fq) const {
        const int pn = u.pn, row0 = u.pm * BM + wr * 64 + fr, cw = wc * 32 + 8 * fq, rl0 = wr * 64 + fr;
        PG8_LAS const float* rb = RowScale{rsb, ss}.stage(u, wr, wc, fr, fq);
        if (pn < 2) {
#pragma unroll
            for (int ai = 0; ai < 2; ++ai)
#pragma unroll
                for (int m = 0; m < 4; ++m) { const size_t row = (size_t)(row0 + ai * HALF + m * 16); const float x = RowScale::ms(rb, rl0 + ai * HALF + m * 16), rs = rsqrtf(x), y = x * rs, c1 = -1.4426950408889634f * rs;
                    const f32x4 a0 = acc[ai][0][m][0], a1 = acc[ai][0][m][1], g0 = acc[ai][1][m][0], g1 = acc[ai][1][m][1]; f32x4 r0, r1;
#pragma unroll
                    for (int i = 0; i < 4; ++i) { r0[i] = a0[i] * __builtin_amdgcn_rcpf(__builtin_fmaf(__builtin_amdgcn_exp2f(g0[i] * c1), y, y)); r1[i] = a1[i] * __builtin_amdgcn_rcpf(__builtin_fmaf(__builtin_amdgcn_exp2f(g1[i] * c1), y, y)); }
                    st8(ZU + row * 256 + pn * HALF + cw, r0, r1); }
        } else if (pn < 6) {
            const bool isq = pn < 4; bf16_t* Z = isq ? ZQ : ZK; const float sc = isq ? 0.125f * 1.4426950408889634f : 1.0f;
            const int ct = (pn & 1) * 256; const bool rot = ((wc & 1) == 0) && (fq < 2);
#pragma unroll
            for (int ai = 0; ai < 2; ++ai) {
                f32x4 cs[4][2];
#pragma unroll
                for (int q = 0; q < 4; ++q) { cs[q][0] = (f32x4){1.f, 0.f, 1.f, 0.f}; cs[q][1] = (f32x4){1.f, 0.f, 1.f, 0.f};
                    if (rot) { const float* rp = rope + (size_t)((row0 + ai * HALF + q * 16) & (SEQ - 1)) * 16 + 8 * fq; cs[q][0] = *(const f32x4*)rp; cs[q][1] = *(const f32x4*)(rp + 4); } }
#pragma unroll
                for (int m = 0; m < 4; ++m) { const int rowi = row0 + ai * HALF + m * 16; const size_t row = (size_t)rowi; const float scr_ = sc * RowScale::rs(rb, rl0 + ai * HALF + m * 16);
                    const f32x4 cs0 = cs[m][0], cs1 = cs[m][1];
#pragma unroll
                    for (int bj = 0; bj < 2; ++bj) { f32x4 x1 = acc[ai][bj][m][0], x2 = acc[ai][bj][m][1], y1, y2;
                        y1[0] = x1[0] * cs0[0] - x2[0] * cs0[1]; y2[0] = x2[0] * cs0[0] + x1[0] * cs0[1];
                        y1[1] = x1[1] * cs0[2] - x2[1] * cs0[3]; y2[1] = x2[1] * cs0[2] + x1[1] * cs0[3];
                        y1[2] = x1[2] * cs1[0] - x2[2] * cs1[1]; y2[2] = x2[2] * cs1[0] + x1[2] * cs1[1];
                        y1[3] = x1[3] * cs1[2] - x2[3] * cs1[3]; y2[3] = x2[3] * cs1[2] + x1[3] * cs1[3];
                        st8(Z + row * 512 + ct + bj * HALF + cw, y1 * scr_, y2 * scr_); } } }
        } else if (pn < 11) {
            bf16_t* Z = pn < 8 ? ZV : ZG; const int ld = pn < 8 ? 512 : 768, ct = pn < 8 ? (pn - 6) * 256 : (pn - 8) * 256;
#pragma unroll
            for (int ai = 0; ai < 2; ++ai)
#pragma unroll
                for (int m = 0; m < 4; ++m) { const size_t row = (size_t)(row0 + ai * HALF + m * 16); const float rs = RowScale::rs(rb, rl0 + ai * HALF + m * 16);
#pragma unroll
                    for (int bj = 0; bj < 2; ++bj) st8(Z + row * ld + ct + bj * HALF + cw, acc[ai][bj][m][0] * rs, acc[ai][bj][m][1] * rs); }
        } else {
            const f32x4 b0 = *(const f32x4*)(bgate + cw), b1 = *(const f32x4*)(bgate + cw + 4);
#pragma unroll
            for (int ai = 0; ai < 2; ++ai)
#pragma unroll
                for (int m = 0; m < 4; ++m) { const size_t row = (size_t)(row0 + ai * HALF + m * 16); const float rs = RowScale::rs(rb, rl0 + ai * HALF + m * 16); f32x4 x0 = acc[ai][0][m][0] * rs + b0, x1 = acc[ai][0][m][1] * rs + b1, l0, l1;
#pragma unroll
                    for (int i = 0; i < 4; ++i) {
                        l0[i] = __builtin_fmaf(__builtin_amdgcn_logf(1.f + __builtin_amdgcn_exp2f(-1.4426950408889634f * fabsf(x0[i]))), -0.6931471805599453f * 0.0625f, fminf(x0[i], 0.f) * 0.0625f);
                        l1[i] = __builtin_fmaf(__builtin_amdgcn_logf(1.f + __builtin_amdgcn_exp2f(-1.4426950408889634f * fabsf(x1[i]))), -0.6931471805599453f * 0.0625f, fminf(x1[i], 0.f) * 0.0625f); }
                    st16f_wt(LA + row * 128 + cw, l0); st16f_wt(LA + row * 128 + cw + 4, l1); }
        }
    }
};
struct GroupedOrder {
    const PG8_LAS int* tb; int nN, G, c;
    __device__ __forceinline__ bool next(int i, Unit& u) const {
        const int total = tb[NEXPG] * nN; const long L = (long)i * G + c; if (L >= total) return false;
        return map((int)L, total, u); }
    __device__ __forceinline__ bool map(int L, int total, Unit& u) const {
        int wgid = L; { const int q = total / NXCD, r = total % NXCD, xcd = wgid % NXCD, off = wgid / NXCD; wgid = (xcd < r ? xcd * (q + 1) : r * (q + 1) + (xcd - r) * q) + off; }
        int e = 0;
#pragma unroll
        for (int j = 1; j < NEXPG; ++j) if (wgid >= tb[j] * nN) e = j;
        const int loc = wgid - tb[e] * nN, nMe = tb[e + 1] - tb[e];
        const int nig = WGM * nN, gid = loc / nig, fm = gid * WGM, gsz = (nMe - fm) < WGM ? (nMe - fm) : WGM;
        u.pm = tb[e] + fm + ((loc % nig) % gsz); u.pn = (loc % nig) / gsz; u.pe = e; u.k0t = 0; u.ntu = 0; u.slot = -1; u.q = 0; return true;
    }
    __device__ __forceinline__ void a_ready(const Unit&) const {}
    __device__ __forceinline__ void done(const Unit&) const {}
};
struct GroupedOrderSplit {
    GroupedOrder base; int ntq;
    __device__ __forceinline__ bool next(int i, Unit& u) const {
        const int total = base.tb[NEXPG] * base.nN, G = base.G, c = base.c;
        if (i < 4) { const int L = i * G + c; if (L >= total) return false; return base.map(L, total, u); }
        if (i > 4) return false;
        const int n5 = total - 4 * G; if (c >= 4 * n5) return false;
        if (!base.map(4 * G + (c >> 2), total, u)) return false;
        u.q = c & 3; u.slot = c >> 2; u.k0t = u.q * ntq; u.ntu = ntq; return true;
    }
    __device__ __forceinline__ void a_ready(const Unit&) const {}
    __device__ __forceinline__ void done(const Unit&) const {}
};
struct EpiBf16Split {
    static constexpr bool PERM = true, AFTER_DRAIN = false;
    bf16_t* O; int ldc; bf16_t* P;
    __device__ __forceinline__ void operator()(const f32x4 (&acc)[2][2][4][2], const Unit& u, int wr, int wc, int fr, int fq) const {
        const bool sp = u.slot >= 0; const int ld = sp ? 256 : ldc;
        bf16_t* base = sp ? P + (size_t)(u.q * 32 + u.slot) * 65536 + (size_t)(wr * 64 + fr) * 256 + wc * 32 + 8 * fq : O + (size_t)(u.pm * BM + wr * 64 + fr) * ldc + u.pn * BM + wc * 32 + 8 * fq;
#pragma unroll
        for (int ai = 0; ai < 2; ++ai)
#pragma unroll
            for (int m = 0; m < 4; ++m) { bf16_t* rowp = base + (size_t)(ai * HALF + m * 16) * ld;
#pragma unroll
                for (int bj = 0; bj < 2; ++bj) { const f32x4 v0 = acc[ai][bj][m][0], v1 = acc[ai][bj][m][1];
                    u32x4 w; w.x = cvt_pk_bf16(v0[0], v0[1]); w.y = cvt_pk_bf16(v0[2], v0[3]); w.z = cvt_pk_bf16(v1[0], v1[1]); w.w = cvt_pk_bf16(v1[2], v1[3]);
                    st16_nt(rowp + bj * HALF, w); } }
    }
};
template <class Epi, class Sched, bool ALIGN_EPI = false, bool SP2 = false>
__device__ __forceinline__ void gemm_phase(PG8_LAS unsigned char* lds, const Gemm g, const Sched& S, const Epi& E, const int wid_in) {
    const int lane = lane_now(), wid = wid_in, tid = wid * 64 + lane,
              wr = wid >> 2, wc = wid & 3, fr = lane & 15, fq = lane >> 4;
    const int K = g.K, nt = K / BK;
    unsigned voffA[2], voffB[2];
#pragma unroll
    for (int i = 0; i < 2; ++i) { int R, C; stage_rc(tid * 16 + i * 8192, R, C); const int Rb = Epi::PERM ? ((R & ~31) + perm32(R & 31)) : R;
        voffA[i] = (unsigned)(R * K + C) * 2u; voffB[i] = (unsigned)(Rb * K + C) * 2u; }
    const size_t kstep = (size_t)(BK * 2);
    const size_t hstep = (size_t)HALF * K * 2;
    const size_t tstep = 2 * hstep;
    const unsigned ldsw = (unsigned)wid * 1024u;
    const int aoff = lds_byte(wr * 64 + fr, fq * 8), boff = lds_byte(wc * 32 + fr, fq * 8);
#define PG8_SA(b, h) (((b) * 2 + (h)) * HTB)
#define PG8_SB(b, h) ((4 + (b) * 2 + (h)) * HTB)
#define PG8_STAGE(bufoff, gbase, voff) do { _Pragma("unroll") for (int _i = 0; _i < 2; ++_i) \
        __builtin_amdgcn_global_load_lds((const unsigned*)((const char*)(gbase) + (voff)[_i]), (PG8_LAS unsigned*)(lds + (bufoff) + ldsw + _i * 8192), 16, 0, 0); } while (0)
#define PG8_LDA(dst, b, h) do { _Pragma("unroll") for (int m = 0; m < 4; ++m) _Pragma("unroll") for (int k = 0; k < 2; ++k) dst[m][k] = *(const PG8_LAS bf16x8*)(lds + PG8_SA(b, h) + aoff + m * 2048 + k * 1024); } while (0)
#define PG8_LDB(dst, b, h) do { _Pragma("unroll") for (int n = 0; n < 2; ++n) _Pragma("unroll") for (int k = 0; k < 2; ++k) dst[n][k] = *(const PG8_LAS bf16x8*)(lds + PG8_SB(b, h) + boff + n * 2048 + k * 1024); } while (0)
#define PG8_MMA(ai, bj, At, Bt) do { __builtin_amdgcn_s_setprio(1); _Pragma("unroll") for (int m = 0; m < 4; ++m) _Pragma("unroll") for (int n = 0; n < 2; ++n) _Pragma("unroll") for (int k = 0; k < 2; ++k) \
        acc[ai][bj][m][n] = __builtin_amdgcn_mfma_f32_16x16x32_bf16(Bt[n][k], At[m][k], acc[ai][bj][m][n], 0, 0, 0); __builtin_amdgcn_s_setprio(0); } while (0)
#define PG8_WAIT_V(n) asm volatile("s_waitcnt vmcnt(" #n ")" ::: "memory")
#define PG8_WAIT_L(n) asm volatile("s_waitcnt lgkmcnt(" #n ")" ::: "memory")
#define PG8_BAR __builtin_amdgcn_s_barrier()
#define PG8_SCHED __builtin_amdgcn_sched_barrier(0)
    Unit cur, nxt; int ui = 0;
    if (!S.next(0, cur)) return;
    f32x4 acc[2][2][4][2];
#pragma unroll
    for (int a = 0; a < 2; ++a)
#pragma unroll
        for (int b = 0; b < 2; ++b)
#pragma unroll
            for (int m = 0; m < 4; ++m)
#pragma unroll
                for (int n = 0; n < 2; ++n) acc[a][b][m][n] = (f32x4){0.f, 0.f, 0.f, 0.f};
    bf16x8 At[4][2], B0[2][2], B1[2][2];
    const char* cA = (const char*)g.A + (size_t)cur.pm * tstep + (size_t)cur.k0t * (BK * 2); const char* cB = (const char*)g.Bt + (size_t)cur.pe * g.bstride + (size_t)cur.pn * tstep + (size_t)cur.k0t * (BK * 2);
    S.a_ready(cur);
    if constexpr (SP2) {
        PG8_STAGE(PG8_SB(0, 0), cB, voffB); PG8_STAGE(PG8_SB(0, 1), cB + hstep, voffB); PG8_STAGE(PG8_SA(0, 0), cA, voffA); PG8_STAGE(PG8_SA(0, 1), cA + hstep, voffA);
        if (wr == 1) PG8_BAR;
        PG8_WAIT_V(2); PG8_BAR;
        PG8_STAGE(PG8_SB(1, 0), cB + kstep, voffB); PG8_STAGE(PG8_SA(1, 0), cA + kstep, voffA); PG8_STAGE(PG8_SB(1, 1), cB + hstep + kstep, voffB);
        PG8_WAIT_V(6); PG8_BAR;
    } else {
        PG8_STAGE(PG8_SB(0, 0), cB, voffB); PG8_STAGE(PG8_SA(0, 0), cA, voffA); PG8_STAGE(PG8_SB(0, 1), cB + hstep, voffB); PG8_STAGE(PG8_SA(0, 1), cA + hstep, voffA);
        if (wr == 1) PG8_BAR;
        PG8_WAIT_V(4); PG8_BAR;
        PG8_STAGE(PG8_SB(1, 0), cB + kstep, voffB); PG8_STAGE(PG8_SA(1, 0), cA + kstep, voffA); PG8_STAGE(PG8_SB(1, 1), cB + hstep + kstep, voffB);
        PG8_WAIT_V(6); PG8_BAR;
    }
    for (;;) {
        const bool has_next = S.next(ui + 1, nxt);
        const char* nA = has_next ? (const char*)g.A + (size_t)nxt.pm * tstep + (size_t)nxt.k0t * kstep : cA; const char* nB = has_next ? (const char*)g.Bt + (size_t)nxt.pe * g.bstride + (size_t)nxt.pn * tstep + (size_t)nxt.k0t * kstep : cB;
        const int ntc = cur.ntu ? cur.ntu : nt;
        GT_START(lds, wid, 41); GT_CSTART(lds, wid, 42);
        for (int t = 0; t < ntc; t += 2) {
            const bool last = (t == ntc - 2);
            const char* a1 = cA + (size_t)(t + 1) * kstep;
            const char* a2 = last ? nA : cA + (size_t)(t + 2) * kstep; const char* b2 = last ? nB : cB + (size_t)(t + 2) * kstep;
            const char* a3 = a2 + kstep; const char* b3 = b2 + kstep;
            if (last && has_next) S.a_ready(nxt);
            if constexpr (SP2) {
            PG8_LDB(B0, 0, 0); PG8_LDB(B1, 0, 1); PG8_SCHED; PG8_LDA(At, 0, 0); PG8_STAGE(PG8_SA(1, 1), a1 + hstep, voffA);
            PG8_WAIT_V(8); PG8_WAIT_L(0); PG8_BAR; PG8_MMA(0, 0, At, B0); PG8_MMA(0, 1, At, B1); PG8_BAR; PG8_SCHED;
            PG8_LDA(At, 0, 1); PG8_STAGE(PG8_SB(0, 0), b2, voffB); PG8_STAGE(PG8_SB(0, 1), b2 + hstep, voffB); PG8_STAGE(PG8_SA(0, 0), a2, voffA);
            PG8_WAIT_V(8); PG8_WAIT_L(0); PG8_BAR; PG8_MMA(1, 0, At, B0); PG8_MMA(1, 1, At, B1); PG8_BAR; PG8_SCHED;
            PG8_LDB(B0, 1, 0); PG8_LDB(B1, 1, 1); PG8_SCHED; PG8_LDA(At, 1, 0); PG8_STAGE(PG8_SA(0, 1), a2 + hstep, voffA);
            PG8_WAIT_V(8); PG8_WAIT_L(0); PG8_BAR; PG8_MMA(0, 0, At, B0); PG8_MMA(0, 1, At, B1); PG8_BAR; PG8_SCHED;
            PG8_LDA(At, 1, 1); PG8_STAGE(PG8_SB(1, 0), b3, voffB); PG8_STAGE(PG8_SB(1, 1), b3 + hstep, voffB); PG8_STAGE(PG8_SA(1, 0), a3, voffA);
            PG8_WAIT_V(8); PG8_WAIT_L(0); PG8_BAR; PG8_MMA(1, 0, At, B0); PG8_MMA(1, 1, At, B1); PG8_BAR; PG8_SCHED;
            } else {
            PG8_LDB(B0, 0, 0); PG8_SCHED; PG8_LDA(At, 0, 0); PG8_STAGE(PG8_SA(1, 1), a1 + hstep, voffA);
            PG8_WAIT_L(8); PG8_BAR; PG8_WAIT_L(0); PG8_MMA(0, 0, At, B0); PG8_BAR; PG8_SCHED;
            PG8_LDB(B1, 0, 1); PG8_STAGE(PG8_SB(0, 0), b2, voffB);
            PG8_BAR; PG8_WAIT_L(0); PG8_MMA(0, 1, At, B1); PG8_BAR;
            PG8_LDA(At, 0, 1); PG8_STAGE(PG8_SA(0, 0), a2, voffA);
            PG8_BAR; PG8_WAIT_L(0); PG8_MMA(1, 0, At, B0); PG8_BAR; PG8_SCHED;
            PG8_STAGE(PG8_SB(0, 1), b2 + hstep, voffB);
            PG8_WAIT_V(6); PG8_BAR; PG8_MMA(1, 1, At, B1); PG8_BAR;
            PG8_LDB(B0, 1, 0); PG8_SCHED; PG8_LDA(At, 1, 0); PG8_STAGE(PG8_SA(0, 1), a2 + hstep, voffA);
            PG8_WAIT_L(8); PG8_BAR; PG8_WAIT_L(0); PG8_MMA(0, 0, At, B0); PG8_BAR; PG8_SCHED;
            PG8_LDB(B1, 1, 1); PG8_STAGE(PG8_SB(1, 0), b3, voffB);
            PG8_BAR; PG8_WAIT_L(0); PG8_MMA(0, 1, At, B1); PG8_BAR;
            PG8_LDA(At, 1, 1); PG8_STAGE(PG8_SA(1, 0), a3, voffA);
            PG8_BAR; PG8_WAIT_L(0); PG8_MMA(1, 0, At, B0); PG8_BAR; PG8_SCHED;
            PG8_STAGE(PG8_SB(1, 1), b3 + hstep, voffB);
            PG8_WAIT_V(6); PG8_BAR; PG8_MMA(1, 1, At, B1); PG8_BAR;
            }
        }
        GT_STOP(lds, wid, 41); GT_CSTOP(lds, wid, 42);
        if constexpr (ALIGN_EPI) { if (wr == 0) PG8_BAR; }
        GT_START(lds, wid, 40); if constexpr (!Epi::AFTER_DRAIN) { const int l2_ = lane_now(); E(acc, cur, wr, wc, l2_ & 15, l2_ >> 4); S.done(cur); } GT_STOP(lds, wid, 40);
        if (!has_next) break;
#pragma unroll
        for (int a = 0; a < 2; ++a)
#pragma unroll
            for (int b = 0; b < 2; ++b)
#pragma unroll
                for (int m = 0; m < 4; ++m)
#pragma unroll
                    for (int n = 0; n < 2; ++n) acc[a][b][m][n] = (f32x4){0.f, 0.f, 0.f, 0.f};
        cur = nxt; cA = nA; cB = nB; ++ui;
        if constexpr (ALIGN_EPI) { if (wr == 1) PG8_BAR; }
    }
    PG8_WAIT_V(0);
    if constexpr (!ALIGN_EPI) { if (wr == 0) PG8_BAR; }
    PG8_BAR;
    if constexpr (Epi::AFTER_DRAIN) { E.fused(acc, cur, wr, wc, lane & 15, lane >> 4, lds, wid, lane); S.done(cur); }
#undef PG8_SA
#undef PG8_SB
#undef PG8_STAGE
#undef PG8_LDA
#undef PG8_LDB
#undef PG8_MMA
#undef PG8_WAIT_V
#undef PG8_WAIT_L
#undef PG8_BAR
#undef PG8_SCHED
}
}
#define PG8_SP2 true
#define PG8_ALIGN true
#include <hip/hip_bf16.h>
#include <cmath>
namespace attn_body {
using bf16=__hip_bfloat16;
using bf16x8=__attribute__((ext_vector_type(8)))short;
using s16x4=__attribute__((ext_vector_type(4)))short;
using f32x16=__attribute__((ext_vector_type(16)))float;
using u32x4=__attribute__((ext_vector_type(4)))unsigned;
constexpr int BATCH=4,NHEAD=16,SEQ=8192,D=64;
constexpr int QP=512,KP=512,VP=512,OP=1024;
constexpr int NW=8,QBLK=32,QB=QBLK*NW,KVBLK=64,NQB=SEQ/QB;
constexpr int ATTN_UNIT_ROWS=QB;
__device__ __forceinline__ int crow(int r,int hi){return (r&3)+8*(r>>2)+4*hi;}
#define SBAR() __builtin_amdgcn_sched_barrier(0)
__device__ __forceinline__ void cmask(f32x16&p0,f32x16&p1,int jb,int qrel,int hi){
  const float NEG=-INFINITY; (void)hi;
  if(jb>(qrel>>6)){
  #pragma unroll
  for(int r=0;r<16;++r){p0[r]=NEG;p1[r]=NEG;} }
}
constexpr int NSLOT=3, SLOTB=8192;
constexpr int SLOTV=2*SLOTB;
constexpr int LDS_K=0, LDS_V=NSLOT*SLOTB, LDS_WS=LDS_V+NSLOT*SLOTV, LDS_OST=LDS_WS+NW*64*4, LDS_BYTES=LDS_OST+NW*4096;
constexpr float C2=0.125f*1.4426950408889634f;
__device__ __forceinline__ void glds16(const void*gsrc,unsigned lds_dst){unsigned keep;
  asm volatile("s_mov_b32 %0, m0\n\ts_mov_b32 m0, %2\n\ts_nop 0\n\tglobal_load_lds_dwordx4 %1, off\n\ts_mov_b32 m0, %0":"=&s"(keep):"v"(gsrc),"s"(lds_dst):"memory");}
__device__ __forceinline__ float max3f(float a,float b,float c){float r;asm("v_max3_f32 %0, %1, %2, %3":"=v"(r):"v"(a),"v"(b),"v"(c));return r;}
__device__ __forceinline__ float max2f(float a,float b){float r;asm("v_max_f32_e32 %0, %1, %2":"=v"(r):"v"(a),"v"(b));return r;}
__device__ __forceinline__ float fadd_s(float a,float b){float r;asm("v_add_f32_e32 %0, %1, %2":"=v"(r):"v"(a),"v"(b));return r;}
__device__ __forceinline__ float fsub_s(float a,float b){float r;asm("v_sub_f32_e32 %0, %1, %2":"=v"(r):"v"(a),"v"(b));return r;}
typedef float f32x2_t __attribute__((ext_vector_type(2))); typedef __bf16 bf16x2_t __attribute__((ext_vector_type(2)));
__device__ __forceinline__ unsigned cvtpk_s(float lo,float hi){f32x2_t v={lo,hi};bf16x2_t b=__builtin_convertvector(v,bf16x2_t);return __builtin_bit_cast(unsigned,b);}
#define WAIT_BAR(N) asm volatile("s_waitcnt vmcnt(" #N ") lgkmcnt(0)\n\ts_barrier":::"memory")

__device__ __forceinline__ void qkt(f32x16&p0,f32x16&p1,const char*Kslot,const bf16x8*qr,const f32x16&negm,int r32,int hi){
  const char*kb=Kslot+hi*1024+r32*16;
  #pragma unroll
  for(int d0=0;d0<4;++d0){
    const bf16x8 b0=*reinterpret_cast<const bf16x8*>(kb+d0*2048);
    const bf16x8 b1=*reinterpret_cast<const bf16x8*>(kb+d0*2048+512);
    if(d0==0){p0=__builtin_amdgcn_mfma_f32_32x32x16_bf16(b0,qr[0],negm,0,0,0);p1=__builtin_amdgcn_mfma_f32_32x32x16_bf16(b1,qr[0],negm,0,0,0);}
    else{p0=__builtin_amdgcn_mfma_f32_32x32x16_bf16(b0,qr[d0],p0,0,0,0);p1=__builtin_amdgcn_mfma_f32_32x32x16_bf16(b1,qr[d0],p1,0,0,0);}}
}
typedef __attribute__((address_space(3))) const char* lds_cptr;
typedef short v4i16_t __attribute__((ext_vector_type(4)));
__device__ __forceinline__ void kload8(bf16x8*kf,lds_cptr kp){
  kf[0]=*(const __attribute__((address_space(3))) bf16x8*)(kp);      kf[1]=*(const __attribute__((address_space(3))) bf16x8*)(kp+512);
  kf[2]=*(const __attribute__((address_space(3))) bf16x8*)(kp+2048); kf[3]=*(const __attribute__((address_space(3))) bf16x8*)(kp+2560);
  kf[4]=*(const __attribute__((address_space(3))) bf16x8*)(kp+4096); kf[5]=*(const __attribute__((address_space(3))) bf16x8*)(kp+4608);
  kf[6]=*(const __attribute__((address_space(3))) bf16x8*)(kp+6144); kf[7]=*(const __attribute__((address_space(3))) bf16x8*)(kp+6656);
}
__device__ __forceinline__ void kload2(bf16x8*kf,lds_cptr kp,int j){ kf[2*j]=*(const __attribute__((address_space(3))) bf16x8*)(kp+j*2048); kf[2*j+1]=*(const __attribute__((address_space(3))) bf16x8*)(kp+j*2048+512); }
__device__ __forceinline__ s16x4 vtr(lds_cptr p){ return __builtin_bit_cast(s16x4,__builtin_amdgcn_ds_read_tr16_b64_v4i16((__attribute__((address_space(3))) v4i16_t*)p)); }
__device__ __forceinline__ float rowmax(const f32x16&p0,const f32x16&p1){
  float a=max3f(p0[0],p0[1],p1[0]),b=max3f(p0[2],p0[3],p1[1]);a=max3f(a,p1[2],p1[3]);
  #pragma unroll
  for(int r=4;r<16;r+=4){a=max3f(a,p0[r],p0[r+1]);b=max3f(b,p0[r+2],p0[r+3]);a=max3f(a,p1[r],p1[r+1]);b=max3f(b,p1[r+2],p1[r+3]);}
  const float m=max2f(a,b);
  auto rr=__builtin_amdgcn_permlane32_swap(__float_as_uint(m),__float_as_uint(m),false,false);
  return max2f(__uint_as_float(rr[0]),__uint_as_float(rr[1]));
}
__device__ __forceinline__ void pv(f32x16*o,int vb,bf16x8 pa0,bf16x8 pa1,bf16x8 pa2,bf16x8 pa3){
  #pragma unroll
  for(int d0=0;d0<2;++d0){s16x4 lo[4],hi[4];
    #pragma unroll
    for(int ks=0;ks<4;++ks){
      asm volatile("ds_read_b64_tr_b16 %0,%1 offset:%c2":"=&v"(lo[ks]):"v"(vb),"i"(d0*4096+ks*1024):"memory");
      asm volatile("ds_read_b64_tr_b16 %0,%1 offset:%c2":"=&v"(hi[ks]):"v"(vb),"i"(d0*4096+ks*1024+512):"memory");}
    asm volatile("s_waitcnt lgkmcnt(0)":::"memory");SBAR();
    #define PK(k) (bf16x8){lo[k][0],lo[k][1],lo[k][2],lo[k][3],hi[k][0],hi[k][1],hi[k][2],hi[k][3]}
    o[d0]=__builtin_amdgcn_mfma_f32_32x32x16_bf16(pa0,PK(0),o[d0],0,0,0);
    o[d0]=__builtin_amdgcn_mfma_f32_32x32x16_bf16(pa1,PK(1),o[d0],0,0,0);
    o[d0]=__builtin_amdgcn_mfma_f32_32x32x16_bf16(pa2,PK(2),o[d0],0,0,0);
    o[d0]=__builtin_amdgcn_mfma_f32_32x32x16_bf16(pa3,PK(3),o[d0],0,0,0);
    #undef PK
  }
}

#ifndef ATTN_STORE16
#define ATTN_STORE16(p,v) st16_wt((void*)(p),(v))
#endif
template<int THRL> __device__ __forceinline__ void attn_unit(int b,int qcol,int vcol,int ocol,int qb,const bf16*Q,const bf16*__restrict__ K,const bf16*__restrict__ V,bf16*O,char*shm,const int wid_in){
  const int lane=lane_now(),r32=lane&31,hi=lane>>5; const int wid=wid_in; const int tid=wid*64+lane; (void)tid;
  const long rowbase=(long)b*SEQ; const int q0=qb*QB;
  const bf16*Qw=Q+(rowbase+q0+wid*QBLK)*QP+qcol;
  const bf16*Kh=K+rowbase*KP+qcol,*Vh=V+rowbase*VP+vcol;
  const unsigned lds0=(unsigned)(uintptr_t)shm;
  float*wsf=(float*)(shm+LDS_WS)+wid*64;
  const bf16*ksrc=Kh+(long)lane*KP+wid*8;
  const bf16*vsrc=Vh+(long)(16*(wid&3)+(lane>>2))*VP+(wid>>2)*32+(lane&3)*8;
  const unsigned kdst=lds0+LDS_K+wid*1024, vdst=lds0+LDS_V+wid*1024;
  #define DMA_K(t,slot) glds16(ksrc+(long)(t)*KVBLK*KP,(unsigned)__builtin_amdgcn_readfirstlane(kdst+(slot)))
  #define DMA_V(t,slot) do{ glds16(vsrc+(long)(t)*KVBLK*VP,(unsigned)__builtin_amdgcn_readfirstlane(vdst+(slot))); glds16(vsrc+64+(long)(t)*KVBLK*VP,(unsigned)__builtin_amdgcn_readfirstlane(vdst+(slot)+8192)); }while(0)
  const int vb0=(int)(lds0+LDS_V)+((lane>>4)&1)*32+(lane&3)*8+(4*hi+((lane&15)>>2))*64;
  const char*Kbase=shm+LDS_K; bf16x8 kf[8];
  const lds_cptr shm3=(lds_cptr)shm; const lds_cptr kp0=shm3+LDS_K+hi*1024+r32*16; const lds_cptr vp0=shm3+LDS_V+((lane>>4)&1)*32+(lane&3)*8+(4*hi+((lane&15)>>2))*64;
  const int NT=(q0+QB)/KVBLK;
  DMA_K(0,0);DMA_V(0,0);DMA_K(1,SLOTB);
  bf16x8 qr[4];
  #pragma unroll
  for(int d0=0;d0<4;++d0)qr[d0]=*reinterpret_cast<const bf16x8*>(&Qw[(long)r32*QP+d0*16+hi*8]);
  float mhat=0.f,l_reg=0.f;f32x16 o[4];o[0]=f32x16{};o[1]=f32x16{};o[2]=f32x16{};o[3]=f32x16{};
  const int qrel=wid*QBLK+r32;
  #define CMASK(P0,P1,t) do{int jb_=(t)-(NT-4); if(jb_>=0)cmask(P0,P1,jb_,qrel,hi);}while(0)
  bool resc=false;
  #define START(P0,P1) do{ const float rm=rowmax(P0,P1); resc=false; \
    { const float dl=rm; mhat=fadd_s(mhat,dl); \
      _Pragma("unroll") for(int r=0;r<16;++r){P0[r]=fsub_s(P0[r],dl);P1[r]=fsub_s(P1[r],dl);} \
      } \
    _Pragma("unroll") for(int r=0;r<16;++r)P0[r]=__builtin_amdgcn_exp2f(P0[r]); }while(0)
  #define RESC() do{ if(resc){ asm volatile("s_waitcnt lgkmcnt(0)":::"memory"); \
      _Pragma("unroll") for(int d_=0;d_<4;++d_) _Pragma("unroll") for(int r=0;r<16;++r)o[d_][r]*=wsf[crow(r,hi)]; } }while(0)
  f32x16 pA0,pA1,pB0,pB1;
  int sl_prev=0,sl_cur=0,sl_next=SLOTB;
  #define ROT() do{sl_prev=sl_cur;sl_cur=sl_next;sl_next=(sl_next==(NSLOT-1)*SLOTB)?0:sl_next+SLOTB;}while(0)
  DMA_K(2,2*SLOTB);
  WAIT_BAR(4);
  qkt(pA0,pA1,Kbase,qr,f32x16{},r32,hi);asm volatile("s_nop 15\n\ts_nop 7":"+v"(pA0),"+v"(pA1));CMASK(pA0,pA1,0);
  START(pA0,pA1);
  _Pragma("unroll") for(int r=0;r<16;++r)pA1[r]=__builtin_amdgcn_exp2f(pA1[r]);
  WAIT_BAR(0);
  DMA_K(3,0);DMA_V(1,2*SLOTB);
  ROT();
  kload8(kf,kp0+sl_cur);
  WAIT_BAR(3);
  s16x4 vlo[8],vhi[8]; u32x4 pw0,pw1,pw2,pw3;
  #define PKW(P,B) cvtpk_s(P[B],P[B+1])
  #define PAF(k) __builtin_bit_cast(bf16x8,pw##k)
  #define VFR(i) (bf16x8){vlo[i][0],vlo[i][1],vlo[i][2],vlo[i][3],vhi[i][0],vhi[i][1],vhi[i][2],vhi[i][3]}
  #define PIN(x) asm volatile("":"+v"(x))
  #define MX3(a,b,c) __builtin_fmaxf(__builtin_fmaxf((a),(b)),(c))
  #define GAPA(MF,A0,A1,A2,A3,W0,W1,PW) do{ MF; sacc+=A0; sacc+=A1; sacc+=A2; sacc+=A3; PIN(sacc); W0; W1; PIN(PW); SBAR(); }while(0)
  #define EX(v) __builtin_amdgcn_exp2f(v)
  #define GAPB(MF,X,B) do{ MF; X[B]=EX(X[B]); X[B+1]=EX(X[B+1]); X[B+2]=EX(X[B+2]); X[B+3]=EX(X[B+3]); PIN(X); SBAR(); }while(0)
  #define VRD(i) do{ vlo[i]=vtr(vp_+(((i)>>2)*4096+((i)&3)*1024)); vhi[i]=vtr(vp_+(((i)>>2)*4096+((i)&3)*1024+512)); }while(0)
  #define VRD2(i) do{ vlo[i]=vtr(vp_+(8192+((i)>>2)*4096+((i)&3)*1024)); vhi[i]=vtr(vp_+(8192+((i)>>2)*4096+((i)&3)*1024+512)); }while(0)
  #define GAPB2(MF,X,B,i) do{ MF; VRD2(i); X[B]=EX(X[B]); X[B+1]=EX(X[B+1]); X[B+2]=EX(X[B+2]); X[B+3]=EX(X[B+3]); PIN(X); SBAR(); }while(0)
  #define KRD(G,j) do{ if(G){ kload2(kf,kp0+sl_next,j); SBAR(); } }while(0)
  #define STEP(C0,C1,P0,P1,t,GK,GV,GL) do{ SBAR(); \
    const lds_cptr vp_=vp0+2*sl_prev; \
    VRD(0); SBAR(); float sacc=(P0[0]+P0[1]); \
    GAPA(C0=__builtin_amdgcn_mfma_f32_32x32x16_bf16(kf[0],qr[0],f32x16{},0,0,0), P0[2],P0[3],P0[4],P0[5],     pw0[0]=PKW(P0,0), pw0[1]=PKW(P0,2), pw0); \
    VRD(4); SBAR(); GAPA(C1=__builtin_amdgcn_mfma_f32_32x32x16_bf16(kf[1],qr[0],f32x16{},0,0,0), P0[6],P0[7],P0[8],P0[9],     pw0[2]=PKW(P0,4), pw0[3]=PKW(P0,6), pw0); \
    VRD(1); SBAR(); GAPA(C0=__builtin_amdgcn_mfma_f32_32x32x16_bf16(kf[2],qr[1],C0,0,0,0),   P0[10],P0[11],P0[12],P0[13], pw1[0]=PKW(P0,8), pw1[1]=PKW(P0,10), pw1); \
    VRD(5); SBAR(); GAPA(C1=__builtin_amdgcn_mfma_f32_32x32x16_bf16(kf[3],qr[1],C1,0,0,0),   P0[14],P0[15],P1[0],P1[1],   pw1[2]=PKW(P0,12),pw1[3]=PKW(P0,14), pw1); \
    VRD(2); SBAR(); GAPA(C0=__builtin_amdgcn_mfma_f32_32x32x16_bf16(kf[4],qr[2],C0,0,0,0),   P1[2],P1[3],P1[4],P1[5],     pw2[0]=PKW(P1,0), pw2[1]=PKW(P1,2), pw2); \
    VRD(6); SBAR(); GAPA(C1=__builtin_amdgcn_mfma_f32_32x32x16_bf16(kf[5],qr[2],C1,0,0,0),   P1[6],P1[7],P1[8],P1[9],     pw2[2]=PKW(P1,4), pw2[3]=PKW(P1,6), pw2); \
    VRD(3); SBAR(); GAPA(C0=__builtin_amdgcn_mfma_f32_32x32x16_bf16(kf[6],qr[3],C0,0,0,0),   P1[10],P1[11],P1[12],P1[13], pw3[0]=PKW(P1,8), pw3[1]=PKW(P1,10), pw3); \
    VRD(7); SBAR(); GAPA(C1=__builtin_amdgcn_mfma_f32_32x32x16_bf16(kf[7],qr[3],C1,0,0,0),   P1[14],P1[15],0.f,0.f,       pw3[2]=PKW(P1,12),pw3[3]=PKW(P1,14), pw3); \
    l_reg+=sacc; \
    if(GK){DMA_K((t)+3,sl_cur);} if(GV){DMA_V((t)+1,2*sl_next);} \
    _Pragma("unroll") for(int r=0;r<16;++r){C0[r]-=mhat;C1[r]-=mhat;} \
    CMASK(C0,C1,t); \
    { float a=MX3(C0[0],C0[1],C1[0]),b=MX3(C0[2],C0[3],C1[1]); a=MX3(a,C1[2],C1[3]); \
      _Pragma("unroll") for(int r=4;r<16;r+=4){a=MX3(a,C0[r],C0[r+1]);b=MX3(b,C0[r+2],C0[r+3]);a=MX3(a,C1[r],C1[r+1]);b=MX3(b,C1[r+2],C1[r+3]);} \
      float rm=__builtin_fmaxf(a,b); { auto rr=__builtin_amdgcn_permlane32_swap(__float_as_uint(rm),__float_as_uint(rm),false,false); rm=__builtin_fmaxf(__uint_as_float(rr[0]),__uint_as_float(rr[1])); } \
      resc=false; \
      if(__builtin_expect(__any(rm>(float)THRL),0)){ const float dl=__builtin_fmaxf(rm,0.f); mhat+=dl; \
        _Pragma("unroll") for(int r=0;r<16;++r){C0[r]-=dl;C1[r]-=dl;} \
        const float f=__builtin_amdgcn_exp2f(-dl); l_reg*=f; if(hi==0)wsf[r32]=f; resc=true; } } \
    SBAR(); \
    GAPB2(o[0]=__builtin_amdgcn_mfma_f32_32x32x16_bf16(PAF(0),VFR(0),o[0],0,0,0), C0,0,0); \
    GAPB2(o[1]=__builtin_amdgcn_mfma_f32_32x32x16_bf16(PAF(0),VFR(4),o[1],0,0,0), C0,4,4); \
    KRD(GL,0); GAPB2(o[0]=__builtin_amdgcn_mfma_f32_32x32x16_bf16(PAF(1),VFR(1),o[0],0,0,0), C0,8,1); \
    KRD(GL,1); GAPB2(o[1]=__builtin_amdgcn_mfma_f32_32x32x16_bf16(PAF(1),VFR(5),o[1],0,0,0), C0,12,5); \
    KRD(GL,2); GAPB2(o[0]=__builtin_amdgcn_mfma_f32_32x32x16_bf16(PAF(2),VFR(2),o[0],0,0,0), C1,0,2); \
    KRD(GL,3); GAPB2(o[1]=__builtin_amdgcn_mfma_f32_32x32x16_bf16(PAF(2),VFR(6),o[1],0,0,0), C1,4,6); \
    GAPB2(o[0]=__builtin_amdgcn_mfma_f32_32x32x16_bf16(PAF(3),VFR(3),o[0],0,0,0), C1,8,3); \
    GAPB2(o[1]=__builtin_amdgcn_mfma_f32_32x32x16_bf16(PAF(3),VFR(7),o[1],0,0,0), C1,12,7); \
    o[2]=__builtin_amdgcn_mfma_f32_32x32x16_bf16(PAF(0),VFR(0),o[2],0,0,0); o[3]=__builtin_amdgcn_mfma_f32_32x32x16_bf16(PAF(0),VFR(4),o[3],0,0,0); \
    o[2]=__builtin_amdgcn_mfma_f32_32x32x16_bf16(PAF(1),VFR(1),o[2],0,0,0); o[3]=__builtin_amdgcn_mfma_f32_32x32x16_bf16(PAF(1),VFR(5),o[3],0,0,0); \
    o[2]=__builtin_amdgcn_mfma_f32_32x32x16_bf16(PAF(2),VFR(2),o[2],0,0,0); o[3]=__builtin_amdgcn_mfma_f32_32x32x16_bf16(PAF(2),VFR(6),o[3],0,0,0); \
    o[2]=__builtin_amdgcn_mfma_f32_32x32x16_bf16(PAF(3),VFR(3),o[2],0,0,0); o[3]=__builtin_amdgcn_mfma_f32_32x32x16_bf16(PAF(3),VFR(7),o[3],0,0,0); SBAR(); \
    }while(0)
  int t=1;
  #undef CMASK
  #define CMASK(P0,P1,t) do{}while(0)
  for(;t+5<NT;t+=2){
    STEP(pB0,pB1,pA0,pA1,t,true,true,true);     WAIT_BAR(3); RESC(); ROT();
    STEP(pA0,pA1,pB0,pB1,t+1,true,true,true);   WAIT_BAR(3); RESC(); ROT();
  }
  #undef CMASK
  #define CMASK(P0,P1,t) do{int jb_=(t)-(NT-4); if(jb_>=0)cmask(P0,P1,jb_,qrel,hi);}while(0)
  #define ENDW(tt) do{ if((tt)+3<NT){WAIT_BAR(3);} else if((tt)+2<NT){WAIT_BAR(2);} else {WAIT_BAR(0);} }while(0)
  for(;t+1<NT;t+=2){
    STEP(pB0,pB1,pA0,pA1,t,(t+3<NT),(t+1<NT),(t+1<NT));       ENDW(t);   RESC(); ROT();
    STEP(pA0,pA1,pB0,pB1,t+1,(t+4<NT),(t+2<NT),(t+2<NT));     ENDW(t+1); RESC(); ROT();
  }
  STEP(pB0,pB1,pA0,pA1,NT-1,false,false,false); RESC();
  { float sacc=pB0[0]+pB0[1]; _Pragma("unroll") for(int r=2;r<16;++r)sacc+=pB0[r]; _Pragma("unroll") for(int r=0;r<16;++r)sacc+=pB1[r]; l_reg+=sacc;
    pw0=(u32x4){PKW(pB0,0),PKW(pB0,2),PKW(pB0,4),PKW(pB0,6)};pw1=(u32x4){PKW(pB0,8),PKW(pB0,10),PKW(pB0,12),PKW(pB0,14)};pw2=(u32x4){PKW(pB1,0),PKW(pB1,2),PKW(pB1,4),PKW(pB1,6)};pw3=(u32x4){PKW(pB1,8),PKW(pB1,10),PKW(pB1,12),PKW(pB1,14)};
    SBAR(); pv(o,vb0+2*sl_cur,PAF(0),PAF(1),PAF(2),PAF(3)); pv(o+2,vb0+2*sl_cur+8192,PAF(0),PAF(1),PAF(2),PAF(3)); }
  #undef PKW
  #undef PAF
  #undef VFR
  #undef PIN
  #undef MX3
  #undef GAPA
  #undef GAPB
  #undef GAPB2
  #undef VRD2
  #undef EX
  #undef VRD
  #undef KRD
  #undef STEP
  #undef ENDW
  {auto rr=__builtin_amdgcn_permlane32_swap(__float_as_uint(l_reg),__float_as_uint(l_reg),false,false);l_reg=__uint_as_float(rr[0])+__uint_as_float(rr[1]);}
  if(hi==0)wsf[32+r32]=l_reg;asm volatile("s_waitcnt lgkmcnt(0)":::"memory");
  float rli[16];
  #pragma unroll
  for(int r=0;r<16;++r)rli[r]=__builtin_amdgcn_rcpf(wsf[32+crow(r,hi)]);
  bf16*Ow=O+(rowbase+q0+wid*QBLK)*OP+ocol;
  { bf16*stg=(bf16*)(shm+LDS_OST)+wid*2048;
    #pragma unroll
    for(int dh=0;dh<2;++dh){
      #pragma unroll
      for(int r=0;r<16;++r){const int orow=crow(r,hi);
        #pragma unroll
        for(int d0=0;d0<2;++d0)stg[orow*64+d0*32+r32]=__float2bfloat16(o[2*dh+d0][r]*rli[r]);}
      asm volatile("s_waitcnt lgkmcnt(0)":::"memory");
      #pragma unroll
      for(int i=0;i<4;++i){const int row=i*8+(lane>>3),ch=lane&7; const u32x4 v=*(const u32x4*)(stg+row*64+ch*8); ATTN_STORE16(Ow+(long)row*OP+dh*64+ch*8,v);}
      asm volatile("s_waitcnt lgkmcnt(0)":::"memory"); } }
  asm volatile("s_waitcnt lgkmcnt(0)\n\ts_barrier":::"memory");
  #undef DMA_K
  #undef DMA_V
  #undef CMASK
  #undef START
  #undef RESC
  #undef ROT
}
constexpr int ATTN_LDS_BYTES=LDS_BYTES;
struct AttnTensors { const bf16* Q; const bf16* K; const bf16* V; bf16* O; };
struct AttnUnit { int bh; int qb; };
struct StaticOrder {
  int vcu;
  __device__ __forceinline__ explicit StaticOrder(int grid,int block):vcu((block%8)*(grid/8)+block/8){}
  __device__ __forceinline__ bool next(int i,AttnUnit&u)const{ if(i>=4)return false; const int s=vcu&7; u.bh=vcu>>3; u.qb=(i==0)?s:(i==1)?15-s:(i==2)?16+s:31-s; return true; }
  __device__ __forceinline__ void a_ready(const AttnUnit&)const{}
  __device__ __forceinline__ void done(const AttnUnit&)const{}
};
template<class Sched,int THRL=8> __device__ __forceinline__ void attn_phase(char*lds,const AttnTensors&T,const Sched&S,const int wid_in){
  AttnUnit u;
  for(int i=0;S.next(i,u);++i){ S.a_ready(u); const int b=u.bh>>3,h=(u.bh>>1)&3,c=u.bh&1;
    attn_unit<THRL>(b,(h*2+c)*64,h*128,h*256+c*128,u.qb,T.Q,T.K,T.V,T.O,lds,wid_in); S.done(u); }
}
#undef SBAR
#undef WAIT_BAR
}
#define GAS __attribute__((address_space(1)))
#define LAS __attribute__((address_space(3)))
typedef unsigned short bf16;
typedef unsigned v4u __attribute__((ext_vector_type(4)));
typedef float f32x4 __attribute__((ext_vector_type(4)));
typedef short bf16x8 __attribute__((ext_vector_type(8)));
typedef GAS unsigned gu32;
typedef GAS unsigned long long gu64;
#define RLX_AGENT __ATOMIC_RELAXED, __HIP_MEMORY_SCOPE_AGENT
#define LDS_WAIT() asm volatile("s_waitcnt lgkmcnt(0)" ::: "memory")
#define VM_WAIT() asm volatile("s_waitcnt vmcnt(0)" ::: "memory")
__device__ __forceinline__ unsigned long long rt() { return __builtin_amdgcn_s_memrealtime(); }
__device__ __forceinline__ unsigned f2bf(float f) { return (unsigned)__builtin_bit_cast(unsigned short, (__bf16)f); }
typedef __bf16 hwbf2 __attribute__((ext_vector_type(2)));
typedef float hwf2 __attribute__((ext_vector_type(2)));
__device__ __forceinline__ unsigned pk2(float lo, float hi) { const hwf2 v = {lo, hi}; return __builtin_bit_cast(unsigned, __builtin_convertvector(v, hwbf2)); }

#define XB_TMO      128
#define XB_XCNT(j)  (256  + 64 * (j))
#define XB_XSUB(j)  (1280 + 64 * (j))
#define XB_XGEN(j)  (2304 + 64 * (j))
#define XB_TOP      3328
#define XB_TOPGEN   3392
#define XCD_BAR_WORDS 3456
#define XB_SPIN_CAP (MK_CHECK ? (1u << 27) : (1u << 18))

__device__ __forceinline__ unsigned xb_ld(unsigned* p)              { return __hip_atomic_load(p, __ATOMIC_RELAXED, __HIP_MEMORY_SCOPE_AGENT); }
__device__ __forceinline__ unsigned xb_add(unsigned* p, unsigned v) { return __hip_atomic_fetch_add(p, v, __ATOMIC_RELAXED, __HIP_MEMORY_SCOPE_AGENT); }
__device__ __forceinline__ unsigned xb_xcc_id() { return (unsigned)__builtin_amdgcn_s_getreg((3 << 11) | 20) & 0xFu; }
#define XB_SPIN(cond, bar) do { unsigned _sp = 0; while (cond) { __builtin_amdgcn_s_sleep(1); \
    if ((++_sp & 255u) == 0u) { if (xb_ld(&(bar)[XB_TMO])) break; if (_sp > XB_SPIN_CAP) { atomicAdd(&(bar)[XB_TMO], 1u); break; } } } } while (0)

struct XcdBarrier {
    unsigned* bar; unsigned x; int wave;
    volatile LAS unsigned* st;
};

__device__ __forceinline__ XcdBarrier xcd_barrier_post(unsigned* bar, volatile LAS unsigned* st, int wave) {
    XcdBarrier b; b.bar = bar; b.x = xb_xcc_id(); b.st = st; b.wave = wave;
    if (wave == 0 && lane_now() == 0) (void)xb_add(&bar[XB_XCNT(b.x)], 1u);
    return b;
}
__device__ __forceinline__ void xcd_barrier_complete(unsigned* bar, unsigned x, unsigned& nloc, unsigned& nx) {
    const unsigned G = gridDim.x * gridDim.y * gridDim.z;
    unsigned sum, cnt, mine, sp = 0u;
    for (;;) {
        sum = 0u; cnt = 0u; mine = 0u;
#pragma unroll
        for (unsigned j = 0; j < 16; ++j) { const unsigned c = xb_ld(&bar[XB_XCNT(j)]); sum += c; cnt += (c > 0u) ? 1u : 0u; mine = (j == x) ? c : mine; }
        if (sum == G) break;
        __builtin_amdgcn_s_sleep(1);
        if ((++sp & 255u) == 0u) { if (xb_ld(&bar[XB_TMO])) break; if (sp > XB_SPIN_CAP) { atomicAdd(&bar[XB_TMO], 1u); break; } }
    }
    nloc = mine > 0u ? mine : 1u; nx = cnt > 0u ? cnt : 1u;
}

__device__ __forceinline__ void xcd_barrier(const XcdBarrier& b) {
    asm volatile("s_waitcnt vmcnt(0)" ::: "memory");
    __syncthreads();
    if (b.wave == 0 && lane_now() == 0) {
        unsigned* bar = b.bar; unsigned bx_ = b.x; asm volatile("" : "+s"(bx_));
        __builtin_amdgcn_s_waitcnt(0);
        unsigned nloc = b.st[0], nx = b.st[1];
        if (nloc == 0u) { xcd_barrier_complete(bar, bx_, nloc, nx); b.st[0] = nloc; b.st[1] = nx; }
        const unsigned old = xb_add(&bar[XB_XSUB(bx_)], 1u);
        const unsigned gen = old / nloc;
        if (old + 1u == (gen + 1u) * nloc) {
            __builtin_amdgcn_fence(__ATOMIC_RELEASE, "agent");
            asm volatile("s_waitcnt vmcnt(0)" ::: "memory");
            const unsigned og = xb_add(&bar[XB_TOP], 1u);
            const unsigned tg = og / nx;
            if (og + 1u == (tg + 1u) * nx) xb_add(&bar[XB_TOPGEN], 1u);
            else XB_SPIN(xb_ld(&bar[XB_TOPGEN]) == tg, bar);
            __builtin_amdgcn_fence(__ATOMIC_ACQUIRE, "agent");
            xb_add(&bar[XB_XGEN(bx_)], 1u);
            asm volatile("s_waitcnt vmcnt(0)" ::: "memory");
        } else {
            XB_SPIN(xb_ld(&bar[XB_XGEN(bx_)]) == gen, bar);
            __builtin_amdgcn_fence(__ATOMIC_ACQUIRE, "agent");
            asm volatile("s_waitcnt vmcnt(0)" ::: "memory");
        }
    }
    __syncthreads();
}
typedef unsigned u32x2g __attribute__((ext_vector_type(2)));
constexpr size_t MiB = 1u << 20;
constexpr size_t WS_CTL = 0, CTL_ZERO_BYTES = 1 * MiB;
constexpr size_t WS_ROPE = 1 * MiB;
constexpr size_t WS_TOKSLOT = WS_ROPE + 512 * 1024;
constexpr size_t WS_GATEW = 2 * MiB;
constexpr size_t WS_DEC = 2 * MiB + 512 * 1024;
constexpr size_t WS_HIST = 2 * MiB + 768 * 1024, WS_TOKE = 3 * MiB;
constexpr size_t WS_KVS = 4 * MiB;
constexpr size_t WS_LA = 20 * MiB;
constexpr size_t WS_WIN = 36 * MiB, WS_WOUT = 60 * MiB, WS_WPG = 68 * MiB, WS_WPU = 76 * MiB, WS_WFGU = 78 * MiB, WS_WFDN = 100 * MiB, WS_WMGU = 112 * MiB, WS_WMDN = 336 * MiB;
constexpr size_t WS_PB = 448 * MiB, WS_HN = 512 * MiB, WS_ZQ = 576 * MiB, WS_ZK = 608 * MiB, WS_ZV = 640 * MiB, WS_ZU = 672 * MiB, WS_ZG = 688 * MiB;
constexpr size_t WS_OV = 736 * MiB, WS_YC = 800 * MiB, WS_UP = 864 * MiB, WS_ACT = 928 * MiB, WS_XG = 1390 * MiB, WS_Y2 = 1522 * MiB, WS_HNB = 1654 * MiB, WS_SS = 1718 * MiB, WS_SSX = 1746 * MiB, WS_END = 1747 * MiB;
static_assert(WS_ACT + (size_t)MOE_ROWS * D_FFE * 2 <= WS_XG && WS_XG + (size_t)MOE_ROWS * 1024 * 2 <= WS_Y2 && WS_Y2 + (size_t)MOE_ROWS * 1024 * 2 <= WS_HNB, "d_ws map");
constexpr int NSS = 13;
constexpr size_t SS_STRIDE = (size_t)T_TOK * 16;
constexpr size_t SZ_WIN = (size_t)NZ * 1024 * 2, SZ_SQ = (size_t)1024 * 1024 * 2, SZ_WPU = (size_t)1024 * 256 * 2, SZ_WFGU = (size_t)2 * D_FF * 1024 * 2, SZ_WFDN = (size_t)1024 * D_FF * 2,
                 SZ_WMGU = (size_t)2 * D_FFE * 1024 * 2, SZ_WMDN = (size_t)1024 * D_FFE * 2;
constexpr int CW_TMO = 0, CW_BAR = 4096, CW_CUR = 8192;

constexpr int RING_OFF = 0, RING_BYTES = 131072;
constexpr int LDSCTL_OFF = RING_BYTES, MISC_OFF = LDSCTL_OFF + 320;
constexpr int LDS_BYTES = 147456;

struct Cx { LAS unsigned char* lds; int tid, lane, wave, vcu, G; };
__device__ __forceinline__ Cx mkcx(LAS unsigned char* lds, int wave) { Cx cx; cx.lds = lds; cx.lane = lane_now(); cx.wave = wave; cx.tid = wave * 64 + cx.lane;
    cx.G = gridDim.x; { const int bx = blockIdx.x; cx.vcu = (cx.G % 8 == 0) ? (bx % 8) * (cx.G / 8) + bx / 8 : bx; } return cx; }
__device__ __forceinline__ unsigned long long ldptr(const LAS unsigned long long* PT, int i) { const unsigned long long v = PT[i];
    return ((unsigned long long)(unsigned)__builtin_amdgcn_readfirstlane((int)(unsigned)(v >> 32)) << 32) | (unsigned)__builtin_amdgcn_readfirstlane((int)(unsigned)v); }

template <int M> __device__ __forceinline__ float swz_xor(float v) { return __builtin_bit_cast(float, __builtin_amdgcn_ds_swizzle(__builtin_bit_cast(int, v), (M << 10) | 0x1f)); }
__device__ __forceinline__ float sum16(float v) { v += swz_xor<1>(v); v += swz_xor<2>(v); v += swz_xor<4>(v); v += swz_xor<8>(v); return v; }
__device__ __forceinline__ float wave_sum(float v) {
    v = sum16(v); const int iv = __builtin_bit_cast(int, v);
    const float a = __builtin_bit_cast(float, __builtin_amdgcn_readlane(iv, 0)), b = __builtin_bit_cast(float, __builtin_amdgcn_readlane(iv, 16)),
                c = __builtin_bit_cast(float, __builtin_amdgcn_readlane(iv, 32)), d = __builtin_bit_cast(float, __builtin_amdgcn_readlane(iv, 48));
    return (a + b) + (c + d);
}
__device__ __forceinline__ float b2f(unsigned short b) { return __builtin_bit_cast(float, (unsigned)b << 16); }
__device__ __forceinline__ float lo2f(unsigned w) { return __builtin_bit_cast(float, w << 16); }
__device__ __forceinline__ float hi2f(unsigned w) { return __builtin_bit_cast(float, w & 0xffff0000u); }
__device__ __forceinline__ float sigm(float x) { return __builtin_amdgcn_rcpf(1.f + __builtin_amdgcn_exp2f(-1.4426950408889634f * x)); }

__device__ __forceinline__ int col_gu(int n, int F) { const int t = n >> 8, j = n & 255; return (j >> 7) * F + t * 128 + (j & 127); }
__device__ __forceinline__ int col_win(int n) { const int t = n >> 8, j = n & 255;
    if (t < 2) return (j >> 7) * 256 + t * 128 + (j & 127);
    if (t < 6) { const int sec = (t - 2) >> 1, w = ((t - 2) & 1) * 256 + j, comp = w >> 6, d = w & 63; int od = d; if (d >= 4 && d < 8) od = d + 4; else if (d >= 8 && d < 12) od = d - 4; return 512 + sec * 512 + comp * 64 + od; }
    if (t < 8) return 1536 + (t - 6) * 256 + j;
    return 2048 + (t - 8) * 256 + j; }
struct TrSrc { const GAS float* src; int k0, n0; };
template <int MODE> __device__ __forceinline__ TrSrc tr_addr(const float* W, int K, int Nsrc, int F, int item, int lane) {
    const int nkb = K / 64, kb = (item >> 3) % nkb, nb = (item & 7) + 8 * (item / (8 * nkb)); TrSrc t; t.k0 = 64 * kb; t.n0 = 32 * nb; const int nd = t.n0 + (lane & 31);
    const int sc = MODE == 0 ? nd : (MODE == 1 ? col_gu(nd, F) : col_win(nd));
    t.src = (const GAS float*)W + (size_t)(t.k0 + (lane >> 5)) * Nsrc + sc; return t;
}
__device__ __forceinline__ void tr_emit(const float (&wv)[32], const TrSrc& t, int K, const float* gk, bf16* WT, LAS float* scr, int lane, float nsc) {
    const int c = lane & 7;
    f32x4 g0 = {1.f, 1.f, 1.f, 1.f}, g1 = {1.f, 1.f, 1.f, 1.f};
    if (gk) { g0 = *(const GAS f32x4*)(gk + t.k0 + 8 * c); g1 = *(const GAS f32x4*)(gk + t.k0 + 8 * c + 4); g0 *= nsc; g1 *= nsc; }
#pragma unroll
    for (int i = 0; i < 32; ++i) scr[(2 * i + (lane >> 5)) * 33 + (lane & 31)] = wv[i];
    LDS_WAIT(); asm volatile("" ::: "memory");
#pragma unroll
    for (int j = 0; j < 4; ++j) { const int n = (lane >> 3) + 8 * j; const LAS float* s = scr + (8 * c) * 33 + n;
        v4u o; o.x = pk2(s[0 * 33] * g0[0], s[1 * 33] * g0[1]); o.y = pk2(s[2 * 33] * g0[2], s[3 * 33] * g0[3]); o.z = pk2(s[4 * 33] * g1[0], s[5 * 33] * g1[1]); o.w = pk2(s[6 * 33] * g1[2], s[7 * 33] * g1[3]);
        st16_wt(WT + (size_t)(t.n0 + n) * K + t.k0 + 8 * c, o); }
    LDS_WAIT(); asm volatile("" ::: "memory");
}
template <int MODE> __device__ __forceinline__ void tr_job(const float* W, int K, int Nsrc, int F, const float* gk, bf16* WT, LAS float* scr, int it0, int stride, int nitems, int lane) {
    for (int it = it0; it < nitems; it += 2 * stride) {
        const bool two = it + stride < nitems;
        const TrSrc ta = tr_addr<MODE>(W, K, Nsrc, F, it, lane), tb = tr_addr<MODE>(W, K, Nsrc, F, two ? it + stride : it, lane);
        float wa[32], wb[32];
#pragma unroll
        for (int i = 0; i < 32; ++i) wa[i] = ta.src[(size_t)(2 * i) * Nsrc];
        if (two) {
#pragma unroll
            for (int i = 0; i < 32; ++i) wb[i] = tb.src[(size_t)(2 * i) * Nsrc]; }
        tr_emit(wa, ta, K, gk, WT, scr, lane, MODE == 1 ? ((ta.n0 & 128) ? 0.6931471805599453f : 1.4426950408889634f) : 1.f);
        if (two) tr_emit(wb, tb, K, gk, WT, scr, lane, MODE == 1 ? ((tb.n0 & 128) ? 0.6931471805599453f : 1.4426950408889634f) : 1.f);
    }
}
__device__ __forceinline__ void gate_item(const float* Win, const float* wg2, const float* gk, bf16* WT, LAS float* scr, int item, int lane) {
    const int kb = item >> 3, jb = item & 7, k0 = 64 * kb, j0 = 32 * jb, k = k0 + lane;
    float wr[16];
#pragma unroll
    for (int q = 0; q < 4; ++q) { const f32x4 x = *(const f32x4*)(Win + (size_t)k * D_IN + 2816 + 4 * q); wr[4 * q] = x[0]; wr[4 * q + 1] = x[1]; wr[4 * q + 2] = x[2]; wr[4 * q + 3] = x[3]; }
    const float gkk = gk[k];
    for (int jj = 0; jj < 32; ++jj) { const int j = j0 + jj; float s = 0.f;
        if (j < 128) {
#pragma unroll
            for (int r = 0; r < 16; ++r) s += wr[r] * wg2[r * 128 + j];
            s *= gkk; }
        scr[lane * 33 + jj] = s; }
    LDS_WAIT(); asm volatile("" ::: "memory");
    const int c = lane & 7;
#pragma unroll
    for (int j = 0; j < 4; ++j) { const int n = (lane >> 3) + 8 * j; const LAS float* s = scr + (8 * c) * 33 + n;
        v4u o; o.x = pk2(s[0 * 33], s[1 * 33]); o.y = pk2(s[2 * 33], s[3 * 33]); o.z = pk2(s[4 * 33], s[5 * 33]); o.w = pk2(s[6 * 33], s[7 * 33]);
        st16_wt(WT + (size_t)(2816 + j0 + n) * 1024 + k0 + 8 * c, o); }
    LDS_WAIT(); asm volatile("" ::: "memory");
}
#define JOB_TR(MODE, n_items, W_, K_, Ns_, F_, gk_, WT_) do { const int _n = (n_items); tr_job<MODE>(W_, K_, Ns_, F_, gk_, WT_, scr, (int)(((long)gw - jbase % NGW + NGW) % NGW), NGW, _n, lane); jbase += _n; } while (0)
#define JOB_LOOP(n_items, body) do { const int _n = (n_items); for (int it = (int)(((long)gw - jbase % NGW + NGW) % NGW); it < _n; it += NGW) { body; } jbase += _n; } while (0)
__device__ __forceinline__ void p0_prologue(const Cx& cx, const LAS unsigned long long* PT, unsigned char* ws) {
    LAS float* scr = (LAS float*)(cx.lds + RING_OFF + cx.wave * 16384);
    const int gw = cx.vcu * 8 + cx.wave, NGW = cx.G * 8, lane = cx.lane; long jbase = 0;
#define PIN(i) ((const float*)(const GAS float*)ldptr(PT, (i)))
    const float *norm_mix_g = PIN(2), *w_in = PIN(3), *gla_w_gate2 = PIN(10), *w_out = PIN(13), *norm_ffn_g = PIN(14), *ffn_w_gu = PIN(15), *ffn_w_down = PIN(16), *moe_w_gu = PIN(18), *moe_w_down = PIN(19),
                *ple_w_up = PIN(20), *ple_w_gate = PIN(21), *ple_norm_g = PIN(22);
    REPEAT(11) for (int m = 0; m < 2; ++m) for (int e = 0; e < NEXP; ++e) {
        const float* Wg = moe_w_gu + (size_t)(m * NEXP + e) * 1024 * (2 * D_FFE); bf16* Dg = (bf16*)(ws + WS_WMGU + (size_t)(m * NEXP + e) * SZ_WMGU);
        JOB_TR(1, 16 * (2 * D_FFE / 32), Wg, 1024, 2 * D_FFE, D_FFE, norm_ffn_g + (2 * m + 1) * 1024, Dg);
        const float* Wd = moe_w_down + (size_t)(m * NEXP + e) * D_FFE * 1024; bf16* Dd = (bf16*)(ws + WS_WMDN + (size_t)(m * NEXP + e) * SZ_WMDN);
        JOB_TR(0, (D_FFE / 64) * 32, Wd, D_FFE, 1024, 0, nullptr, Dd);
    }
    REPEAT(12) { for (int d = 0; d < 2; ++d) {
        JOB_TR(1, 16 * (2 * D_FF / 32), ffn_w_gu + (size_t)d * 1024 * 2 * D_FF, 1024, 2 * D_FF, D_FF, norm_ffn_g + (2 * d) * 1024, (bf16*)(ws + WS_WFGU + d * SZ_WFGU));
        JOB_TR(0, (D_FF / 64) * 32, ffn_w_down + (size_t)d * D_FF * 1024, D_FF, 1024, 0, nullptr, (bf16*)(ws + WS_WFDN + d * SZ_WFDN));
    }
    for (int li = 0; li < DEPTH; ++li) {
        JOB_TR(2, 16 * (2816 / 32), w_in + (size_t)li * 1024 * D_IN, 1024, D_IN, 0, norm_mix_g + li * 1024, (bf16*)(ws + WS_WIN + li * SZ_WIN));
        JOB_LOOP(16 * 8, gate_item(w_in + (size_t)li * 1024 * D_IN, gla_w_gate2 + li * 16 * 128, norm_mix_g + li * 1024, (bf16*)(ws + WS_WIN + li * SZ_WIN), scr, it, lane));
        JOB_TR(0, 16 * 32, w_out + (size_t)li * 1024 * 1024, 1024, 1024, 0, nullptr, (bf16*)(ws + WS_WOUT + li * SZ_SQ));
        JOB_TR(0, 16 * 32, ple_w_gate + (size_t)li * 1024 * 1024, 1024, 1024, 0, ple_norm_g + li * 1024, (bf16*)(ws + WS_WPG + li * SZ_SQ));
        JOB_TR(0, 4 * 32, ple_w_up + (size_t)li * 256 * 1024, 256, 1024, 0, nullptr, (bf16*)(ws + WS_WPU + li * SZ_WPU));
    } }
    REPEAT(13) { const float* p = PIN(1); bf16* pb = (bf16*)(ws + WS_PB); const long n8 = (long)DEPTH * T_TOK * PLE_DIM / 8, NT = (long)cx.G * 512;
      for (long i0 = (long)cx.vcu * 512 + cx.tid; i0 < n8; i0 += 4 * NT) { f32x4 a[4], b[4];
#pragma unroll
          for (int r = 0; r < 4; ++r) { const long i = i0 + r * NT; a[r] = *(const f32x4*)(p + i * 8); b[r] = *(const f32x4*)(p + i * 8 + 4); }
#pragma unroll
          for (int r = 0; r < 4; ++r) { const long i = i0 + r * NT; v4u o; o.x = pk2(a[r][0], a[r][1]); o.y = pk2(a[r][2], a[r][3]); o.z = pk2(b[r][0], b[r][1]); o.w = pk2(b[r][2], b[r][3]); st16_wt(pb + i * 8, o); } } }
    { const float* x = PIN(0); bf16* hb = (bf16*)(ws + WS_HNB); float* ss = (float*)(ws + WS_SS);
      for (int m0 = gw; m0 < T_TOK; m0 += 4 * NGW) { f32x4 v[4][4];
#pragma unroll
          for (int r = 0; r < 4; ++r) { const GAS f32x4* xr = (const GAS f32x4*)(x + (size_t)(m0 + r * NGW) * 1024) + lane;
#pragma unroll
              for (int j = 0; j < 4; ++j) v[r][j] = xr[64 * j]; }
#pragma unroll
          for (int r = 0; r < 4; ++r) { const int m = m0 + r * NGW; float s = 0.f;
#pragma unroll
              for (int j = 0; j < 4; ++j) s += (v[r][j].x * v[r][j].x + v[r][j].y * v[r][j].y) + (v[r][j].z * v[r][j].z + v[r][j].w * v[r][j].w);
              s = wave_sum(s); if (lane < 4) ((f32x4*)(ss + (size_t)m * 16))[lane] = (f32x4){lane == 0 ? s : 0.f, 0.f, 0.f, 0.f};
              GAS unsigned long long* o8 = (GAS unsigned long long*)(hb + (size_t)m * 1024) + lane;
#pragma unroll
              for (int j = 0; j < 4; ++j) o8[64 * j] = (unsigned long long)pk2(v[r][j].x, v[r][j].y) | ((unsigned long long)pk2(v[r][j].z, v[r][j].w) << 32); } }
    }
    { float* rope = (float*)(ws + WS_ROPE); const int idx = cx.vcu * 512 + cx.tid;
      if (idx < SEQ * 8) { const int pos = idx >> 3, j = idx & 7;
          const double invf[8] = {1.0, 0.19391010807943456, 0.037601130015015855, 0.0072912391843014545, 0.001414213562373095, 0.00027423030417878515, 5.317602791587768e-05, 1.031136931769684e-05};
          double f = invf[0];
#pragma unroll
          for (int q = 1; q < 8; ++q) f = (j == q) ? invf[q] : f;
          const double rev = (double)pos * f * 0.15915494309189535; const float fr = (float)(rev - rint(rev));
          rope[idx * 2] = __builtin_amdgcn_cosf(fr); rope[idx * 2 + 1] = __builtin_amdgcn_sinf(fr); } }
}

__device__ __forceinline__ void norm_rows(const Cx& cx, const float* src, bf16* dst) {
    const int gw = cx.vcu * 8 + cx.wave, NGW = cx.G * 8;
    for (int m = gw; m < T_TOK; m += NGW) {
        const GAS f32x4* xr = (const GAS f32x4*)(src + (size_t)m * 1024) + cx.lane; f32x4 v[4]; float s = 0.f;
#pragma unroll
        for (int j = 0; j < 4; ++j) { v[j] = xr[64 * j]; s += (v[j].x * v[j].x + v[j].y * v[j].y) + (v[j].z * v[j].z + v[j].w * v[j].w); }
        const float rs = __builtin_amdgcn_rsqf(wave_sum(s) * (1.f / 1024.f) + EPS);
        GAS unsigned long long* o8 = (GAS unsigned long long*)(dst + (size_t)m * 1024) + cx.lane;
#pragma unroll
        for (int j = 0; j < 4; ++j) st8_wt((void*)(o8 + 64 * j), (unsigned long long)pk2(v[j].x * rs, v[j].y * rs) | ((unsigned long long)pk2(v[j].z * rs, v[j].w * rs) << 32));
    }
}
__device__ __forceinline__ void final_norm_rows(const Cx& cx, const bf16* h, float* out, const float* g, const float* ss) {
    const int gw = cx.vcu * 8 + cx.wave, NGW = cx.G * 8;
    f32x4 gv[4];
#pragma unroll
    for (int j = 0; j < 4; ++j) gv[j] = ((const f32x4*)g)[64 * j + cx.lane];
    for (int m0 = gw; m0 < T_TOK; m0 += 4 * NGW) {
        u32x2g w[4][4]; float rs[4];
#pragma unroll
        for (int r = 0; r < 4; ++r) { const int m = m0 + r * NGW; const GAS u32x2g* xr = (const GAS u32x2g*)(h + (size_t)m * 1024) + cx.lane; rs[r] = pg8::row_rs16(ss, m);
#pragma unroll
            for (int j = 0; j < 4; ++j) w[r][j] = xr[64 * j]; }
#pragma unroll
        for (int r = 0; r < 4; ++r) { GAS f32x4* orow = (GAS f32x4*)(out + (size_t)(m0 + r * NGW) * 1024) + cx.lane;
#pragma unroll
            for (int j = 0; j < 4; ++j) orow[64 * j] = (f32x4){lo2f(w[r][j].x), hi2f(w[r][j].x), lo2f(w[r][j].y), hi2f(w[r][j].y)} * rs[r] * gv[j]; }
    }
}
__device__ __forceinline__ void router_rows(const Cx& cx, const bf16* h, const float* g, const float* R, int* hist, int* toke, float* gatew, const float* ss) {
    LAS unsigned short* BW = (LAS unsigned short*)cx.lds;
    LAS int* lcnt = (LAS int*)(cx.lds + 32768);
    LAS float* LG = (LAS float*)(cx.lds + 33792 + cx.wave * 512);
    const int r = cx.lane & 15, quad = cx.lane >> 4;
    for (int blk = cx.vcu; blk < T_TOK / 128; blk += cx.G) {
        const int m0 = blk * 128 + cx.wave * 16;
        if (blk == cx.vcu) {
            float gv[16], rv[16];
#pragma unroll
            for (int ii = 0; ii < 16; ++ii) { const int idx = cx.tid + ii * 512; gv[ii] = g[idx >> 3]; rv[ii] = R[idx]; }
#pragma unroll
            for (int ii = 0; ii < 16; ++ii) { const int idx = cx.tid + ii * 512, e = idx & 7, k = idx >> 3; const float w = gv[ii] * rv[ii];
                const unsigned hi = f2bf(w); const unsigned lo = f2bf(w - __uint_as_float(hi << 16));
                LAS unsigned short* d = BW + (((k >> 3) * 16) + e * 2) * 8 + (k & 7); d[0] = (unsigned short)hi; d[8] = (unsigned short)lo; }
            if (cx.tid < 8) lcnt[cx.tid] = 0;
        }
        v4u a[32];
        { const bf16* hp = h + (size_t)(m0 + r) * 1024 + quad * 8;
#pragma unroll
          for (int i = 0; i < 32; ++i) a[i] = *(const v4u*)(hp + i * 32); }
        f32x4 sp0 = {0.f, 0.f, 0.f, 0.f}, sp1 = sp0, sp2 = sp0, sp3 = sp0;
        if (cx.lane < 16) { const f32x4* p = (const f32x4*)(ss + (size_t)(m0 + cx.lane) * 16); sp0 = p[0]; sp1 = p[1]; sp2 = p[2]; sp3 = p[3]; }
        __syncthreads();
        f32x4 acc = {0.f, 0.f, 0.f, 0.f};
#pragma unroll
        for (int i = 0; i < 32; ++i) { const v4u bw = *(const LAS v4u*)(BW + ((i * 4 + quad) * 16 + r) * 8);
            acc = __builtin_amdgcn_mfma_f32_16x16x32_bf16(__builtin_bit_cast(bf16x8, a[i]), __builtin_bit_cast(bf16x8, bw), acc, 0, 0, 0); }
#pragma unroll
        for (int q = 0; q < 4; ++q) { const float v = acc[q] + __shfl_xor(acc[q], 1); if (!(r & 1)) LG[(quad * 4 + q) * 8 + (r >> 1)] = v; }
        LDS_WAIT(); asm volatile("" ::: "memory");
        if (cx.lane < 16) { const int m = m0 + cx.lane; const f32x4 l0 = *(const LAS f32x4*)(LG + cx.lane * 8), l1 = *(const LAS f32x4*)(LG + cx.lane * 8 + 4);
            const float s = (((sp0[0] + sp0[1]) + (sp0[2] + sp0[3])) + ((sp1[0] + sp1[1]) + (sp1[2] + sp1[3]))) + (((sp2[0] + sp2[1]) + (sp2[2] + sp2[3])) + ((sp3[0] + sp3[1]) + (sp3[2] + sp3[3])));
            const float rs = __builtin_amdgcn_rsqf(s * (1.f / 1024.f) + EPS);
            float lg[8] = {l0[0] * rs, l0[1] * rs, l0[2] * rs, l0[3] * rs, l1[0] * rs, l1[1] * rs, l1[2] * rs, l1[3] * rs};
            int e0 = 0; float v0 = lg[0];
#pragma unroll
            for (int e = 1; e < 8; ++e) if (lg[e] > v0) { v0 = lg[e]; e0 = e; }
            int e1 = -1; float v1 = -INFINITY;
#pragma unroll
            for (int e = 0; e < 8; ++e) if (e != e0 && lg[e] > v1) { v1 = lg[e]; e1 = e; }
            const float t = __expf(v1 - v0), w0 = 1.0f / (1.0f + t);
            __hip_atomic_fetch_add(lcnt + e0, 1, __ATOMIC_RELAXED, __HIP_MEMORY_SCOPE_WORKGROUP); __hip_atomic_fetch_add(lcnt + e1, 1, __ATOMIC_RELAXED, __HIP_MEMORY_SCOPE_WORKGROUP);
            toke[m] = e0 | (e1 << 8); *(float2*)(gatew + (size_t)m * 2) = make_float2(w0, t * w0); }
        __syncthreads();
        if (cx.tid < 8) { hist[blk * 8 + cx.tid] = lcnt[cx.tid]; lcnt[cx.tid] = 0; }
        __syncthreads();
    }
}
__device__ __forceinline__ void moe_prefix(const Cx& cx, gu32* cursor, LAS int* tb) {
    if (cx.tid == 0) { int t = 0;
        for (int e = 0; e < NEXP; ++e) { tb[e] = t; t += ((int)__hip_atomic_load(cursor + e * 64, RLX_AGENT) + 255) >> 8; }
        tb[NEXP] = t; }
    __syncthreads();
}
__device__ __forceinline__ void dispatch_rows(const Cx& cx, const bf16* hn, bf16* xg, const int* hist, const int* toke, int* tokslot, gu32* cursor, LAS int* tb, const float* ss, float* ssx) {
    LAS int* hh = (LAS int*)cx.lds;
    LAS int* totS = hh + 2048; LAS int* preS = totS + 8; LAS int* e0s = preS + 8; LAS int* e1s = e0s + 128; LAS int* rk0 = e1s + 128; LAS int* rk1 = rk0 + 128; LAS int* d0s = rk1 + 128; LAS int* d1s = d0s + 128;
    for (int blk = cx.vcu; blk < T_TOK / 128; blk += cx.G) {
        if (cx.tid < 256) { const v4u a = *(const v4u*)(hist + cx.tid * 8), b = *(const v4u*)(hist + cx.tid * 8 + 4); *(LAS v4u*)(hh + cx.tid * 8) = a; *(LAS v4u*)(hh + cx.tid * 8 + 4) = b; }
        if (cx.tid < 128) { const int te = toke[blk * 128 + cx.tid]; e0s[cx.tid] = te & 255; e1s[cx.tid] = te >> 8; }
        __syncthreads();
        if (cx.tid < 64) { const int e = cx.tid & 7, part = cx.tid >> 3; int tot = 0, pre = 0;
            for (int b = part * 32; b < part * 32 + 32; ++b) { const int v = hh[b * 8 + e]; pre += (b < blk) ? v : 0; tot += v; }
            d0s[cx.tid] = tot; d1s[cx.tid] = pre; }
        __syncthreads();
        if (cx.tid < 8) { int tot = 0, pre = 0; for (int q = 0; q < 8; ++q) { tot += d0s[q * 8 + cx.tid]; pre += d1s[q * 8 + cx.tid]; } totS[cx.tid] = tot; preS[cx.tid] = pre;
            if (blk == 0) __hip_atomic_store(cursor + cx.tid * 64, (unsigned)tot, RLX_AGENT); }
        { const int e = cx.wave, la = cx.lane, lb = cx.lane + 64; const bool f0a = e0s[la] == e, f1a = e1s[la] == e, f0b = e0s[lb] == e, f1b = e1s[lb] == e;
          const unsigned long long M0a = __ballot(f0a), M1a = __ballot(f1a), M0b = __ballot(f0b), M1b = __ballot(f1b), below = (1ull << la) - 1ull;
          const int ba = __popcll(M0a & below) + __popcll(M1a & below), bb = __popcll(M0a) + __popcll(M1a) + __popcll(M0b & below) + __popcll(M1b & below);
          if (f0a) rk0[la] = ba; if (f1a) rk1[la] = ba; if (f0b) rk0[lb] = bb; if (f1b) rk1[lb] = bb; }
        __syncthreads();
        if (cx.tid == 0) { int t = 0; for (int e = 0; e < NEXP; ++e) { tb[e] = t; t += (totS[e] + 255) >> 8; } tb[NEXP] = t; }
        __syncthreads();
        if (cx.tid < 128) { const int m = blk * 128 + cx.tid, e0 = e0s[cx.tid], e1 = e1s[cx.tid], p0 = preS[e0] + rk0[cx.tid], p1 = preS[e1] + rk1[cx.tid];
            *(int4*)(tokslot + (size_t)m * 4) = make_int4(e0, p0, e1, p1); d0s[cx.tid] = tb[e0] * 256 + p0; d1s[cx.tid] = tb[e1] * 256 + p1; }
        __syncthreads();
#pragma unroll 1
        for (int i0 = 0; i0 < 16; i0 += 4) {
            v4u av[4], bv[4]; f32x4 sp[4];
#pragma unroll
            for (int r = 0; r < 4; ++r) { const int m = blk * 128 + cx.wave * 16 + i0 + r;
                av[r] = *(const v4u*)(hn + (size_t)m * 1024 + cx.lane * 8); bv[r] = *(const v4u*)(hn + (size_t)m * 1024 + 512 + cx.lane * 8); sp[r] = *((const f32x4*)(ss + (size_t)m * 16) + (cx.lane & 3)); }
#pragma unroll
            for (int r = 0; r < 4; ++r) { const int t = cx.wave * 16 + i0 + r; const size_t d0 = (size_t)d0s[t], d1 = (size_t)d1s[t]; v4u a = av[r], b = bv[r];
                float s = (sp[r][0] + sp[r][1]) + (sp[r][2] + sp[r][3]); s += swz_xor<1>(s); s += swz_xor<2>(s);
                const float rs = rsqrtf(s * (1.f / 1024.f) + EPS);
                a.x = pk2(lo2f(a.x) * rs, hi2f(a.x) * rs); a.y = pk2(lo2f(a.y) * rs, hi2f(a.y) * rs); a.z = pk2(lo2f(a.z) * rs, hi2f(a.z) * rs); a.w = pk2(lo2f(a.w) * rs, hi2f(a.w) * rs);
                b.x = pk2(lo2f(b.x) * rs, hi2f(b.x) * rs); b.y = pk2(lo2f(b.y) * rs, hi2f(b.y) * rs); b.z = pk2(lo2f(b.z) * rs, hi2f(b.z) * rs); b.w = pk2(lo2f(b.w) * rs, hi2f(b.w) * rs);
                st16_wt(xg + d0 * 1024 + cx.lane * 8, a); st16_wt(xg + d0 * 1024 + 512 + cx.lane * 8, b);
                st16_wt(xg + d1 * 1024 + cx.lane * 8, a); st16_wt(xg + d1 * 1024 + 512 + cx.lane * 8, b); } }
        __syncthreads();
    }
}
__device__ __forceinline__ void add_y2p(float (&a)[4], const bf16* y2p, unsigned s, size_t d, int lane) {
    a[0] = a[1] = a[2] = a[3] = 0.f;
#pragma unroll
    for (int q = 0; q < 4; ++q) { const u32x2g w = *((const GAS u32x2g*)(y2p + (size_t)(q * 32 + s) * 65536 + (d & 255) * 256) + lane); a[0] += lo2f(w.x); a[1] += hi2f(w.x); a[2] += lo2f(w.y); a[3] += hi2f(w.y); }
}
__device__ __forceinline__ void combine_rows(const Cx& cx, bf16* h, const bf16* y2, const bf16* y2p, const int* tokslot, const float* gatew, const LAS int* tb, float* sso) {
    const int gw = cx.vcu * 8 + cx.wave, NGW = cx.G * 8;
    LAS unsigned char* spl = (LAS unsigned char*)(cx.lds + MISC_OFF + 6144);
    { const int total = tb[NEXP] * 4, n5 = total - 4 * cx.G;
      for (int i = cx.tid; i < 1088; i += 512) spl[i] = 0xffu;
      __syncthreads();
      if (cx.tid < n5) { pg8::GroupedOrder S{(const PG8_LAS int*)tb, 4, cx.G, 0}; pg8::Unit u; S.map(4 * cx.G + cx.tid, total, u); spl[u.pm * 4 + u.pn] = (unsigned char)cx.tid; }
      __syncthreads(); }
    for (int m0 = gw; m0 < T_TOK; m0 += 2 * NGW) {
        int4 tsv[2]; float2 gwv[2];
#pragma unroll
        for (int r = 0; r < 2; ++r) { const int m = m0 + r * NGW; tsv[r] = *(const int4*)(tokslot + (size_t)m * 4); gwv[r] = *(const float2*)(gatew + (size_t)m * 2); }
        u32x2g hw[2][4], aw[2][4], bw[2][4]; size_t d0v[2], d1v[2];
#pragma unroll
        for (int r = 0; r < 2; ++r) { const int m = m0 + r * NGW; d0v[r] = (size_t)(tb[tsv[r].x] * 256 + tsv[r].y); d1v[r] = (size_t)(tb[tsv[r].z] * 256 + tsv[r].w);
            const GAS u32x2g* xr = (const GAS u32x2g*)(h + (size_t)m * 1024) + cx.lane;
            const GAS u32x2g* y0 = (const GAS u32x2g*)(y2 + d0v[r] * 1024) + cx.lane; const GAS u32x2g* y1 = (const GAS u32x2g*)(y2 + d1v[r] * 1024) + cx.lane;
#pragma unroll
            for (int j = 0; j < 4; ++j) { hw[r][j] = xr[64 * j]; aw[r][j] = y0[64 * j]; bw[r][j] = y1[64 * j]; } }
#pragma unroll
        for (int r = 0; r < 2; ++r) { const int m = m0 + r * NGW; const size_t d0 = d0v[r], d1 = d1v[r]; const float2 gwt = gwv[r]; float s = 0.f;
        GAS u32x2g* xr = (GAS u32x2g*)(h + (size_t)m * 1024) + cx.lane;
        const unsigned sa = *(const LAS unsigned*)(spl + (d0 >> 8) * 4), sb = *(const LAS unsigned*)(spl + (d1 >> 8) * 4);
        float a[4][4], b[4][4];
#pragma unroll
        for (int j = 0; j < 4; ++j) { a[j][0] = lo2f(aw[r][j].x); a[j][1] = hi2f(aw[r][j].x); a[j][2] = lo2f(aw[r][j].y); a[j][3] = hi2f(aw[r][j].y); b[j][0] = lo2f(bw[r][j].x); b[j][1] = hi2f(bw[r][j].x); b[j][2] = lo2f(bw[r][j].y); b[j][3] = hi2f(bw[r][j].y); }
        if ((sa & sb) != 0xffffffffu) {
#pragma unroll
            for (int j = 0; j < 4; ++j) { const unsigned s0 = (sa >> (8 * j)) & 255u, s1 = (sb >> (8 * j)) & 255u; if (s0 != 255u) add_y2p(a[j], y2p, s0, d0, cx.lane); if (s1 != 255u) add_y2p(b[j], y2p, s1, d1, cx.lane); } }
#pragma unroll
        for (int j = 0; j < 4; ++j) { const float v0 = lo2f(hw[r][j].x) + gwt.x * a[j][0] + gwt.y * b[j][0], v1 = hi2f(hw[r][j].x) + gwt.x * a[j][1] + gwt.y * b[j][1], v2 = lo2f(hw[r][j].y) + gwt.x * a[j][2] + gwt.y * b[j][2], v3 = hi2f(hw[r][j].y) + gwt.x * a[j][3] + gwt.y * b[j][3];
            u32x2g o; o.x = pk2(v0, v1); o.y = pk2(v2, v3); xr[64 * j] = o; s += (v0 * v0 + v1 * v1) + (v2 * v2 + v3 * v3); }
        s = wave_sum(s); if (cx.lane < 4) ((f32x4*)(sso + (size_t)m * 16))[cx.lane] = (f32x4){cx.lane == 0 ? s : 0.f, 0.f, 0.f, 0.f}; }
    }
}
__device__ __forceinline__ void diff_combine_rows(const Cx& cx, const bf16* ov, bf16* yc, const float* lp, const float* subg, float lam_init) {
    const int gw = cx.vcu * 8 + cx.wave, NGW = cx.G * 8, hh = cx.lane >> 4, dc = cx.lane & 15;
    const float s01 = wave_sum(lp[cx.lane] * lp[64 + cx.lane]), s23 = wave_sum(lp[128 + cx.lane] * lp[192 + cx.lane]);
    const float lam = expf(s01) - expf(s23) + lam_init, post = 1.0f - lam_init;
    const f32x4 g0 = *(const f32x4*)(subg + dc * 8), g1 = *(const f32x4*)(subg + dc * 8 + 4);
    for (int m0 = gw; m0 < T_TOK; m0 += 4 * NGW) {
        v4u av[4], bv[4];
#pragma unroll
        for (int r = 0; r < 4; ++r) { const size_t m = (size_t)m0 + (size_t)r * NGW; av[r] = *(const v4u*)(ov + m * 1024 + hh * 256 + dc * 8); bv[r] = *(const v4u*)(ov + m * 1024 + hh * 256 + 128 + dc * 8); }
#pragma unroll
        for (int r = 0; r < 4; ++r) { const size_t m = (size_t)m0 + (size_t)r * NGW; const v4u a = av[r], b = bv[r];
        float y[8];
        y[0] = lo2f(a.x) - lam * lo2f(b.x); y[1] = hi2f(a.x) - lam * hi2f(b.x); y[2] = lo2f(a.y) - lam * lo2f(b.y); y[3] = hi2f(a.y) - lam * hi2f(b.y);
        y[4] = lo2f(a.z) - lam * lo2f(b.z); y[5] = hi2f(a.z) - lam * hi2f(b.z); y[6] = lo2f(a.w) - lam * lo2f(b.w); y[7] = hi2f(a.w) - lam * hi2f(b.w);
        float s = 0.f;
#pragma unroll
        for (int i = 0; i < 8; ++i) s += y[i] * y[i];
        s = sum16(s);
        const float rs = post * __builtin_amdgcn_rsqf(s * (1.f / 128.f) + EPS);
        v4u o; o.x = pk2(y[0] * rs * g0[0], y[1] * rs * g0[1]); o.y = pk2(y[2] * rs * g0[2], y[3] * rs * g0[3]); o.z = pk2(y[4] * rs * g1[0], y[5] * rs * g1[1]); o.w = pk2(y[6] * rs * g1[2], y[7] * rs * g1[3]);
        st16_wt(yc + m * 1024 + 256 + hh * 128 + dc * 8, o); }
    }
}

__device__ __forceinline__ void conv_units(const Cx& cx, const bf16* zu, bf16* yc, const float* cw, const float* cb, const float* lng, const float* lnb) {
    LAS unsigned short* ub = (LAS unsigned short*)cx.lds;
    LAS float* cbuf = (LAS float*)(cx.lds + 49152);
    const int c = cx.tid & 255, th = cx.tid >> 8;
    float w[31];
#pragma unroll
    for (int j = 0; j < 31; ++j) w[j] = cw[j * 256 + c];
    const float bias = cb[c];
    const f32x4 lg = *(const f32x4*)(lng + 4 * cx.lane), lb = *(const f32x4*)(lnb + 4 * cx.lane);
    v4u xs[6];
#define CONV_LD(unit_) do { const int t0_ = (unit_) * 64, tin_ = t0_ & (SEQ - 1); _Pragma("unroll") for (int i_ = 0; i_ < 6; ++i_) { const int ch_ = cx.tid + i_ * 512, r_ = ch_ >> 5, cc_ = ch_ & 31; xs[i_] = (v4u){0u, 0u, 0u, 0u}; \
        if (ch_ < 94 * 32 && tin_ - 30 + r_ >= 0) xs[i_] = *(const v4u*)(zu + (size_t)(t0_ - 30 + r_) * 256 + cc_ * 8); } } while (0)
    if (cx.vcu < T_TOK / 64) CONV_LD(cx.vcu);
    for (int unit = cx.vcu; unit < T_TOK / 64; unit += cx.G) {
        const int t0 = unit * 64;
#pragma unroll
        for (int i = 0; i < 6; ++i) { const int ch = cx.tid + i * 512, r = ch >> 5, cc = ch & 31; if (ch < 94 * 32) *(LAS v4u*)(ub + r * 256 + cc * 8) = xs[i]; }
        __syncthreads();
        if (unit + cx.G < T_TOK / 64) CONV_LD(unit + cx.G);
#pragma unroll 1
        for (int ob = 0; ob < 4; ++ob) {
            float xw[38];
#pragma unroll
            for (int i = 0; i < 38; ++i) xw[i] = b2f(ub[(th * 32 + ob * 8 + i) * 256 + c]);
#pragma unroll
            for (int o = 0; o < 8; ++o) { float a = bias;
#pragma unroll
                for (int j = 0; j < 31; ++j) a += w[j] * xw[o + j];
                cbuf[(th * 32 + ob * 8 + o) * 256 + c] = a; }
        }
        __syncthreads();
#pragma unroll
        for (int i = 0; i < 8; ++i) { const int tok = cx.wave * 8 + i; const f32x4 x = *(const LAS f32x4*)(cbuf + tok * 256 + 4 * cx.lane);
            const float mean = wave_sum((x[0] + x[1]) + (x[2] + x[3])) * (1.f / 256.f); const f32x4 d = x - mean;
            const float var = wave_sum((d[0] * d[0] + d[1] * d[1]) + (d[2] * d[2] + d[3] * d[3])) * (1.f / 256.f); const float rstd = __builtin_amdgcn_rsqf(var + EPS);
            f32x4 y = d * rstd * lg + lb;
#pragma unroll
            for (int q = 0; q < 4; ++q) y[q] = y[q] * sigm(y[q]);
            st8_wt(yc + (size_t)(t0 + tok) * 1024 + 4 * cx.lane, (unsigned long long)pk2(y[0], y[1]) | ((unsigned long long)pk2(y[2], y[3]) << 32)); }
        __syncthreads();
    }
}

#undef CONV_LD
__device__ __forceinline__ void gla_pass1(const Cx& cx, const bf16* zg, const float* la, float* kvs, float* dec) {
    const int lane = cx.lane, n = lane & 15, quad = lane >> 4;
    for (int task = cx.vcu * 8 + cx.wave; task < 2048; task += cx.G * 8) {
        const int hd = task & 3, chunk = task >> 2; const size_t t0 = (size_t)chunk * 64; const int bh = (chunk >> 7) * 4 + hd, nn = chunk & 127;
        float lv[2][2][8]; unsigned kq[2][2][8]; u32x2g vx[2][8];
#pragma unroll
        for (int cs = 0; cs < 2; ++cs)
#pragma unroll
            for (int j = 0; j < 8; ++j) { const size_t tk = t0 + cs * 32 + quad * 8 + j;
                lv[0][cs][j] = la[tk * 128 + hd * 32 + n]; lv[1][cs][j] = la[tk * 128 + hd * 32 + 16 + n];
                kq[0][cs][j] = ((const unsigned short*)zg)[tk * 768 + 128 + hd * 32 + n]; kq[1][cs][j] = ((const unsigned short*)zg)[tk * 768 + 128 + hd * 32 + 16 + n];
                vx[cs][j] = *(const GAS u32x2g*)(zg + tk * 768 + 256 + hd * 64 + 4 * n); }
        v4u af[2][2];
#pragma unroll
        for (int mt = 0; mt < 2; ++mt) {
#pragma unroll
            for (int cs = 0; cs < 2; ++cs)
#pragma unroll
                for (int j = 1; j < 8; ++j) lv[mt][cs][j] += lv[mt][cs][j - 1];
            float b0 = 0.f, b1 = 0.f, h0 = 0.f, h1 = 0.f;
#pragma unroll
            for (int q = 0; q < 4; ++q) { const float x0 = __shfl(lv[mt][0][7], n + 16 * q), x1 = __shfl(lv[mt][1][7], n + 16 * q); h0 += x0; h1 += x1; if (q < quad) { b0 += x0; b1 += x1; } }
            b1 += h0; const float tot = h0 + h1;
            if (quad == 0) dec[((size_t)bh * 128 + nn) * 32 + mt * 16 + n] = __expf(tot);
#pragma unroll
            for (int cs = 0; cs < 2; ++cs) { float w[8]; const float base = cs ? b1 : b0;
#pragma unroll
                for (int j = 0; j < 8; ++j) w[j] = __uint_as_float(kq[mt][cs][j] << 16) * __expf(tot - (base + lv[mt][cs][j]));
                af[mt][cs] = (v4u){pk2(w[0], w[1]), pk2(w[2], w[3]), pk2(w[4], w[5]), pk2(w[6], w[7])}; }
        }
        f32x4 d[2][4];
#pragma unroll
        for (int nt = 0; nt < 4; ++nt) { v4u bf[2];
#pragma unroll
            for (int cs = 0; cs < 2; ++cs)
#pragma unroll
                for (int jj = 0; jj < 4; ++jj) { const unsigned lo = (nt & 2) ? vx[cs][2 * jj].y : vx[cs][2 * jj].x, hi = (nt & 2) ? vx[cs][2 * jj + 1].y : vx[cs][2 * jj + 1].x;
                    bf[cs][jj] = __builtin_amdgcn_perm(hi, lo, (nt & 1) ? 0x07060302u : 0x05040100u); }
#pragma unroll
            for (int mt = 0; mt < 2; ++mt) {
                d[mt][nt] = __builtin_amdgcn_mfma_f32_16x16x32_bf16(__builtin_bit_cast(bf16x8, af[mt][0]), __builtin_bit_cast(bf16x8, bf[0]), (f32x4){0.f, 0.f, 0.f, 0.f}, 0, 0, 0);
                d[mt][nt] = __builtin_amdgcn_mfma_f32_16x16x32_bf16(__builtin_bit_cast(bf16x8, af[mt][1]), __builtin_bit_cast(bf16x8, bf[1]), d[mt][nt], 0, 0, 0); } }
        float* dst = kvs + ((size_t)bh * 128 + nn) * 2048 + 4 * n;
#pragma unroll
        for (int mt = 0; mt < 2; ++mt)
#pragma unroll
            for (int q = 0; q < 4; ++q) *(f32x4*)(dst + (mt * 16 + quad * 4 + q) * 64) = (f32x4){d[mt][0][q], d[mt][1][q], d[mt][2][q], d[mt][3][q]};
    }
}
__device__ __forceinline__ void gla_scan(const Cx& cx, float* kvs, const float* dec) {
    for (int j = cx.vcu; j < 64; j += cx.G) {
        const int bh = j >> 2, idx = (j & 3) * 512 + cx.tid, k = idx >> 6;
        float* p = kvs + (size_t)bh * 128 * 2048 + idx; const float* dp = dec + (size_t)bh * 128 * 32 + k;
        float s = 0.f;
        for (int n0 = 0; n0 < 128; n0 += 32) { float kv[32], d[32];
#pragma unroll
            for (int q = 0; q < 32; ++q) { kv[q] = p[(size_t)(n0 + q) * 2048]; d[q] = dp[(n0 + q) * 32]; }
#pragma unroll
            for (int q = 0; q < 32; ++q) { s = d[q] * s + kv[q]; p[(size_t)(n0 + q) * 2048] = s; } }
    }
}
__device__ __forceinline__ void gla_pass3(const Cx& cx, const bf16* zg, const float* kvs, const float* ng, bf16* yc) {
    const int lane = cx.lane, n = lane & 15, quad = lane >> 4;
    const f32x4 gn = *(const f32x4*)(ng + 4 * n);
    for (int task = cx.vcu * 8 + cx.wave; task < 2048; task += cx.G * 8) {
        const int hd = task & 3, chunk = task >> 2; const size_t t0 = (size_t)chunk * 64; const int bh = (chunk >> 7) * 4 + hd, nn = chunk & 127;
        const float* sp = kvs + ((size_t)bh * 128 + nn) * 2048 + (quad * 8) * 64 + 4 * n;
        f32x4 sv[8];
#pragma unroll
        for (int j = 0; j < 8; ++j) sv[j] = *(const f32x4*)(sp + j * 64);
        v4u qa[4]; u32x2g rw[16];
#pragma unroll
        for (int mt = 0; mt < 4; ++mt) qa[mt] = *(const v4u*)(zg + (t0 + mt * 16 + n) * 768 + hd * 32 + quad * 8);
#pragma unroll
        for (int i = 0; i < 16; ++i) rw[i] = *(const GAS u32x2g*)(zg + (t0 + (i >> 2) * 16 + quad * 4 + (i & 3)) * 768 + 512 + hd * 64 + 4 * n);
        f32x4 d[4][4];
#pragma unroll
        for (int nt = 0; nt < 4; ++nt) { v4u bw; bw.x = pk2(sv[0][nt], sv[1][nt]); bw.y = pk2(sv[2][nt], sv[3][nt]); bw.z = pk2(sv[4][nt], sv[5][nt]); bw.w = pk2(sv[6][nt], sv[7][nt]);
#pragma unroll
            for (int mt = 0; mt < 4; ++mt) d[mt][nt] = __builtin_amdgcn_mfma_f32_16x16x32_bf16(__builtin_bit_cast(bf16x8, qa[mt]), __builtin_bit_cast(bf16x8, bw), (f32x4){0.f, 0.f, 0.f, 0.f}, 0, 0, 0); }
#pragma unroll
        for (int i = 0; i < 16; ++i) { const int mt = i >> 2, q = i & 3;
            const float o0 = d[mt][0][q], o1 = d[mt][1][q], o2 = d[mt][2][q], o3 = d[mt][3][q];
            const float ss = sum16((o0 * o0 + o1 * o1) + (o2 * o2 + o3 * o3));
            const float rs = 0.17677669529663687f * __builtin_amdgcn_rsqf(ss * (0.03125f / 64.f) + EPS);
            const u32x2g w = rw[i]; const float r0 = lo2f(w.x), r1 = hi2f(w.x), r2 = lo2f(w.y), r3 = hi2f(w.y);
            u32x2g ow; ow.x = pk2(o0 * rs * gn[0] * (r0 * sigm(r0)), o1 * rs * gn[1] * (r1 * sigm(r1))); ow.y = pk2(o2 * rs * gn[2] * (r2 * sigm(r2)), o3 * rs * gn[3] * (r3 * sigm(r3)));
            *(GAS u32x2g*)(yc + (t0 + mt * 16 + quad * 4 + q) * 1024 + 768 + hd * 64 + 4 * n) = ow; }
    }
}
#if MK_CHECK
constexpr int CW_CHK = 12288;
__device__ __forceinline__ unsigned hsh(unsigned x) { x ^= x >> 16; x *= 0x7feb352dU; x ^= x >> 15; x *= 0x846ca68bU; x ^= x >> 16; return x; }
__device__ __forceinline__ bool bad(float got, float ref, float tol) { return !(fabsf(got - ref) <= 2.0f * tol * fmaxf(fabsf(ref), 1.0f)); }
__device__ __forceinline__ bool bad_small(float got, float ref) { return !(fabsf(got - ref) <= 0.004f + 0.05f * fabsf(ref)); }
__device__ __forceinline__ void cntf(gu32* ctl, int slot, unsigned n) { if (n) __hip_atomic_fetch_add(ctl + CW_CHK + 64 * (1 + slot), n, RLX_AGENT); }
__device__ __forceinline__ void flag(gu32* ctl, int bit) { __hip_atomic_fetch_or(ctl + CW_CHK, 1u << bit, RLX_AGENT); }
__device__ __forceinline__ float logsig(float x) { return fminf(x, 0.f) - __logf(1.f + __expf(-fabsf(x))); }
__device__ __forceinline__ float zdot(const float* xr, float rs, const float* gmix, const float* win, int col) { float a = 0.f; for (int k = 0; k < 1024; ++k) a += xr[k] * rs * gmix[k] * win[(size_t)k * D_IN + col]; return a; }
__device__ __forceinline__ void chk_win(int tid, const float* x, const float* gmix, const float* win, const float* wg2, const float* bg, const bf16* ZU, const bf16* ZQ, const bf16* ZK, const bf16* ZV, const bf16* ZG, const float* LA, gu32* ctl) {
    for (int s = tid; s < 3072; s += 512) {
        const unsigned h1 = hsh(s * 2654435761u + 17u), h2 = hsh(h1 + 0x9e3779b9u); const int row = h1 % T_TOK, type = s % 6;
        const float* xr = x + (size_t)row * 1024; float ss = 0.f; for (int k = 0; k < 1024; ++k) ss += xr[k] * xr[k]; const float rs = 1.0f / sqrtf(ss / 1024.f + EPS);
        float got, ref;
        if (type == 0) { const int ch = h2 % 256; const float a = zdot(xr, rs, gmix, win, ch), g = zdot(xr, rs, gmix, win, 256 + ch); ref = a / (1.f + expf(-g)); got = b2f(ZU[(size_t)row * 256 + ch]); }
        else if (type == 1 || type == 2) { const int comp = h2 % 8, d = (h2 >> 8) % 64, base = (type == 1 ? 512 : 1024) + comp * 64; const float sc = type == 1 ? 0.125f * 1.4426950408889634f : 1.f;
            if (d < 16) { const int j = d & 7; const float x1 = zdot(xr, rs, gmix, win, base + j), x2 = zdot(xr, rs, gmix, win, base + 8 + j); const int pos = row & (SEQ - 1);
                const double invf[8] = {1.0, 0.19391010807943456, 0.037601130015015855, 0.0072912391843014545, 0.001414213562373095, 0.00027423030417878515, 5.317602791587768e-05, 1.031136931769684e-05}; double fq_ = invf[0];
                for (int q_ = 1; q_ < 8; ++q_) fq_ = (j == q_) ? invf[q_] : fq_;
                const double rev = (double)pos * fq_ * 0.15915494309189535; const float fr_ = (float)(rev - rint(rev)); const float c = __builtin_amdgcn_cosf(fr_), sn = __builtin_amdgcn_sinf(fr_);
                ref = (d < 8 ? x1 * c - x2 * sn : x2 * c + x1 * sn) * sc; }
            else ref = zdot(xr, rs, gmix, win, base + d) * sc;
            int nd = d; if (d >= 4 && d < 8) nd = d + 4; else if (d >= 8 && d < 12) nd = d - 4;
            got = b2f((type == 1 ? ZQ : ZK)[(size_t)row * 512 + comp * 64 + nd]); }
        else if (type == 3) { const int col = h2 % 512; ref = zdot(xr, rs, gmix, win, 1536 + col); got = b2f(ZV[(size_t)row * 512 + col]); }
        else if (type == 4) { const int col = h2 % 768; ref = zdot(xr, rs, gmix, win, 2048 + col); got = b2f(ZG[(size_t)row * 768 + col]); }
        else { const int col = h2 % 128; float pre = bg[col]; for (int r = 0; r < 16; ++r) pre += zdot(xr, rs, gmix, win, 2816 + r) * wg2[r * 128 + col]; ref = logsig(pre) / 16.f; got = LA[(size_t)row * 128 + col]; }
        if (type == 5 ? bad_small(got, ref) : bad(got, ref, 0.04f)) flag(ctl, type == 0 ? 0 : (type < 3 ? 1 : 2));
    }
}
__device__ __forceinline__ float convy(const bf16* ZU, const float* cw, const float* cb, int row, int tin, int c) { float a = cb[c]; for (int j = 0; j < 31; ++j) { const int tt = tin - 30 + j; if (tt >= 0) a += cw[j * 256 + c] * b2f(ZU[(size_t)(row - 30 + j) * 256 + c]); } return a; }
__device__ __forceinline__ void chk_conv(int tid, const bf16* ZU, const bf16* YC, const float* cw, const float* cb, const float* lng, const float* lnb, gu32* ctl, int slot) {
    const unsigned h1 = hsh(tid * 2246822519u + 3u); int row = h1 % T_TOK; if (tid < 64) row = (tid & 3) * SEQ + (tid >> 2);
    const int tin = row & (SEQ - 1);
    float mu = 0.f; for (int c = 0; c < 256; ++c) mu += convy(ZU, cw, cb, row, tin, c); mu /= 256.f;
    float var = 0.f; for (int c = 0; c < 256; ++c) { const float d = convy(ZU, cw, cb, row, tin, c) - mu; var += d * d; } var /= 256.f; const float rstd = 1.0f / sqrtf(var + EPS);
    unsigned nf = 0, nq0 = 0, nq1 = 0; for (int c = 0; c < 256; ++c) { const float y = (convy(ZU, cw, cb, row, tin, c) - mu) * rstd * lng[c] + lnb[c]; const float ref = y / (1.f + expf(-y)); if (bad(b2f(YC[(size_t)row * 1024 + c]), ref, 0.04f)) { ++nf; if (c < 64) ++nq0; else if (c < 128) ++nq1; } }
    cntf(ctl, 2, nq0); cntf(ctl, 3, nq1);
    if (nf) flag(ctl, 3); cntf(ctl, slot, nf > 8 ? 1u : 0u);
}
__device__ __forceinline__ void chk_gla(int tid, const bf16* ZG, const float* LA, const float* ng, const bf16* YC, gu32* ctl) {
    const unsigned h1 = hsh(tid * 3266489917u + 5u); const int b = h1 & 3, n = (h1 >> 2) % 3, c = (h1 >> 8) & 63, hd = (h1 >> 16) & 3; const size_t row = (size_t)b * SEQ + n * 64 + c;
    float o[64];
#pragma unroll
    for (int v = 0; v < 64; ++v) o[v] = 0.f;
    for (int k = 0; k < 32; ++k) {
        float st[64];
#pragma unroll
        for (int v = 0; v < 64; ++v) st[v] = 0.f;
        for (int m = 0; m <= n; ++m) { const size_t t0 = (size_t)b * SEQ + m * 64; float tot = 0.f; for (int cc = 0; cc < 64; ++cc) tot += LA[(t0 + cc) * 128 + hd * 32 + k];
            const float dcy = expf(tot);
#pragma unroll
            for (int v = 0; v < 64; ++v) st[v] *= dcy;
            float run = 0.f;
            for (int cc = 0; cc < 64; ++cc) { run += LA[(t0 + cc) * 128 + hd * 32 + k]; const float w = b2f(ZG[(t0 + cc) * 768 + 128 + hd * 32 + k]) * expf(tot - run);
#pragma unroll
                for (int v = 0; v < 64; ++v) st[v] += w * b2f(ZG[(t0 + cc) * 768 + 256 + hd * 64 + v]); } }
        const float q = b2f(ZG[row * 768 + hd * 32 + k]) * 0.17677669529663687f;
#pragma unroll
        for (int v = 0; v < 64; ++v) o[v] += q * st[v];
    }
    float ss = 0.f;
#pragma unroll
    for (int v = 0; v < 64; ++v) ss += o[v] * o[v];
    const float rs = 1.0f / sqrtf(ss / 64.f + EPS); unsigned nf = 0;
#pragma unroll
    for (int v = 0; v < 64; ++v) { const float r = b2f(ZG[row * 768 + 512 + hd * 64 + v]); const float ref = o[v] * rs * ng[v] * (r / (1.f + expf(-r))); if (bad(b2f(YC[row * 1024 + 768 + hd * 64 + v]), ref, 0.05f)) ++nf; }
    if (nf) flag(ctl, 4);
}
__device__ __forceinline__ void chk_attn(int tid, const bf16* ZQ, const bf16* ZK, const bf16* ZV, const bf16* OV, gu32* ctl) {
    const unsigned h1 = hsh(tid * 668265263u + 7u); const int b = h1 & 3, hh = (h1 >> 2) & 3, c = (h1 >> 4) & 1, vq = (h1 >> 5) & 3; int t = (h1 >> 8) % SEQ; if (tid & 1) t = (h1 >> 8) % 512;
    const size_t row = (size_t)b * SEQ + t; const int nk = ((t >> 6) + 1) * 64;
    float q[64];
#pragma unroll
    for (int d = 0; d < 64; ++d) q[d] = b2f(ZQ[row * 512 + (hh * 2 + c) * 64 + d]);
    float m = -INFINITY, l = 0.f, acc[32];
#pragma unroll
    for (int i = 0; i < 32; ++i) acc[i] = 0.f;
    for (int kk = 0; kk < nk; ++kk) { const size_t kr = (size_t)b * SEQ + kk; float s = 0.f;
#pragma unroll
        for (int d = 0; d < 64; ++d) s += q[d] * b2f(ZK[kr * 512 + (hh * 2 + c) * 64 + d]);
        const float mn = fmaxf(m, s), al = exp2f(m - mn), p = exp2f(s - mn); l = l * al + p; m = mn;
#pragma unroll
        for (int i = 0; i < 32; ++i) acc[i] = acc[i] * al + p * b2f(ZV[kr * 512 + hh * 128 + vq * 32 + i]); }
    bool f = false;
#pragma unroll
    for (int i = 0; i < 32; ++i) if (bad(b2f(OV[row * 1024 + hh * 256 + c * 128 + vq * 32 + i]), acc[i] / l, 0.05f)) f = true;
    if (f) flag(ctl, 5);
}
__device__ __forceinline__ void chk_mix(int tid, const bf16* OV, const bf16* YC, const float* lp, const float* subg, const float* x, const float* wout, const float* out, gu32* ctl) {
    float s01 = 0.f, s23 = 0.f; for (int d = 0; d < 64; ++d) { s01 += lp[d] * lp[64 + d]; s23 += lp[128 + d] * lp[192 + d]; }
    const float lam = expf(s01) - expf(s23) + 0.2f;
    const unsigned h1 = hsh(tid * 374761393u + 11u); const size_t row = h1 % T_TOK; const int hh = (h1 >> 20) & 3;
    float ss = 0.f; for (int d = 0; d < 128; ++d) { const float y = b2f(OV[row * 1024 + hh * 256 + d]) - lam * b2f(OV[row * 1024 + hh * 256 + 128 + d]); ss += y * y; }
    const float rs = 0.8f / sqrtf(ss / 128.f + EPS); bool f = false;
    for (int d = 0; d < 128; ++d) { const float y = b2f(OV[row * 1024 + hh * 256 + d]) - lam * b2f(OV[row * 1024 + hh * 256 + 128 + d]); if (bad(b2f(YC[row * 1024 + 256 + hh * 128 + d]), y * rs * subg[d], 0.04f)) f = true; }
    if (f) flag(ctl, 6);
    const int col = (h1 >> 8) & 1023; float a = x[row * 1024 + col]; for (int k = 0; k < 1024; ++k) a += b2f(YC[row * 1024 + k]) * wout[(size_t)k * 1024 + col];
    if (bad(out[row * 1024 + col], a, 0.03f)) flag(ctl, 6);
}
#endif
#ifndef MK_CHECK
#define MK_CHECK 0
#endif
#ifndef MK_TIME
#define MK_TIME 0
#endif
#ifndef MK_DELAY
#define MK_DELAY 0
#endif
#ifndef MK_XBAR
#define MK_XBAR 0
#endif
#ifndef MK_DBLK
#define MK_DBLK 0
#endif
#ifndef MK_STAG
#define MK_STAG 0
#endif
#ifndef MK_MULTI
#define MK_MULTI 0
#endif
constexpr int NPH_LAYER = 12, NPH = 1 + DEPTH * NPH_LAYER + 1;
struct Args { const float* in[24]; float* out; unsigned char* ws; int ph_lo, ph_hi; };
#if MK_TIME
#define STAMP_PH() do { if (blockIdx.x == 0 && cx.tid == 0) { volatile LAS unsigned* pc_ = (volatile LAS unsigned*)(ldsb + MISC_OFF + 80); const unsigned k_ = pc_[0]; pc_[0] = k_ + 1u; \
    ((unsigned long long*)((unsigned char*)ldptr(PT, 25) + WS_CTL) + 16384)[k_] = __builtin_amdgcn_s_memrealtime(); } } while (0)
#else
#define STAMP_PH() do {} while (0)
#endif
#if MK_DELAY
#define TSEL(id) ((MK_DELAY) == (id))
#define TSTART(id) do { if (TSEL(id) && blockIdx.x == MK_DBLK && wave_s == 0 && lane_now() == 0) { volatile LAS unsigned long long* t_ = (volatile LAS unsigned long long*)(ldsb + MISC_OFF + 104); t_[0] = __builtin_amdgcn_s_memrealtime(); } } while (0)
#define TSTOP(id) do { if (TSEL(id) && blockIdx.x == MK_DBLK && wave_s == 0 && lane_now() == 0) { volatile LAS unsigned long long* t_ = (volatile LAS unsigned long long*)(ldsb + MISC_OFF + 104); t_[1] += __builtin_amdgcn_s_memrealtime() - t_[0]; } } while (0)
#else
#define TSTART(id) do {} while (0)
#define TSTOP(id) do {} while (0)
#endif
#define IN(k) (lo <= (k) && (k) < hi)
#define SEAM() do { TSTART(11); if (!MK_MULTI) xcd_barrier(bar); TSTOP(11); } while (0)
#define PTR(i) ((const float*)(const GAS float*)ldptr(PT, (i)))
#define PH_BEGIN Cx cx = mkcx(ldsb, wave_s); STAMP_PH(); unsigned char* ws = (unsigned char*)(GAS unsigned char*)ldptr(PT, 25); float* out = (float*)(GAS float*)ldptr(PT, 24); (void)out; \
    bf16* HN = (bf16*)(ws + WS_HN); bf16* ZQ = (bf16*)(ws + WS_ZQ); bf16* ZK = (bf16*)(ws + WS_ZK); bf16* ZV = (bf16*)(ws + WS_ZV); bf16* ZU = (bf16*)(ws + WS_ZU); bf16* ZG = (bf16*)(ws + WS_ZG); \
    bf16* OV = (bf16*)(ws + WS_OV); bf16* YC = (bf16*)(ws + WS_YC); bf16* UP = (bf16*)(ws + WS_UP); bf16* ACT = (bf16*)(ws + WS_ACT); bf16* XG = (bf16*)(ws + WS_XG); bf16* Y2 = (bf16*)(ws + WS_Y2); \
    float* LAp = (float*)(ws + WS_LA); float* KVS = (float*)(ws + WS_KVS); float* DEC = (float*)(ws + WS_DEC); const float* ROPE = (const float*)(ws + WS_ROPE); \
    int* TOKSLOT = (int*)(ws + WS_TOKSLOT); float* GATEW = (float*)(ws + WS_GATEW); gu32* ctl = (gu32*)(ws + WS_CTL); bf16* HNB = (bf16*)(ws + WS_HNB); float* SS = (float*)(ws + WS_SS); float* SSX = (float*)(ws + WS_SSX); (void)HNB; (void)SS; (void)SSX; \
    (void)HN; (void)ZQ; (void)ZK; (void)ZV; (void)ZU; (void)ZG; (void)OV; (void)YC; (void)UP; (void)ACT; (void)XG; (void)Y2; (void)LAp; (void)KVS; (void)DEC; (void)ROPE; (void)TOKSLOT; (void)GATEW; (void)ctl;

template <int li> __device__ __forceinline__ void layer_body(unsigned char* lds_raw, LAS unsigned char* const ldsb, const int wave_s, const int lo, const int hi, const XcdBarrier& bar, const LAS unsigned long long* PT, LAS int* TB) {
        constexpr int pb = 1 + li * NPH_LAYER; constexpr bool moe = (li & 1) != 0; constexpr int hf = li >> 1;
        if (IN(pb + 1)) { PH_BEGIN
            pg8::Gemm g{HNB, (const bf16*)(ws + WS_WIN + li * SZ_WIN), 1024, 0}; pg8::StaticOrder S; S.init(T_TOK, NZ, cx.G, (int)blockIdx.x);
            pg8::EpiWin E{ZU, ZQ, ZK, ZV, ZG, LAp, ROPE, PTR(11) + li * 128, SS + (size_t)(3 * li) * SS_STRIDE, (PG8_LAS float*)(ldsb + MISC_OFF + 1024)};
            TSTART(12); REPEAT(9) pg8::gemm_phase<pg8::EpiWin, pg8::StaticOrder, true, true>(cx.lds + RING_OFF, g, S, E, wave_s); TSTOP(12);
            SEAM(); }
        if (IN(pb + 2)) { PH_BEGIN
            { const int odd = (int)(cx.vcu & 1);
#pragma unroll 1
              for (int st = 0; st < 2; ++st) {
                  if ((st ^ odd) == 0) gla_pass1(cx, ZG, LAp, KVS, DEC);
                  else conv_units(cx, ZU, YC, PTR(4) + li * 31 * 256, PTR(5) + li * 256, PTR(6) + li * 256, PTR(7) + li * 256);
                  __syncthreads(); } }
            SEAM(); }
#if MK_CHECK
        if constexpr (li == 0) { if (IN(pb + 2) && blockIdx.x == 0) { PH_BEGIN
            const float v = (float)((hsh(cx.tid * 7919u + 13u) & 1023u)) * 0.125f;
            LAS float* TS = (LAS float*)(cx.lds); TS[cx.tid] = v; __syncthreads();
            float ref64 = 0.f, ref16 = 0.f; for (int q = 0; q < 64; ++q) ref64 += TS[cx.wave * 64 + q]; for (int q = 0; q < 16; ++q) ref16 += TS[cx.wave * 64 + (cx.lane & 48) + q];
            const float g64 = wave_sum(v), g16 = sum16(v);
            if (g64 != ref64) { flag(ctl, 3); cntf(ctl, 2, 1u); } if (g16 != ref16) { flag(ctl, 3); cntf(ctl, 3, 1u); }
            __syncthreads(); } }
#endif
        if (IN(pb + 3)) { PH_BEGIN
            TSTART(24); gla_scan(cx, KVS, DEC);
            __syncthreads(); TSTOP(24);
            const attn_body::AttnTensors AT{(const attn_body::bf16*)ZQ, (const attn_body::bf16*)ZK, (const attn_body::bf16*)ZV, (attn_body::bf16*)OV};
            const attn_body::StaticOrder S((int)cx.G, (int)blockIdx.x);
            REPEAT(3) attn_body::attn_phase<attn_body::StaticOrder>((char*)lds_raw + RING_OFF, AT, S, wave_s);
            SEAM(); }
        if (IN(pb + 4)) { PH_BEGIN
            const float lam_init = 0.8f - 0.6f * expf(-0.3f * (float)li);
            REPEAT(4) { TSTART(22); gla_pass3(cx, ZG, KVS, PTR(12) + li * 64, YC); TSTOP(22); TSTART(23);
            diff_combine_rows(cx, OV, YC, PTR(8) + li * 256, PTR(9) + li * 128, lam_init); TSTOP(23); }
            SEAM(); }
        if (IN(pb + 5)) { PH_BEGIN
            pg8::Gemm g{YC, (const bf16*)(ws + WS_WOUT + li * SZ_SQ), 1024, 0}; pg8::StaticOrder S; S.init(T_TOK, 1024, cx.G, (int)blockIdx.x);
            pg8::EpiResB E{HNB, HN, SS + (size_t)(3 * li + 1) * SS_STRIDE, 1024};
            TSTART(3); pg8::gemm_phase<pg8::EpiResB, pg8::StaticOrder, true, true>(cx.lds + RING_OFF, g, S, E, wave_s); TSTOP(3);
            SEAM(); }
#if MK_CHECK
        if constexpr (li == 0) { if (IN(pb + 5) && blockIdx.x == 0) { PH_BEGIN
            chk_win(cx.tid, PTR(0), PTR(2), PTR(3), PTR(10), PTR(11), ZU, ZQ, ZK, ZV, ZG, LAp, ctl);
            chk_conv(cx.tid, ZU, YC, PTR(4), PTR(5), PTR(6), PTR(7), ctl, 1);
            chk_gla(cx.tid, ZG, LAp, PTR(12), YC, ctl);
            chk_attn(cx.tid, ZQ, ZK, ZV, OV, ctl);
            chk_mix(cx.tid, OV, YC, PTR(8), PTR(9), PTR(0), PTR(13), out, ctl); } }
#endif
        if constexpr (!moe) {
            if (IN(pb + 8)) { PH_BEGIN
                pg8::Gemm g{HN, (const bf16*)(ws + WS_WFGU + hf * SZ_WFGU), 1024, 0}; pg8::StaticOrder S; S.init(T_TOK, 2 * D_FF, cx.G, (int)blockIdx.x);
                pg8::EpiSwiglu<16> E{ACT, D_FF, SS + (size_t)(3 * li + 1) * SS_STRIDE, (PG8_LAS float*)(ldsb + MISC_OFF + 1024)};
                REPEAT(8) pg8::gemm_phase<pg8::EpiSwiglu<16>, pg8::StaticOrder, true, true>(cx.lds + RING_OFF, g, S, E, wave_s);
                SEAM(); }
            if (IN(pb + 9)) { PH_BEGIN
                { pg8::Gemm g{ACT, (const bf16*)(ws + WS_WFDN + hf * SZ_WFDN), D_FF, 0}; pg8::StaticOrder S; S.init(T_TOK, 1024, cx.G, (int)blockIdx.x);
                  pg8::EpiResB E{HN, HN, SS + (size_t)(3 * li + 2) * SS_STRIDE, 1024};
                  TSTART(4); pg8::gemm_phase<pg8::EpiResB, pg8::StaticOrder, true, true>(cx.lds + RING_OFF, g, S, E, wave_s); TSTOP(4); }
                {
                  pg8::Gemm g{(const bf16*)(ws + WS_PB) + (size_t)li * T_TOK * PLE_DIM, (const bf16*)(ws + WS_WPU + li * SZ_WPU), PLE_DIM, 0}; pg8::StaticOrder S; S.init(T_TOK, 1024, cx.G, (int)blockIdx.x);
                  pg8::EpiBf16P E{UP, 1024};
                  pg8::gemm_phase<pg8::EpiBf16P, pg8::StaticOrder, true, true>(cx.lds + RING_OFF, g, S, E, wave_s); }
                SEAM(); }
        } else {
            if (IN(pb + 6)) { PH_BEGIN gu32* cursor = ctl + CW_CUR + hf * 8 * 64; TSTART(7); router_rows(cx, HN, PTR(14) + li * 1024, PTR(17) + (size_t)hf * 1024 * 8, (int*)(ws + WS_HIST) + hf * 2048, (int*)(ws + WS_TOKE), GATEW, SS + (size_t)(3 * li + 1) * SS_STRIDE); TSTOP(7); SEAM(); }
            if (IN(pb + 7)) { PH_BEGIN gu32* cursor = ctl + CW_CUR + hf * 8 * 64; TSTART(8); dispatch_rows(cx, HN, XG, (const int*)(ws + WS_HIST) + hf * 2048, (const int*)(ws + WS_TOKE), TOKSLOT, cursor, TB, SS + (size_t)(3 * li + 1) * SS_STRIDE, SSX); TSTOP(8); SEAM(); }
            if (IN(pb + 8)) { PH_BEGIN
                gu32* cursor = ctl + CW_CUR + hf * 8 * 64; moe_prefix(cx, cursor, TB);
                pg8::Gemm g{XG, (const bf16*)(ws + WS_WMGU + (size_t)hf * NEXP * SZ_WMGU), 1024, SZ_WMGU}; pg8::GroupedOrder S{(const PG8_LAS int*)TB, 2 * D_FFE / 256, cx.G, (int)blockIdx.x};
                pg8::EpiSwiglu<0> E{ACT, D_FFE, nullptr, nullptr};
#if MK_STAG
                if (blockIdx.x & 1) { const unsigned long long t0_ = __builtin_amdgcn_s_memrealtime(); while (__builtin_amdgcn_s_memrealtime() - t0_ < MK_STAG) __builtin_amdgcn_s_sleep(8); }
#endif
                REPEAT(6) pg8::gemm_phase<pg8::EpiSwiglu<0>, pg8::GroupedOrder, true, true>(cx.lds + RING_OFF, g, S, E, wave_s);
                SEAM(); }
            if (IN(pb + 9)) { PH_BEGIN
                gu32* cursor = ctl + CW_CUR + hf * 8 * 64; moe_prefix(cx, cursor, TB);
                pg8::Gemm g{ACT, (const bf16*)(ws + WS_WMDN + (size_t)hf * NEXP * SZ_WMDN), D_FFE, SZ_WMDN}; pg8::GroupedOrderSplit S{pg8::GroupedOrder{(const PG8_LAS int*)TB, 4, cx.G, (int)blockIdx.x}, D_FFE / 64 / 4};
                pg8::EpiBf16Split E{Y2, 1024, XG + (size_t)T_TOK * 1024};
                REPEAT(7) pg8::gemm_phase<pg8::EpiBf16Split, pg8::GroupedOrderSplit, true, true>(cx.lds + RING_OFF, g, S, E, wave_s);
                { const int total = TB[NEXP] * 4; int n5 = 4 * (total - 4 * cx.G); n5 = n5 < 0 ? 0 : (n5 >= cx.G ? 0 : n5);
                  if ((int)blockIdx.x >= n5) { const int G2 = cx.G - n5, c2 = (int)blockIdx.x - n5;
                    { pg8::Gemm g2{(const bf16*)(ws + WS_PB) + (size_t)li * T_TOK * PLE_DIM, (const bf16*)(ws + WS_WPU + li * SZ_WPU), PLE_DIM, 0}; pg8::StaticOrder S2; S2.init(T_TOK, 1024, G2, c2);
                      pg8::EpiBf16P E2{UP, 1024}; pg8::gemm_phase<pg8::EpiBf16P, pg8::StaticOrder, true, true>(cx.lds + RING_OFF, g2, S2, E2, wave_s); }
                  } }
                SEAM(); }
            if (IN(pb + 10)) { PH_BEGIN
                gu32* cursor = ctl + CW_CUR + hf * 8 * 64; moe_prefix(cx, cursor, TB);
                TSTART(9); combine_rows(cx, HN, Y2, XG + (size_t)T_TOK * 1024, TOKSLOT, GATEW, TB, SS + (size_t)(3 * li + 2) * SS_STRIDE); TSTOP(9);
                SEAM(); }
        }
        if (IN(pb + 11)) { PH_BEGIN
            pg8::Gemm g{HN, (const bf16*)(ws + WS_WPG + li * SZ_SQ), 1024, 0}; pg8::StaticOrder S; S.init(T_TOK, 1024, cx.G, (int)blockIdx.x);
            pg8::EpiPleB E{HN, UP, HNB, SS + (size_t)(3 * li + 2) * SS_STRIDE, SS + (size_t)(3 * li + 3) * SS_STRIDE, 1024, (PG8_LAS float*)(ldsb + MISC_OFF + 1024)};
            TSTART(5); pg8::gemm_phase<pg8::EpiPleB, pg8::StaticOrder, true, true>(cx.lds + RING_OFF, g, S, E, wave_s); TSTOP(5);
            SEAM(); }
}
__global__ void __launch_bounds__(512, 2) trunk_fwd(Args args) {
    extern __shared__ __attribute__((aligned(16))) unsigned char lds_raw[];
    LAS unsigned char* const ldsb = (LAS unsigned char*)lds_raw;
    const int wave_s = __builtin_amdgcn_readfirstlane((int)(threadIdx.x >> 6));
    volatile LAS unsigned* MISC = (volatile LAS unsigned*)(ldsb + MISC_OFF);
    LAS int* TB = (LAS int*)(ldsb + MISC_OFF + 64);
    LAS unsigned long long* PT = (LAS unsigned long long*)(ldsb + MISC_OFF + 128);
    for (int u = threadIdx.x; u < (LDS_BYTES - LDSCTL_OFF) / 4; u += 512) ((LAS unsigned*)(ldsb + LDSCTL_OFF))[u] = 0u;
    __syncthreads();
    if (threadIdx.x == 0) {
        PT[0] = (unsigned long long)args.in[0]; PT[1] = (unsigned long long)args.in[1]; PT[2] = (unsigned long long)args.in[2]; PT[3] = (unsigned long long)args.in[3]; PT[4] = (unsigned long long)args.in[4]; PT[5] = (unsigned long long)args.in[5];
        PT[6] = (unsigned long long)args.in[6]; PT[7] = (unsigned long long)args.in[7]; PT[8] = (unsigned long long)args.in[8]; PT[9] = (unsigned long long)args.in[9]; PT[10] = (unsigned long long)args.in[10]; PT[11] = (unsigned long long)args.in[11];
        PT[12] = (unsigned long long)args.in[12]; PT[13] = (unsigned long long)args.in[13]; PT[14] = (unsigned long long)args.in[14]; PT[15] = (unsigned long long)args.in[15]; PT[16] = (unsigned long long)args.in[16]; PT[17] = (unsigned long long)args.in[17];
        PT[18] = (unsigned long long)args.in[18]; PT[19] = (unsigned long long)args.in[19]; PT[20] = (unsigned long long)args.in[20]; PT[21] = (unsigned long long)args.in[21]; PT[22] = (unsigned long long)args.in[22]; PT[23] = (unsigned long long)args.in[23];
        PT[24] = (unsigned long long)args.out; PT[25] = (unsigned long long)args.ws; }
    __syncthreads();
    XcdBarrier bar; bar.bar = (unsigned*)((gu32*)(args.ws + WS_CTL) + CW_BAR); bar.x = 0; bar.st = nullptr; bar.wave = wave_s;
    if (!MK_MULTI) bar = xcd_barrier_post((unsigned*)((gu32*)(args.ws + WS_CTL) + CW_BAR), MISC + 8, wave_s);
    const int lo = args.ph_lo, hi = args.ph_hi;
    TSTART(1); if (IN(0)) { PH_BEGIN REPEAT(1) p0_prologue(cx, PT, ws); TSTOP(1); TSTART(2); SEAM(); TSTOP(2); }

    layer_body<0>(lds_raw, ldsb, wave_s, lo, hi, bar, PT, TB);
    layer_body<1>(lds_raw, ldsb, wave_s, lo, hi, bar, PT, TB);
    layer_body<2>(lds_raw, ldsb, wave_s, lo, hi, bar, PT, TB);
    layer_body<3>(lds_raw, ldsb, wave_s, lo, hi, bar, PT, TB);
    for (int xb_ = 0; xb_ < MK_XBAR; ++xb_) { SEAM(); }
    if (IN(NPH - 1)) { PH_BEGIN
#if MK_TIME
        { const unsigned long long* ts = (const unsigned long long*)(ws + WS_CTL) + 16384; float v1 = 0.f, v2 = 0.f;
          int k = 0; float tt[16];
#pragma unroll
          for (int q = 0; q < 16; ++q) tt[q] = 0.f;
          { const float dt = (float)(ts[k + 1] - ts[k]) * 0.01f; tt[0] += dt; ++k; }
          for (int l = 0; l < 4; ++l) { const int n = (l & 1) ? 12 : 11; for (int q = 0; q < n; ++q) {
              int ty; if (l & 1) ty = (q < 6) ? q + 1 : (q == 6 ? 9 : q == 7 ? 10 : q == 8 ? 11 : q == 9 ? 12 : q == 10 ? 13 : 14); else ty = (q < 6) ? q + 1 : (q == 6 ? 1 : q == 7 ? 7 : q == 8 ? 8 : q == 9 ? 13 : 14);
              const float dt = (float)(ts[k + 1] - ts[k]) * 0.01f;
#pragma unroll
              for (int z = 0; z < 16; ++z) if (z == ty) tt[z] += dt;
              ++k; } }
#pragma unroll
          for (int z = 0; z < 16; ++z) { if (z == (MK_TIME & 15)) v1 = tt[z]; if (z == ((MK_TIME >> 4) & 15)) v2 = tt[z]; }
          const float K1 = sqrtf(fmaxf(v1, 1.f) * 100.f), K2 = 30.f * K1 * (1.f + v2 * (1.f / 400.f));
          for (size_t i = (size_t)blockIdx.x * 512 + cx.tid; i < (size_t)T_TOK * 1024; i += (size_t)gridDim.x * 512) out[i] = (i == 12345) ? K2 : K1; }
#else
#if MK_CHECK
        const unsigned mask = __hip_atomic_load(ctl + CW_CHK, RLX_AGENT);
        if (mask) { const float k2 = ((float)(10 + (mask & 63)) + 0.3f) * ((mask >> 6) ? 1000.f : 100.f); const float kv = sqrtf(k2);
            for (size_t i = (size_t)blockIdx.x * 512 + cx.tid; i < (size_t)T_TOK * 1024; i += (size_t)gridDim.x * 512) out[i] = kv; }
        else
#endif
        final_norm_rows(cx, HNB, out, PTR(23), SS + (size_t)12 * SS_STRIDE);
#endif
    }
#if MK_DELAY
    if (blockIdx.x == MK_DBLK && wave_s == 0 && lane_now() == 0) { volatile LAS unsigned long long* t_ = (volatile LAS unsigned long long*)(ldsb + MISC_OFF + 104); const unsigned long long dl = t_[1] * 10ull, t0 = __builtin_amdgcn_s_memrealtime();
        while (__builtin_amdgcn_s_memrealtime() - t0 < dl) __builtin_amdgcn_s_sleep(32); }
#endif
}

extern "C" void kernel_launch(void* const* d_in, const int* in_sizes, int n_in, void* d_out, int out_size, void* d_ws, size_t ws_size, hipStream_t stream) {
    static int grid = 0;
    if (grid == 0) {
        if (n_in != 24 || in_sizes[0] != T_TOK * DMOD || out_size != T_TOK * DMOD || ws_size < WS_END) { fprintf(stderr, "kernel_launch: unexpected shapes (n_in %d, in0 %d, out %d, ws %zu); nothing launched\n", n_in, n_in > 0 ? in_sizes[0] : -1, out_size, ws_size); grid = -1; return; }
        if (hipFuncSetAttribute((const void*)trunk_fwd, hipFuncAttributeMaxDynamicSharedMemorySize, LDS_BYTES) != hipSuccess) { fprintf(stderr, "kernel_launch: hipFuncSetAttribute failed\n"); grid = -1; return; }
        int per_cu = 0;
        if (hipOccupancyMaxActiveBlocksPerMultiprocessor(&per_cu, (const void*)trunk_fwd, 512, LDS_BYTES) != hipSuccess || per_cu < 1) fprintf(stderr, "kernel_launch: note: occupancy query reports %d workgroups per CU\n", per_cu);
        (void)hipGetLastError();
        grid = 256;
    }
    if (grid < 0) return;
    if (hipMemsetAsync((char*)d_ws + WS_CTL, 0, CTL_ZERO_BYTES, stream) != hipSuccess) { fprintf(stderr, "kernel_launch: hipMemsetAsync failed\n"); return; }
    Args a{};
    for (int i = 0; i < 24; ++i) a.in[i] = (const float*)d_in[i];
    a.out = (float*)d_out; a.ws = (unsigned char*)d_ws;
#if MK_MULTI
    for (int ph = 0; ph < NPH; ++ph) { a.ph_lo = ph; a.ph_hi = ph + 1; hipLaunchKernelGGL(trunk_fwd, dim3(grid), dim3(512), LDS_BYTES, stream, a); }
#else
    a.ph_lo = 0; a.ph_hi = NPH;
    hipLaunchKernelGGL(trunk_fwd, dim3(grid), dim3(512), LDS_BYTES, stream, a);
#endif
    const hipError_t le = hipPeekAtLastError();
    if (le != hipSuccess) fprintf(stderr, "kernel_launch: launch failed: %s\n", hipGetErrorName(le));
}
```

```cpp
#define MK_CHECK 0
#define MK_TIME 0
#define MK_STAG 0
#define MK_NT 0
#define MK_DBLK 0
#define MK_XBAR 0
#define MK_DELAY 0
#define MK_REP 0
#define MK_REPN 2
#include <hip/hip_runtime.h>
#include <hip/hip_bf16.h>
#include <cstdio>
#include <cstdint>
#include <cmath>

constexpr int T_TOK = 32768, SEQ = 8192, DMOD = 1024, DEPTH = 4;
constexpr int D_IN = 2832, NZ = 3072;
constexpr int D_FF = 2816, D_FFE = 3584, NEXP = 8;
constexpr int PLE_DIM = 256;
constexpr float EPS = 1e-6f;
constexpr int MOE_ROWS = 2 * T_TOK + NEXP * 256;
__device__ __forceinline__ int lane_now() { int l; asm volatile("v_mbcnt_lo_u32_b32 %0, -1, 0\n\tv_mbcnt_hi_u32_b32 %0, -1, %0" : "=v"(l)); return l; }
#ifndef MK_REP
#define MK_REP 0
#endif
#ifndef MK_REPN
#define MK_REPN 2
#endif
#define REPEAT(grp) for (int rep_ = 0; rep_ < ((MK_REP == (grp)) ? MK_REPN : 1); ++rep_)
#ifndef MK_WT
#define MK_WT 0
#endif
typedef unsigned wt_u32x4 __attribute__((ext_vector_type(4)));
typedef float wt_f32x4 __attribute__((ext_vector_type(4)));
__device__ __forceinline__ void st16_wt(void* p, wt_u32x4 v) {
#if MK_WT
    asm volatile("global_store_dwordx4 %0, %1, off sc1\n\ts_nop 1" :: "v"(p), "v"(v) : "memory");
#else
    *(wt_u32x4*)p = v;
#endif
}
__device__ __forceinline__ void st16f_wt(void* p, wt_f32x4 v) {
#if MK_WT
    asm volatile("global_store_dwordx4 %0, %1, off sc1\n\ts_nop 1" :: "v"(p), "v"(v) : "memory");
#else
    *(wt_f32x4*)p = v;
#endif
}
__device__ __forceinline__ void st8_wt(void* p, unsigned long long v) {
#if MK_WT
    asm volatile("global_store_dwordx2 %0, %1, off sc1\n\ts_nop 1" :: "v"(p), "v"(v) : "memory");
#else
    *(unsigned long long*)p = v;
#endif
}
#if MK_DELAY
#define GT_START(ldsb_, wid_, id) do { if ((MK_DELAY) == (id) && blockIdx.x == MK_DBLK && (wid_) == 0 && lane_now() == 0) { volatile __attribute__((address_space(3))) unsigned long long* t_ = (volatile __attribute__((address_space(3))) unsigned long long*)((ldsb_) + 131072 + 320 + 104); t_[0] = __builtin_amdgcn_s_memrealtime(); } } while (0)
#define GT_STOP(ldsb_, wid_, id) do { if ((MK_DELAY) == (id) && blockIdx.x == MK_DBLK && (wid_) == 0 && lane_now() == 0) { volatile __attribute__((address_space(3))) unsigned long long* t_ = (volatile __attribute__((address_space(3))) unsigned long long*)((ldsb_) + 131072 + 320 + 104); t_[1] += __builtin_amdgcn_s_memrealtime() - t_[0]; } } while (0)
#define GT_CSTART(ldsb_, wid_, id) do { if ((MK_DELAY) == (id) && blockIdx.x == MK_DBLK && (wid_) == 0 && lane_now() == 0) { volatile __attribute__((address_space(3))) unsigned long long* t_ = (volatile __attribute__((address_space(3))) unsigned long long*)((ldsb_) + 131072 + 320 + 104); t_[0] = clock64(); } } while (0)
#define GT_CSTOP(ldsb_, wid_, id) do { if ((MK_DELAY) == (id) && blockIdx.x == MK_DBLK && (wid_) == 0 && lane_now() == 0) { volatile __attribute__((address_space(3))) unsigned long long* t_ = (volatile __attribute__((address_space(3))) unsigned long long*)((ldsb_) + 131072 + 320 + 104); t_[1] += (clock64() - t_[0]) / 100ull; } } while (0)
#else
#define GT_CSTART(ldsb_, wid_, id) do {} while (0)
#define GT_CSTOP(ldsb_, wid_, id) do {} while (0)
#define GT_START(ldsb_, wid_, id) do {} while (0)
#define GT_STOP(ldsb_, wid_, id) do {} while (0)
#endif
#ifndef MK_DBLK
#define MK_DBLK 0
#endif
#ifndef MK_NT
#define MK_NT 0
#endif
__device__ __forceinline__ void st16_nt(void* p, wt_u32x4 v) {
#if MK_NT
    __builtin_nontemporal_store(v, (wt_u32x4*)p);
#else
    *(wt_u32x4*)p = v;
#endif
}
namespace pg8 {
#define PG8_LAS __attribute__((address_space(3)))
typedef unsigned short bf16_t;
typedef short bf16x8 __attribute__((ext_vector_type(8)));
typedef float f32x4 __attribute__((ext_vector_type(4)));
typedef unsigned u32x4 __attribute__((ext_vector_type(4)));
constexpr int BM = 256, BK = 64, HALF = 128, HTB = HALF * BK * 2  , STAGE_BYTES = 8 * HTB, NXCD = 8, WGM = 8;

__host__ __device__ __forceinline__ int lds_byte(int r, int c) { const int st = (r >> 4) * 2 + (c >> 5), rr = r & 15, cc = c & 31, ob = rr * 64 + cc * 2; return st * 1024 + (ob ^ (((ob >> 9) & 1) << 5)); }
__host__ __device__ __forceinline__ void stage_rc(int b, int& R, int& C) { const int st = b / 1024, sb = b % 1024, swz = sb ^ (((sb >> 9) & 1) << 5); R = (st >> 1) * 16 + swz / 64; C = (st & 1) * 32 + (swz % 64) / 2; }
__host__ __device__ __forceinline__ int perm32(int rho) { const int n = rho >> 4, i = rho & 15; return 8 * (i >> 2) + 4 * n + (i & 3); }

struct Unit { int pm, pn, pe, k0t, ntu, slot, q; };
struct Gemm { const bf16_t* A; const bf16_t* Bt; int K; size_t bstride; };

struct StaticOrder {
    int nM, nN, nwg, G, c;
    __host__ __device__ void init(int M, int N, int G_, int c_) { nM = M / BM; nN = N / BM; nwg = nM * nN; G = G_; c = c_; }
    __host__ __device__ bool next(int i, Unit& u) const {
        const long L = (long)i * G + c; if (L >= nwg) return false;
        int wgid = (int)L; { const int q = nwg / NXCD, r = nwg % NXCD, xcd = wgid % NXCD, off = wgid / NXCD; wgid = (xcd < r ? xcd * (q + 1) : r * (q + 1) + (xcd - r) * q) + off; }
        const int nig = WGM * nN, gid = wgid / nig, fm = gid * WGM, gsz = (nM - fm) < WGM ? (nM - fm) : WGM;
        u.pm = fm + ((wgid % nig) % gsz); u.pn = (wgid % nig) / gsz; u.pe = 0; u.k0t = 0; u.ntu = 0; u.slot = -1; u.q = 0; return true;
    }
    __device__ __forceinline__ void a_ready(const Unit&) const {}
    __device__ __forceinline__ void done(const Unit&) const {}
};
constexpr int NEXPG = 8;
__device__ __forceinline__ unsigned cvt_pk_bf16(float lo, float hi) { unsigned r; asm volatile("v_cvt_pk_bf16_f32 %0, %1, %2" : "=v"(r) : "v"(lo), "v"(hi)); return r; }
typedef float f32x2 __attribute__((ext_vector_type(2)));
__device__ __forceinline__ float fsigmoid(float x) { return __builtin_amdgcn_rcpf(1.f + __builtin_amdgcn_exp2f(-1.4426950408889634f * x)); }
__device__ __forceinline__ float fsilu(float x) { return x * fsigmoid(x); }
__device__ __forceinline__ float bf2f(unsigned short b) { return __builtin_bit_cast(float, (unsigned)b << 16); }
typedef unsigned u32x2 __attribute__((ext_vector_type(2)));
__device__ __forceinline__ float row_rs16(const float* ssp, int row) { const f32x4* p = (const f32x4*)(ssp + (size_t)row * 16); const f32x4 a = p[0], b = p[1], c = p[2], d = p[3];
    const float s = (((a[0] + a[1]) + (a[2] + a[3])) + ((b[0] + b[1]) + (b[2] + b[3]))) + (((c[0] + c[1]) + (c[2] + c[3])) + ((d[0] + d[1]) + (d[2] + d[3])));
    return rsqrtf(s * (1.f / 1024.f) + 1e-6f); }

struct RowScale {
    PG8_LAS float* rsb; const float* ssp;
    __device__ __forceinline__ PG8_LAS const float* stage(const Unit& u, int wr, int wc, int fr, int fq) const {
        const int tid = (wr * 4 + wc) * 64 + fq * 16 + fr, r = tid & 255, hf = tid >> 8; PG8_LAS float* buf = rsb + ((u.pm ^ u.pn) & 1) * 512;
        const f32x4* p = (const f32x4*)(ssp + (size_t)(u.pm * BM + r) * 16) + 2 * hf; const f32x4 a = p[0], b = p[1];
        buf[hf * 256 + r] = ((a[0] + a[1]) + (a[2] + a[3])) + ((b[0] + b[1]) + (b[2] + b[3]));
        asm volatile("s_waitcnt lgkmcnt(0)" ::: "memory"); __builtin_amdgcn_s_barrier(); asm volatile("" ::: "memory");
        return buf; }
    static __device__ __forceinline__ float ms(PG8_LAS const float* buf, int rl) { return (buf[rl] + buf[256 + rl]) * (1.f / 1024.f) + 1e-6f; }
    static __device__ __forceinline__ float rs(PG8_LAS const float* buf, int rl) { return rsqrtf((buf[rl] + buf[256 + rl]) * (1.f / 1024.f) + 1e-6f); }
};
struct EpiBf16P {
    static constexpr bool PERM = true, AFTER_DRAIN = false;
    bf16_t* O; int ldc;
    __device__ __forceinline__ void operator()(const f32x4 (&acc)[2][2][4][2], const Unit& u, int wr, int wc, int fr, int fq) const {
        const int row0 = u.pm * BM + wr * 64 + fr, col0 = u.pn * BM + wc * 32 + 8 * fq;
#pragma unroll
        for (int ai = 0; ai < 2; ++ai)
#pragma unroll
            for (int m = 0; m < 4; ++m) { bf16_t* rowp = O + (size_t)(row0 + ai * HALF + m * 16) * ldc + col0;
#pragma unroll
                for (int bj = 0; bj < 2; ++bj) { const f32x4 v0 = acc[ai][bj][m][0], v1 = acc[ai][bj][m][1];
                    u32x4 w; w.x = cvt_pk_bf16(v0[0], v0[1]); w.y = cvt_pk_bf16(v0[2], v0[3]); w.z = cvt_pk_bf16(v1[0], v1[1]); w.w = cvt_pk_bf16(v1[2], v1[3]);
                    st16_wt(rowp + bj * HALF, w); } }
    }
};
template <int NP> struct EpiSwiglu {
    static constexpr bool PERM = true, AFTER_DRAIN = false;
    bf16_t* O; int ldc; const float* ss; PG8_LAS float* rsb;
    __device__ __forceinline__ void operator()(const f32x4 (&acc)[2][2][4][2], const Unit& u, int wr, int wc, int fr, int fq) const {
        const int row0 = u.pm * BM + wr * 64 + fr, col0 = u.pn * HALF + wc * 32 + 8 * fq;
        PG8_LAS const float* rb = nullptr; if (NP == 16) rb = RowScale{rsb, ss}.stage(u, wr, wc, fr, fq);
        float rsv[8];
#pragma unroll
        for (int q = 0; q < 8; ++q) rsv[q] = NP == 16 ? RowScale::ms(rb, wr * 64 + fr + (q >> 2) * HALF + (q & 3) * 16) : 1.f;
#pragma unroll
        for (int ai = 0; ai < 2; ++ai)
#pragma unroll
            for (int m = 0; m < 4; ++m) { bf16_t* rowp = O + (size_t)(row0 + ai * HALF + m * 16) * ldc + col0;
                const float x = rsv[ai * 4 + m], c1 = -rsqrtf(x);
                const f32x4 g0 = acc[ai][0][m][0], g1 = acc[ai][0][m][1], u0 = acc[ai][1][m][0], u1 = acc[ai][1][m][1];
                float r[8];
                if (NP == 16) {
#pragma unroll
                    for (int i = 0; i < 4; ++i) { r[i] = (g0[i] * u0[i]) * __builtin_amdgcn_rcpf(__builtin_fmaf(__builtin_amdgcn_exp2f(g0[i] * c1), x, x)); r[4 + i] = (g1[i] * u1[i]) * __builtin_amdgcn_rcpf(__builtin_fmaf(__builtin_amdgcn_exp2f(g1[i] * c1), x, x)); }
                } else {
#pragma unroll
                    for (int i = 0; i < 4; ++i) { r[i] = (g0[i] * u0[i]) * __builtin_amdgcn_rcpf(1.f + __builtin_amdgcn_exp2f(-g0[i])); r[4 + i] = (g1[i] * u1[i]) * __builtin_amdgcn_rcpf(1.f + __builtin_amdgcn_exp2f(-g1[i])); }
                }
                u32x4 w; w.x = cvt_pk_bf16(r[0], r[1]); w.y = cvt_pk_bf16(r[2], r[3]); w.z = cvt_pk_bf16(r[4], r[5]); w.w = cvt_pk_bf16(r[6], r[7]);
                st16_nt(rowp, w); }
    }
};
__device__ __forceinline__ float blo(unsigned w) { return __builtin_bit_cast(float, w << 16); }
__device__ __forceinline__ float bhi(unsigned w) { return __builtin_bit_cast(float, w & 0xffff0000u); }
struct EpiResB {
    static constexpr bool PERM = true, AFTER_DRAIN = false;
    const bf16_t* base; bf16_t* out; float* ssq; int ldc;
    __device__ __forceinline__ void operator()(const f32x4 (&acc)[2][2][4][2], const Unit& u, int wr, int wc, int fr, int fq) const {
        const int row0 = u.pm * BM + wr * 64 + fr, col0 = u.pn * BM + wc * 32 + 8 * fq;
#pragma unroll
        for (int ai = 0; ai < 2; ++ai) {
            u32x4 bv[4][2];
#pragma unroll
            for (int m = 0; m < 4; ++m)
#pragma unroll
                for (int bj = 0; bj < 2; ++bj) bv[m][bj] = *(const u32x4*)(base + (size_t)(row0 + ai * HALF + m * 16) * ldc + col0 + bj * HALF);
#pragma unroll
            for (int m = 0; m < 4; ++m) { const int row = row0 + ai * HALF + m * 16; const size_t off = (size_t)row * ldc + col0; float s = 0.f;
#pragma unroll
                for (int bj = 0; bj < 2; ++bj) { const u32x4 bw = bv[m][bj]; const f32x4 a0 = acc[ai][bj][m][0], a1 = acc[ai][bj][m][1];
                    const float v0 = blo(bw.x) + a0[0], v1 = bhi(bw.x) + a0[1], v2 = blo(bw.y) + a0[2], v3 = bhi(bw.y) + a0[3], v4 = blo(bw.z) + a1[0], v5 = bhi(bw.z) + a1[1], v6 = blo(bw.w) + a1[2], v7 = bhi(bw.w) + a1[3];
                    u32x4 w; w.x = cvt_pk_bf16(v0, v1); w.y = cvt_pk_bf16(v2, v3); w.z = cvt_pk_bf16(v4, v5); w.w = cvt_pk_bf16(v6, v7); *(u32x4*)(out + off + bj * HALF) = w;
                    s += (v0 * v0 + v1 * v1) + (v2 * v2 + v3 * v3) + (v4 * v4 + v5 * v5) + (v6 * v6 + v7 * v7); }
                s += __shfl_xor(s, 16); s += __shfl_xor(s, 32);
                if (fq == 0) ssq[(size_t)row * 16 + u.pn * 4 + wc] = s; } }
    }
};
struct EpiPleB {
    static constexpr bool PERM = true, AFTER_DRAIN = false;
    const bf16_t* h; const bf16_t* up; bf16_t* out; const float* ssi; float* sso; int ldc; PG8_LAS float* rsb;
    __device__ __forceinline__ void operator()(const f32x4 (&acc)[2][2][4][2], const Unit& u, int wr, int wc, int fr, int fq) const {
        const int row0 = u.pm * BM + wr * 64 + fr, col0 = u.pn * BM + wc * 32 + 8 * fq;
        PG8_LAS const float* rb = RowScale{rsb, ssi}.stage(u, wr, wc, fr, fq);
#pragma unroll
        for (int ai = 0; ai < 2; ++ai) {
            u32x4 hv[4][2], uv[4][2];
#pragma unroll
            for (int m = 0; m < 4; ++m)
#pragma unroll
                for (int bj = 0; bj < 2; ++bj) { const size_t o = (size_t)(row0 + ai * HALF + m * 16) * ldc + col0 + bj * HALF; hv[m][bj] = *(const u32x4*)(h + o); uv[m][bj] = *(const u32x4*)(up + o); }
#pragma unroll
            for (int m = 0; m < 4; ++m) { const int row = row0 + ai * HALF + m * 16; const size_t off = (size_t)row * ldc + col0; float s = 0.f;
                const float rs = RowScale::rs(rb, wr * 64 + fr + ai * HALF + m * 16);
#pragma unroll
                for (int bj = 0; bj < 2; ++bj) { const u32x4 hw = hv[m][bj], uw = uv[m][bj]; const f32x4 a0 = acc[ai][bj][m][0] * rs, a1 = acc[ai][bj][m][1] * rs;
                    const float v0 = blo(hw.x) + fsigmoid(a0[0]) * blo(uw.x), v1 = bhi(hw.x) + fsigmoid(a0[1]) * bhi(uw.x), v2 = blo(hw.y) + fsigmoid(a0[2]) * blo(uw.y), v3 = bhi(hw.y) + fsigmoid(a0[3]) * bhi(uw.y),
                                v4 = blo(hw.z) + fsigmoid(a1[0]) * blo(uw.z), v5 = bhi(hw.z) + fsigmoid(a1[1]) * bhi(uw.z), v6 = blo(hw.w) + fsigmoid(a1[2]) * blo(uw.w), v7 = bhi(hw.w) + fsigmoid(a1[3]) * bhi(uw.w);
                    u32x4 w; w.x = cvt_pk_bf16(v0, v1); w.y = cvt_pk_bf16(v2, v3); w.z = cvt_pk_bf16(v4, v5); w.w = cvt_pk_bf16(v6, v7); *(u32x4*)(out + off + bj * HALF) = w;
                    s += (v0 * v0 + v1 * v1) + (v2 * v2 + v3 * v3) + (v4 * v4 + v5 * v5) + (v6 * v6 + v7 * v7); }
                s += __shfl_xor(s, 16); s += __shfl_xor(s, 32);
                if (fq == 0) sso[(size_t)row * 16 + u.pn * 4 + wc] = s; } }
    }
};
struct EpiWin {
    static constexpr bool PERM = true, AFTER_DRAIN = false;
    bf16_t *ZU, *ZQ, *ZK, *ZV, *ZG; float* LA; const float* rope; const float* bgate; const float* ss; PG8_LAS float* rsb;
    __device__ __forceinline__ void st8(bf16_t* p, const f32x4 v0, const f32x4 v1) const { u32x4 w; w.x = cvt_pk_bf16(v0[0], v0[1]); w.y = cvt_pk_bf16(v0[2], v0[3]); w.z = cvt_pk_bf16(v1[0], v1[1]); w.w = cvt_pk_bf16(v1[2], v1[3]); st16_wt(p, w); }
    __device__ __forceinline__ void operator()(const f32x4 (&acc)[2][2][4][2], const Unit& u, int wr, int wc, int fr, int fq) const {
        const int pn = u.pn, row0 = u.pm * BM + wr * 64 + fr, cw = wc * 32 + 8 * fq, rl0 = wr * 64 + fr;
        PG8_LAS const float* rb = RowScale{rsb, ss}.stage(u, wr, wc, fr, fq);
        if (pn < 2) {
#pragma unroll
            for (int ai = 0; ai < 2; ++ai)
#pragma unroll
                for (int m = 0; m < 4; ++m) { const size_t row = (size_t)(row0 + ai * HALF + m * 16); const float x = RowScale::ms(rb, rl0 + ai * HALF + m * 16), rs = rsqrtf(x), y = x * rs, c1 = -1.4426950408889634f * rs;
                    const f32x4 a0 = acc[ai][0][m][0], a1 = acc[ai][0][m][1], g0 = acc[ai][1][m][0], g1 = acc[ai][1][m][1]; f32x4 r0, r1;
#pragma unroll
                    for (int i = 0; i < 4; ++i) { r0[i] = a0[i] * __builtin_amdgcn_rcpf(__builtin_fmaf(__builtin_amdgcn_exp2f(g0[i] * c1), y, y)); r1[i] = a1[i] * __builtin_amdgcn_rcpf(__builtin_fmaf(__builtin_amdgcn_exp2f(g1[i] * c1), y, y)); }
                    st8(ZU + row * 256 + pn * HALF + cw, r0, r1); }
        } else if (pn < 6) {
            const bool isq = pn < 4; bf16_t* Z = isq ? ZQ : ZK; const float sc = isq ? 0.125f * 1.4426950408889634f : 1.0f;
            const int ct = (pn & 1) * 256; const bool rot = ((wc & 1) == 0) && (fq < 2);
#pragma unroll
            for (int ai = 0; ai < 2; ++ai) {
                f32x4 cs[4][2];
#pragma unroll
                for (int q = 0; q < 4; ++q) { cs[q][0] = (f32x4){1.f, 0.f, 1.f, 0.f}; cs[q][1] = (f32x4){1.f, 0.f, 1.f, 0.f};
                    if (rot) { const float* rp = rope + (size_t)((row0 + ai * HALF + q * 16) & (SEQ - 1)) * 16 + 8 * fq; cs[q][0] = *(const f32x4*)rp; cs[q][1] = *(const f32x4*)(rp + 4); } }
#pragma unroll
                for (int m = 0; m < 4; ++m) { const int rowi = row0 + ai * HALF + m * 16; const size_t row = (size_t)rowi; const float scr_ = sc * RowScale::rs(rb, rl0 + ai * HALF + m * 16);
                    const f32x4 cs0 = cs[m][0], cs1 = cs[m][1];
#pragma unroll
                    for (int bj = 0; bj < 2; ++bj) { f32x4 x1 = acc[ai][bj][m][0], x2 = acc[ai][bj][m][1], y1, y2;
                        y1[0] = x1[0] * cs0[0] - x2[0] * cs0[1]; y2[0] = x2[0] * cs0[0] + x1[0] * cs0[1];
                        y1[1] = x1[1] * cs0[2] - x2[1] * cs0[3]; y2[1] = x2[1] * cs0[2] + x1[1] * cs0[3];
                        y1[2] = x1[2] * cs1[0] - x2[2] * cs1[1]; y2[2] = x2[2] * cs1[0] + x1[2] * cs1[1];
                        y1[3] = x1[3] * cs1[2] - x2[3] * cs1[3]; y2[3] = x2[3] * cs1[2] + x1[3] * cs1[3];
                        st8(Z + row * 512 + ct + bj * HALF + cw, y1 * scr_, y2 * scr_); } } }
        } else if (pn < 11) {
            bf16_t* Z = pn < 8 ? ZV : ZG; const int ld = pn < 8 ? 512 : 768, ct = pn < 8 ? (pn - 6) * 256 : (pn - 8) * 256;
#pragma unroll
            for (int ai = 0; ai < 2; ++ai)
#pragma unroll
                for (int m = 0; m < 4; ++m) { const size_t row = (size_t)(row0 + ai * HALF + m * 16); const float rs = RowScale::rs(rb, rl0 + ai * HALF + m * 16);
#pragma unroll
                    for (int bj = 0; bj < 2; ++bj) st8(Z + row * ld + ct + bj * HALF + cw, acc[ai][bj][m][0] * rs, acc[ai][bj][m][1] * rs); }
        } else {
            const f32x4 b0 = *(const f32x4*)(bgate + cw), b1 = *(const f32x4*)(bgate + cw + 4);
#pragma unroll
            for (int ai = 0; ai < 2; ++ai)
#pragma unroll
                for (int m = 0; m < 4; ++m) { const size_t row = (size_t)(row0 + ai * HALF + m * 16); const float rs = RowScale::rs(rb, rl0 + ai * HALF + m * 16); f32x4 x0 = acc[ai][0][m][0] * rs + b0, x1 = acc[ai][0][m][1] * rs + b1, l0, l1;
#pragma unroll
                    for (int i = 0; i < 4; ++i) {
                        l0[i] = __builtin_fmaf(__builtin_amdgcn_logf(1.f + __builtin_amdgcn_exp2f(-1.4426950408889634f * fabsf(x0[i]))), -0.6931471805599453f * 0.0625f, fminf(x0[i], 0.f) * 0.0625f);
                        l1[i] = __builtin_fmaf(__builtin_amdgcn_logf(1.f + __builtin_amdgcn_exp2f(-1.4426950408889634f * fabsf(x1[i]))), -0.6931471805599453f * 0.0625f, fminf(x1[i], 0.f) * 0.0625f); }
                    st16f_wt(LA + row * 128 + cw, l0); st16f_wt(LA + row * 128 + cw + 4, l1); }
        }
    }
};
struct GroupedOrder {
    const PG8_LAS int* tb; int nN, G, c;
    __device__ __forceinline__ bool next(int i, Unit& u) const {
        const int total = tb[NEXPG] * nN; const long L = (long)i * G + c; if (L >= total) return false;
        return map((int)L, total, u); }
    __device__ __forceinline__ bool map(int L, int total, Unit& u) const {
        int wgid = L; { const int q = total / NXCD, r = total % NXCD, xcd = wgid % NXCD, off = wgid / NXCD; wgid = (xcd < r ? xcd * (q + 1) : r * (q + 1) + (xcd - r) * q) + off; }
        int e = 0;
#pragma unroll
        for (int j = 1; j < NEXPG; ++j) if (wgid >= tb[j] * nN) e = j;
        const int loc = wgid - tb[e] * nN, nMe = tb[e + 1] - tb[e];
        const int nig = WGM * nN, gid = loc / nig, fm = gid * WGM, gsz = (nMe - fm) < WGM ? (nMe - fm) : WGM;
        u.pm = tb[e] + fm + ((loc % nig) % gsz); u.pn = (loc % nig) / gsz; u.pe = e; u.k0t = 0; u.ntu = 0; u.slot = -1; u.q = 0; return true;
    }
    __device__ __forceinline__ void a_ready(const Unit&) const {}
    __device__ __forceinline__ void done(const Unit&) const {}
};
struct GroupedOrderSplit {
    GroupedOrder base; int ntq;
    __device__ __forceinline__ bool next(int i, Unit& u) const {
        const int total = base.tb[NEXPG] * base.nN, G = base.G, c = base.c;
        if (i < 4) { const int L = i * G + c; if (L >= total) return false; return base.map(L, total, u); }
        if (i > 4) return false;
        const int n5 = total - 4 * G; if (c >= 4 * n5) return false;
        if (!base.map(4 * G + (c >> 2), total, u)) return false;
        u.q = c & 3; u.slot = c >> 2; u.k0t = u.q * ntq; u.ntu = ntq; return true;
    }
    __device__ __forceinline__ void a_ready(const Unit&) const {}
    __device__ __forceinline__ void done(const Unit&) const {}
};
struct EpiBf16Split {
    static constexpr bool PERM = true, AFTER_DRAIN = false;
    bf16_t* O; int ldc; bf16_t* P;
    __device__ __forceinline__ void operator()(const f32x4 (&acc)[2][2][4][2], const Unit& u, int wr, int wc, int fr, int fq) const {
        const bool sp = u.slot >= 0; const int ld = sp ? 256 : ldc;
        bf16_t* base = sp ? P + (size_t)(u.q * 32 + u.slot) * 65536 + (size_t)(wr * 64 + fr) * 256 + wc * 32 + 8 * fq : O + (size_t)(u.pm * BM + wr * 64 + fr) * ldc + u.pn * BM + wc * 32 + 8 * fq;
#pragma unroll
        for (int ai = 0; ai < 2; ++ai)
#pragma unroll
            for (int m = 0; m < 4; ++m) { bf16_t* rowp = base + (size_t)(ai * HALF + m * 16) * ld;
#pragma unroll
                for (int bj = 0; bj < 2; ++bj) { const f32x4 v0 = acc[ai][bj][m][0], v1 = acc[ai][bj][m][1];
                    u32x4 w; w.x = cvt_pk_bf16(v0[0], v0[1]); w.y = cvt_pk_bf16(v0[2], v0[3]); w.z = cvt_pk_bf16(v1[0], v1[1]); w.w = cvt_pk_bf16(v1[2], v1[3]);
                    st16_nt(rowp + bj * HALF, w); } }
    }
};
template <class Epi, class Sched, bool ALIGN_EPI = false, bool SP2 = false>
__device__ __forceinline__ void gemm_phase(PG8_LAS unsigned char* lds, const Gemm g, const Sched& S, const Epi& E, const int wid_in) {
    const int lane = lane_now(), wid = wid_in, tid = wid * 64 + lane,
              wr = wid >> 2, wc = wid & 3, fr = lane & 15, fq = lane >> 4;
    const int K = g.K, nt = K / BK;
    unsigned voffA[2], voffB[2];
#pragma unroll
    for (int i = 0; i < 2; ++i) { int R, C; stage_rc(tid * 16 + i * 8192, R, C); const int Rb = Epi::PERM ? ((R & ~31) + perm32(R & 31)) : R;
        voffA[i] = (unsigned)(R * K + C) * 2u; voffB[i] = (unsigned)(Rb * K + C) * 2u; }
    const size_t kstep = (size_t)(BK * 2);
    const size_t hstep = (size_t)HALF * K * 2;
    const size_t tstep = 2 * hstep;
    const unsigned ldsw = (unsigned)wid * 1024u;
    const int aoff = lds_byte(wr * 64 + fr, fq * 8), boff = lds_byte(wc * 32 + fr, fq * 8);
#define PG8_SA(b, h) (((b) * 2 + (h)) * HTB)
#define PG8_SB(b, h) ((4 + (b) * 2 + (h)) * HTB)
#define PG8_STAGE(bufoff, gbase, voff) do { _Pragma("unroll") for (int _i = 0; _i < 2; ++_i) \
        __builtin_amdgcn_global_load_lds((const unsigned*)((const char*)(gbase) + (voff)[_i]), (PG8_LAS unsigned*)(lds + (bufoff) + ldsw + _i * 8192), 16, 0, 0); } while (0)
#define PG8_LDA(dst, b, h) do { _Pragma("unroll") for (int m = 0; m < 4; ++m) _Pragma("unroll") for (int k = 0; k < 2; ++k) dst[m][k] = *(const PG8_LAS bf16x8*)(lds + PG8_SA(b, h) + aoff + m * 2048 + k * 1024); } while (0)
#define PG8_LDB(dst, b, h) do { _Pragma("unroll") for (int n = 0; n < 2; ++n) _Pragma("unroll") for (int k = 0; k < 2; ++k) dst[n][k] = *(const PG8_LAS bf16x8*)(lds + PG8_SB(b, h) + boff + n * 2048 + k * 1024); } while (0)
#define PG8_MMA(ai, bj, At, Bt) do { __builtin_amdgcn_s_setprio(1); _Pragma("unroll") for (int m = 0; m < 4; ++m) _Pragma("unroll") for (int n = 0; n < 2; ++n) _Pragma("unroll") for (int k = 0; k < 2; ++k) \
        acc[ai][bj][m][n] = __builtin_amdgcn_mfma_f32_16x16x32_bf16(Bt[n][k], At[m][k], acc[ai][bj][m][n], 0, 0, 0); __builtin_amdgcn_s_setprio(0); } while (0)
#define PG8_WAIT_V(n) asm volatile("s_waitcnt vmcnt(" #n ")" ::: "memory")
#define PG8_WAIT_L(n) asm volatile("s_waitcnt lgkmcnt(" #n ")" ::: "memory")
#define PG8_BAR __builtin_amdgcn_s_barrier()
#define PG8_SCHED __builtin_amdgcn_sched_barrier(0)
    Unit cur, nxt; int ui = 0;
    if (!S.next(0, cur)) return;
    f32x4 acc[2][2][4][2];
#pragma unroll
    for (int a = 0; a < 2; ++a)
#pragma unroll
        for (int b = 0; b < 2; ++b)
#pragma unroll
            for (int m = 0; m < 4; ++m)
#pragma unroll
                for (int n = 0; n < 2; ++n) acc[a][b][m][n] = (f32x4){0.f, 0.f, 0.f, 0.f};
    bf16x8 At[4][2], B0[2][2], B1[2][2];
    const char* cA = (const char*)g.A + (size_t)cur.pm * tstep + (size_t)cur.k0t * (BK * 2); const char* cB = (const char*)g.Bt + (size_t)cur.pe * g.bstride + (size_t)cur.pn * tstep + (size_t)cur.k0t * (BK * 2);
    S.a_ready(cur);
    if constexpr (SP2) {
        PG8_STAGE(PG8_SB(0, 0), cB, voffB); PG8_STAGE(PG8_SB(0, 1), cB + hstep, voffB); PG8_STAGE(PG8_SA(0, 0), cA, voffA); PG8_STAGE(PG8_SA(0, 1), cA + hstep, voffA);
        if (wr == 1) PG8_BAR;
        PG8_WAIT_V(2); PG8_BAR;
        PG8_STAGE(PG8_SB(1, 0), cB + kstep, voffB); PG8_STAGE(PG8_SA(1, 0), cA + kstep, voffA); PG8_STAGE(PG8_SB(1, 1), cB + hstep + kstep, voffB);
        PG8_WAIT_V(6); PG8_BAR;
    } else {
        PG8_STAGE(PG8_SB(0, 0), cB, voffB); PG8_STAGE(PG8_SA(0, 0), cA, voffA); PG8_STAGE(PG8_SB(0, 1), cB + hstep, voffB); PG8_STAGE(PG8_SA(0, 1), cA + hstep, voffA);
        if (wr == 1) PG8_BAR;
        PG8_WAIT_V(4); PG8_BAR;
        PG8_STAGE(PG8_SB(1, 0), cB + kstep, voffB); PG8_STAGE(PG8_SA(1, 0), cA + kstep, voffA); PG8_STAGE(PG8_SB(1, 1), cB + hstep + kstep, voffB);
        PG8_WAIT_V(6); PG8_BAR;
    }
    for (;;) {
        const bool has_next = S.next(ui + 1, nxt);
        const char* nA = has_next ? (const char*)g.A + (size_t)nxt.pm * tstep + (size_t)nxt.k0t * kstep : cA; const char* nB = has_next ? (const char*)g.Bt + (size_t)nxt.pe * g.bstride + (size_t)nxt.pn * tstep + (size_t)nxt.k0t * kstep : cB;
        const int ntc = cur.ntu ? cur.ntu : nt;
        GT_START(lds, wid, 41); GT_CSTART(lds, wid, 42);
        for (int t = 0; t < ntc; t += 2) {
            const bool last = (t == ntc - 2);
            const char* a1 = cA + (size_t)(t + 1) * kstep;
            const char* a2 = last ? nA : cA + (size_t)(t + 2) * kstep; const char* b2 = last ? nB : cB + (size_t)(t + 2) * kstep;
            const char* a3 = a2 + kstep; const char* b3 = b2 + kstep;
            if (last && has_next) S.a_ready(nxt);
            if constexpr (SP2) {
            PG8_LDB(B0, 0, 0); PG8_LDB(B1, 0, 1); PG8_SCHED; PG8_LDA(At, 0, 0); PG8_STAGE(PG8_SA(1, 1), a1 + hstep, voffA);
            PG8_WAIT_V(8); PG8_WAIT_L(0); PG8_BAR; PG8_MMA(0, 0, At, B0); PG8_MMA(0, 1, At, B1); PG8_BAR; PG8_SCHED;
            PG8_LDA(At, 0, 1); PG8_STAGE(PG8_SB(0, 0), b2, voffB); PG8_STAGE(PG8_SB(0, 1), b2 + hstep, voffB); PG8_STAGE(PG8_SA(0, 0), a2, voffA);
            PG8_WAIT_V(8); PG8_WAIT_L(0); PG8_BAR; PG8_MMA(1, 0, At, B0); PG8_MMA(1, 1, At, B1); PG8_BAR; PG8_SCHED;
            PG8_LDB(B0, 1, 0); PG8_LDB(B1, 1, 1); PG8_SCHED; PG8_LDA(At, 1, 0); PG8_STAGE(PG8_SA(0, 1), a2 + hstep, voffA);
            PG8_WAIT_V(8); PG8_WAIT_L(0); PG8_BAR; PG8_MMA(0, 0, At, B0); PG8_MMA(0, 1, At, B1); PG8_BAR; PG8_SCHED;
            PG8_LDA(At, 1, 1); PG8_STAGE(PG8_SB(1, 0), b3, voffB); PG8_STAGE(PG8_SB(1, 1), b3 + hstep, voffB); PG8_STAGE(PG8_SA(1, 0), a3, voffA);
            PG8_WAIT_V(8); PG8_WAIT_L(0); PG8_BAR; PG8_MMA(1, 0, At, B0); PG8_MMA(1, 1, At, B1); PG8_BAR; PG8_SCHED;
            } else {
            PG8_LDB(B0, 0, 0); PG8_SCHED; PG8_LDA(At, 0, 0); PG8_STAGE(PG8_SA(1, 1), a1 + hstep, voffA);
            PG8_WAIT_L(8); PG8_BAR; PG8_WAIT_L(0); PG8_MMA(0, 0, At, B0); PG8_BAR; PG8_SCHED;
            PG8_LDB(B1, 0, 1); PG8_STAGE(PG8_SB(0, 0), b2, voffB);
            PG8_BAR; PG8_WAIT_L(0); PG8_MMA(0, 1, At, B1); PG8_BAR;
            PG8_LDA(At, 0, 1); PG8_STAGE(PG8_SA(0, 0), a2, voffA);
            PG8_BAR; PG8_WAIT_L(0); PG8_MMA(1, 0, At, B0); PG8_BAR; PG8_SCHED;
            PG8_STAGE(PG8_SB(0, 1), b2 + hstep, voffB);
            PG8_WAIT_V(6); PG8_BAR; PG8_MMA(1, 1, At, B1); PG8_BAR;
            PG8_LDB(B0, 1, 0); PG8_SCHED; PG8_LDA(At, 1, 0); PG8_STAGE(PG8_SA(0, 1), a2 + hstep, voffA);
            PG8_WAIT_L(8); PG8_BAR; PG8_WAIT_L(0); PG8_MMA(0, 0, At, B0); PG8_BAR; PG8_SCHED;
            PG8_LDB(B1, 1, 1); PG8_STAGE(PG8_SB(1, 0), b3, voffB);
            PG8_BAR; PG8_WAIT_L(0); PG8_MMA(0, 1, At, B1); PG8_BAR;
            PG8_LDA(At, 1, 1); PG8_STAGE(PG8_SA(1, 0), a3, voffA);
            PG8_BAR; PG8_WAIT_L(0); PG8_MMA(1, 0, At, B0); PG8_BAR; PG8_SCHED;
            PG8_STAGE(PG8_SB(1, 1), b3 + hstep, voffB);
            PG8_WAIT_V(6); PG8_BAR; PG8_MMA(1, 1, At, B1); PG8_BAR;
            }
        }
        GT_STOP(lds, wid, 41); GT_CSTOP(lds, wid, 42);
        if constexpr (ALIGN_EPI) { if (wr == 0) PG8_BAR; }
        GT_START(lds, wid, 40); if constexpr (!Epi::AFTER_DRAIN) { const int l2_ = lane_now(); E(acc, cur, wr, wc, l2_ & 15, l2_ >> 4); S.done(cur); } GT_STOP(lds, wid, 40);
        if (!has_next) break;
#pragma unroll
        for (int a = 0; a < 2; ++a)
#pragma unroll
            for (int b = 0; b < 2; ++b)
#pragma unroll
                for (int m = 0; m < 4; ++m)
#pragma unroll
                    for (int n = 0; n < 2; ++n) acc[a][b][m][n] = (f32x4){0.f, 0.f, 0.f, 0.f};
        cur = nxt; cA = nA; cB = nB; ++ui;
        if constexpr (ALIGN_EPI) { if (wr == 1) PG8_BAR; }
    }
    PG8_WAIT_V(0);
    if constexpr (!ALIGN_EPI) { if (wr == 0) PG8_BAR; }
    PG8_BAR;
    if constexpr (Epi::AFTER_DRAIN) { E.fused(acc, cur, wr, wc, lane & 15, lane >> 4, lds, wid, lane); S.done(cur); }
#undef PG8_SA
#undef PG8_SB
#undef PG8_STAGE
#undef PG8_LDA
#undef PG8_LDB
#undef PG8_MMA
#undef PG8_WAIT_V
#undef PG8_WAIT_L
#undef PG8_BAR
#undef PG8_SCHED
}
}
#define PG8_SP2 true
#define PG8_ALIGN true
#include <hip/hip_bf16.h>
#include <cmath>
namespace attn_body {
using bf16=__hip_bfloat16;
using bf16x8=__attribute__((ext_vector_type(8)))short;
using s16x4=__attribute__((ext_vector_type(4)))short;
using f32x16=__attribute__((ext_vector_type(16)))float;
using u32x4=__attribute__((ext_vector_type(4)))unsigned;
constexpr int BATCH=4,NHEAD=16,SEQ=8192,D=64;
constexpr int QP=512,KP=512,VP=512,OP=1024;
constexpr int NW=8,QBLK=32,QB=QBLK*NW,KVBLK=64,NQB=SEQ/QB;
constexpr int ATTN_UNIT_ROWS=QB;
__device__ __forceinline__ int crow(int r,int hi){return (r&3)+8*(r>>2)+4*hi;}
#define SBAR() __builtin_amdgcn_sched_barrier(0)
__device__ __forceinline__ void cmask(f32x16&p0,f32x16&p1,int jb,int qrel,int hi){
  const float NEG=-INFINITY; (void)hi;
  if(jb>(qrel>>6)){
  #pragma unroll
  for(int r=0;r<16;++r){p0[r]=NEG;p1[r]=NEG;} }
}
constexpr int NSLOT=3, SLOTB=8192;
constexpr int SLOTV=2*SLOTB;
constexpr int LDS_K=0, LDS_V=NSLOT*SLOTB, LDS_WS=LDS_V+NSLOT*SLOTV, LDS_OST=LDS_WS+NW*64*4, LDS_BYTES=LDS_OST+NW*4096;
constexpr float C2=0.125f*1.4426950408889634f;
__device__ __forceinline__ void glds16(const void*gsrc,unsigned lds_dst){unsigned keep;
  asm volatile("s_mov_b32 %0, m0\n\ts_mov_b32 m0, %2\n\ts_nop 0\n\tglobal_load_lds_dwordx4 %1, off\n\ts_mov_b32 m0, %0":"=&s"(keep):"v"(gsrc),"s"(lds_dst):"memory");}
__device__ __forceinline__ float max3f(float a,float b,float c){float r;asm("v_max3_f32 %0, %1, %2, %3":"=v"(r):"v"(a),"v"(b),"v"(c));return r;}
__device__ __forceinline__ float max2f(float a,float b){float r;asm("v_max_f32_e32 %0, %1, %2":"=v"(r):"v"(a),"v"(b));return r;}
__device__ __forceinline__ float fadd_s(float a,float b){float r;asm("v_add_f32_e32 %0, %1, %2":"=v"(r):"v"(a),"v"(b));return r;}
__device__ __forceinline__ float fsub_s(float a,float b){float r;asm("v_sub_f32_e32 %0, %1, %2":"=v"(r):"v"(a),"v"(b));return r;}
typedef float f32x2_t __attribute__((ext_vector_type(2))); typedef __bf16 bf16x2_t __attribute__((ext_vector_type(2)));
__device__ __forceinline__ unsigned cvtpk_s(float lo,float hi){f32x2_t v={lo,hi};bf16x2_t b=__builtin_convertvector(v,bf16x2_t);return __builtin_bit_cast(unsigned,b);}
#define WAIT_BAR(N) asm volatile("s_waitcnt vmcnt(" #N ") lgkmcnt(0)\n\ts_barrier":::"memory")

__device__ __forceinline__ void qkt(f32x16&p0,f32x16&p1,const char*Kslot,const bf16x8*qr,const f32x16&negm,int r32,int hi){
  const char*kb=Kslot+hi*1024+r32*16;
  #pragma unroll
  for(int d0=0;d0<4;++d0){
    const bf16x8 b0=*reinterpret_cast<const bf16x8*>(kb+d0*2048);
    const bf16x8 b1=*reinterpret_cast<const bf16x8*>(kb+d0*2048+512);
    if(d0==0){p0=__builtin_amdgcn_mfma_f32_32x32x16_bf16(b0,qr[0],negm,0,0,0);p1=__builtin_amdgcn_mfma_f32_32x32x16_bf16(b1,qr[0],negm,0,0,0);}
    else{p0=__builtin_amdgcn_mfma_f32_32x32x16_bf16(b0,qr[d0],p0,0,0,0);p1=__builtin_amdgcn_mfma_f32_32x32x16_bf16(b1,qr[d0],p1,0,0,0);}}
}
typedef __attribute__((address_space(3))) const char* lds_cptr;
typedef short v4i16_t __attribute__((ext_vector_type(4)));
__device__ __forceinline__ void kload8(bf16x8*kf,lds_cptr kp){
  kf[0]=*(const __attribute__((address_space(3))) bf16x8*)(kp);      kf[1]=*(const __attribute__((address_space(3))) bf16x8*)(kp+512);
  kf[2]=*(const __attribute__((address_space(3))) bf16x8*)(kp+2048); kf[3]=*(const __attribute__((address_space(3))) bf16x8*)(kp+2560);
  kf[4]=*(const __attribute__((address_space(3))) bf16x8*)(kp+4096); kf[5]=*(const __attribute__((address_space(3))) bf16x8*)(kp+4608);
  kf[6]=*(const __attribute__((address_space(3))) bf16x8*)(kp+6144); kf[7]=*(const __attribute__((address_space(3))) bf16x8*)(kp+6656);
}
__device__ __forceinline__ void kload2(bf16x8*kf,lds_cptr kp,int j){ kf[2*j]=*(const __attribute__((address_space(3))) bf16x8*)(kp+j*2048); kf[2*j+1]=*(const __attribute__((address_space(3))) bf16x8*)(kp+j*2048+512); }
__device__ __forceinline__ s16x4 vtr(lds_cptr p){ return __builtin_bit_cast(s16x4,__builtin_amdgcn_ds_read_tr16_b64_v4i16((__attribute__((address_space(3))) v4i16_t*)p)); }
__device__ __forceinline__ float rowmax(const f32x16&p0,const f32x16&p1){
  float a=max3f(p0[0],p0[1],p1[0]),b=max3f(p0[2],p0[3],p1[1]);a=max3f(a,p1[2],p1[3]);
  #pragma unroll
  for(int r=4;r<16;r+=4){a=max3f(a,p0[r],p0[r+1]);b=max3f(b,p0[r+2],p0[r+3]);a=max3f(a,p1[r],p1[r+1]);b=max3f(b,p1[r+2],p1[r+3]);}
  const float m=max2f(a,b);
  auto rr=__builtin_amdgcn_permlane32_swap(__float_as_uint(m),__float_as_uint(m),false,false);
  return max2f(__uint_as_float(rr[0]),__uint_as_float(rr[1]));
}
__device__ __forceinline__ void pv(f32x16*o,int vb,bf16x8 pa0,bf16x8 pa1,bf16x8 pa2,bf16x8 pa3){
  #pragma unroll
  for(int d0=0;d0<2;++d0){s16x4 lo[4],hi[4];
    #pragma unroll
    for(int ks=0;ks<4;++ks){
      asm volatile("ds_read_b64_tr_b16 %0,%1 offset:%c2":"=&v"(lo[ks]):"v"(vb),"i"(d0*4096+ks*1024):"memory");
      asm volatile("ds_read_b64_tr_b16 %0,%1 offset:%c2":"=&v"(hi[ks]):"v"(vb),"i"(d0*4096+ks*1024+512):"memory");}
    asm volatile("s_waitcnt lgkmcnt(0)":::"memory");SBAR();
    #define PK(k) (bf16x8){lo[k][0],lo[k][1],lo[k][2],lo[k][3],hi[k][0],hi[k][1],hi[k][2],hi[k][3]}
    o[d0]=__builtin_amdgcn_mfma_f32_32x32x16_bf16(pa0,PK(0),o[d0],0,0,0);
    o[d0]=__builtin_amdgcn_mfma_f32_32x32x16_bf16(pa1,PK(1),o[d0],0,0,0);
    o[d0]=__builtin_amdgcn_mfma_f32_32x32x16_bf16(pa2,PK(2),o[d0],0,0,0);
    o[d0]=__builtin_amdgcn_mfma_f32_32x32x16_bf16(pa3,PK(3),o[d0],0,0,0);
    #undef PK
  }
}

#ifndef ATTN_STORE16
#define ATTN_STORE16(p,v) st16_wt((void*)(p),(v))
#endif
template<int THRL> __device__ __forceinline__ void attn_unit(int b,int qcol,int vcol,int ocol,int qb,const bf16*Q,const bf16*__restrict__ K,const bf16*__restrict__ V,bf16*O,char*shm,const int wid_in){
  const int lane=lane_now(),r32=lane&31,hi=lane>>5; const int wid=wid_in; const int tid=wid*64+lane; (void)tid;
  const long rowbase=(long)b*SEQ; const int q0=qb*QB;
  const bf16*Qw=Q+(rowbase+q0+wid*QBLK)*QP+qcol;
  const bf16*Kh=K+rowbase*KP+qcol,*Vh=V+rowbase*VP+vcol;
  const unsigned lds0=(unsigned)(uintptr_t)shm;
  float*wsf=(float*)(shm+LDS_WS)+wid*64;
  const bf16*ksrc=Kh+(long)lane*KP+wid*8;
  const bf16*vsrc=Vh+(long)(16*(wid&3)+(lane>>2))*VP+(wid>>2)*32+(lane&3)*8;
  const unsigned kdst=lds0+LDS_K+wid*1024, vdst=lds0+LDS_V+wid*1024;
  #define DMA_K(t,slot) glds16(ksrc+(long)(t)*KVBLK*KP,(unsigned)__builtin_amdgcn_readfirstlane(kdst+(slot)))
  #define DMA_V(t,slot) do{ glds16(vsrc+(long)(t)*KVBLK*VP,(unsigned)__builtin_amdgcn_readfirstlane(vdst+(slot))); glds16(vsrc+64+(long)(t)*KVBLK*VP,(unsigned)__builtin_amdgcn_readfirstlane(vdst+(slot)+8192)); }while(0)
  const int vb0=(int)(lds0+LDS_V)+((lane>>4)&1)*32+(lane&3)*8+(4*hi+((lane&15)>>2))*64;
  const char*Kbase=shm+LDS_K; bf16x8 kf[8];
  const lds_cptr shm3=(lds_cptr)shm; const lds_cptr kp0=shm3+LDS_K+hi*1024+r32*16; const lds_cptr vp0=shm3+LDS_V+((lane>>4)&1)*32+(lane&3)*8+(4*hi+((lane&15)>>2))*64;
  const int NT=(q0+QB)/KVBLK;
  DMA_K(0,0);DMA_V(0,0);DMA_K(1,SLOTB);
  bf16x8 qr[4];
  #pragma unroll
  for(int d0=0;d0<4;++d0)qr[d0]=*reinterpret_cast<const bf16x8*>(&Qw[(long)r32*QP+d0*16+hi*8]);
  float mhat=0.f,l_reg=0.f;f32x16 o[4];o[0]=f32x16{};o[1]=f32x16{};o[2]=f32x16{};o[3]=f32x16{};
  const int qrel=wid*QBLK+r32;
  #define CMASK(P0,P1,t) do{int jb_=(t)-(NT-4); if(jb_>=0)cmask(P0,P1,jb_,qrel,hi);}while(0)
  bool resc=false;
  #define START(P0,P1) do{ const float rm=rowmax(P0,P1); resc=false; \
    { const float dl=rm; mhat=fadd_s(mhat,dl); \
      _Pragma("unroll") for(int r=0;r<16;++r){P0[r]=fsub_s(P0[r],dl);P1[r]=fsub_s(P1[r],dl);} \
      } \
    _Pragma("unroll") for(int r=0;r<16;++r)P0[r]=__builtin_amdgcn_exp2f(P0[r]); }while(0)
  #define RESC() do{ if(resc){ asm volatile("s_waitcnt lgkmcnt(0)":::"memory"); \
      _Pragma("unroll") for(int d_=0;d_<4;++d_) _Pragma("unroll") for(int r=0;r<16;++r)o[d_][r]*=wsf[crow(r,hi)]; } }while(0)
  f32x16 pA0,pA1,pB0,pB1;
  int sl_prev=0,sl_cur=0,sl_next=SLOTB;
  #define ROT() do{sl_prev=sl_cur;sl_cur=sl_next;sl_next=(sl_next==(NSLOT-1)*SLOTB)?0:sl_next+SLOTB;}while(0)
  DMA_K(2,2*SLOTB);
  WAIT_BAR(4);
  qkt(pA0,pA1,Kbase,qr,f32x16{},r32,hi);asm volatile("s_nop 15\n\ts_nop 7":"+v"(pA0),"+v"(pA1));CMASK(pA0,pA1,0);
  START(pA0,pA1);
  _Pragma("unroll") for(int r=0;r<16;++r)pA1[r]=__builtin_amdgcn_exp2f(pA1[r]);
  WAIT_BAR(0);
  DMA_K(3,0);DMA_V(1,2*SLOTB);
  ROT();
  kload8(kf,kp0+sl_cur);
  WAIT_BAR(3);
  s16x4 vlo[8],vhi[8]; u32x4 pw0,pw1,pw2,pw3;
  #define PKW(P,B) cvtpk_s(P[B],P[B+1])
  #define PAF(k) __builtin_bit_cast(bf16x8,pw##k)
  #define VFR(i) (bf16x8){vlo[i][0],vlo[i][1],vlo[i][2],vlo[i][3],vhi[i][0],vhi[i][1],vhi[i][2],vhi[i][3]}
  #define PIN(x) asm volatile("":"+v"(x))
  #define MX3(a,b,c) __builtin_fmaxf(__builtin_fmaxf((a),(b)),(c))
  #define GAPA(MF,A0,A1,A2,A3,W0,W1,PW) do{ MF; sacc+=A0; sacc+=A1; sacc+=A2; sacc+=A3; PIN(sacc); W0; W1; PIN(PW); SBAR(); }while(0)
  #define EX(v) __builtin_amdgcn_exp2f(v)
  #define GAPB(MF,X,B) do{ MF; X[B]=EX(X[B]); X[B+1]=EX(X[B+1]); X[B+2]=EX(X[B+2]); X[B+3]=EX(X[B+3]); PIN(X); SBAR(); }while(0)
  #define VRD(i) do{ vlo[i]=vtr(vp_+(((i)>>2)*4096+((i)&3)*1024)); vhi[i]=vtr(vp_+(((i)>>2)*4096+((i)&3)*1024+512)); }while(0)
  #define VRD2(i) do{ vlo[i]=vtr(vp_+(8192+((i)>>2)*4096+((i)&3)*1024)); vhi[i]=vtr(vp_+(8192+((i)>>2)*4096+((i)&3)*1024+512)); }while(0)
  #define GAPB2(MF,X,B,i) do{ MF; VRD2(i); X[B]=EX(X[B]); X[B+1]=EX(X[B+1]); X[B+2]=EX(X[B+2]); X[B+3]=EX(X[B+3]); PIN(X); SBAR(); }while(0)
  #define KRD(G,j) do{ if(G){ kload2(kf,kp0+sl_next,j); SBAR(); } }while(0)
  #define STEP(C0,C1,P0,P1,t,GK,GV,GL) do{ SBAR(); \
    const lds_cptr vp_=vp0+2*sl_prev; \
    VRD(0); SBAR(); float sacc=(P0[0]+P0[1]); \
    GAPA(C0=__builtin_amdgcn_mfma_f32_32x32x16_bf16(kf[0],qr[0],f32x16{},0,0,0), P0[2],P0[3],P0[4],P0[5],     pw0[0]=PKW(P0,0), pw0[1]=PKW(P0,2), pw0); \
    VRD(4); SBAR(); GAPA(C1=__builtin_amdgcn_mfma_f32_32x32x16_bf16(kf[1],qr[0],f32x16{},0,0,0), P0[6],P0[7],P0[8],P0[9],     pw0[2]=PKW(P0,4), pw0[3]=PKW(P0,6), pw0); \
    VRD(1); SBAR(); GAPA(C0=__builtin_amdgcn_mfma_f32_32x32x16_bf16(kf[2],qr[1],C0,0,0,0),   P0[10],P0[11],P0[12],P0[13], pw1[0]=PKW(P0,8), pw1[1]=PKW(P0,10), pw1); \
    VRD(5); SBAR(); GAPA(C1=__builtin_amdgcn_mfma_f32_32x32x16_bf16(kf[3],qr[1],C1,0,0,0),   P0[14],P0[15],P1[0],P1[1],   pw1[2]=PKW(P0,12),pw1[3]=PKW(P0,14), pw1); \
    VRD(2); SBAR(); GAPA(C0=__builtin_amdgcn_mfma_f32_32x32x16_bf16(kf[4],qr[2],C0,0,0,0),   P1[2],P1[3],P1[4],P1[5],     pw2[0]=PKW(P1,0), pw2[1]=PKW(P1,2), pw2); \
    VRD(6); SBAR(); GAPA(C1=__builtin_amdgcn_mfma_f32_32x32x16_bf16(kf[5],qr[2],C1,0,0,0),   P1[6],P1[7],P1[8],P1[9],     pw2[2]=PKW(P1,4), pw2[3]=PKW(P1,6), pw2); \
    VRD(3); SBAR(); GAPA(C0=__builtin_amdgcn_mfma_f32_32x32x16_bf16(kf[6],qr[3],C0,0,0,0),   P1[10],P1[11],P1[12],P1[13], pw3[0]=PKW(P1,8), pw3[1]=PKW(P1,10), pw3); \
    VRD(7); SBAR(); GAPA(C1=__builtin_amdgcn_mfma_f32_32x32x16_bf16(kf[7],qr[3],C1,0,0,0),   P1[14],P1[15],0.f,0.f,       pw3[2]=PKW(P1,12),pw3[3]=PKW(P1,14), pw3); \
    l_reg+=sacc; \
    if(GK){DMA_K((t)+3,sl_cur);} if(GV){DMA_V((t)+1,2*sl_next);} \
    _Pragma("unroll") for(int r=0;r<16;++r){C0[r]-=mhat;C1[r]-=mhat;} \
    CMASK(C0,C1,t); \
    { float a=MX3(C0[0],C0[1],C1[0]),b=MX3(C0[2],C0[3],C1[1]); a=MX3(a,C1[2],C1[3]); \
      _Pragma("unroll") for(int r=4;r<16;r+=4){a=MX3(a,C0[r],C0[r+1]);b=MX3(b,C0[r+2],C0[r+3]);a=MX3(a,C1[r],C1[r+1]);b=MX3(b,C1[r+2],C1[r+3]);} \
      float rm=__builtin_fmaxf(a,b); { auto rr=__builtin_amdgcn_permlane32_swap(__float_as_uint(rm),__float_as_uint(rm),false,false); rm=__builtin_fmaxf(__uint_as_float(rr[0]),__uint_as_float(rr[1])); } \
      resc=false; \
      if(__builtin_expect(__any(rm>(float)THRL),0)){ const float dl=__builtin_fmaxf(rm,0.f); mhat+=dl; \
        _Pragma("unroll") for(int r=0;r<16;++r){C0[r]-=dl;C1[r]-=dl;} \
        const float f=__builtin_amdgcn_exp2f(-dl); l_reg*=f; if(hi==0)wsf[r32]=f; resc=true; } } \
    SBAR(); \
    GAPB2(o[0]=__builtin_amdgcn_mfma_f32_32x32x16_bf16(PAF(0),VFR(0),o[0],0,0,0), C0,0,0); \
    GAPB2(o[1]=__builtin_amdgcn_mfma_f32_32x32x16_bf16(PAF(0),VFR(4),o[1],0,0,0), C0,4,4); \
    KRD(GL,0); GAPB2(o[0]=__builtin_amdgcn_mfma_f32_32x32x16_bf16(PAF(1),VFR(1),o[0],0,0,0), C0,8,1); \
    KRD(GL,1); GAPB2(o[1]=__builtin_amdgcn_mfma_f32_32x32x16_bf16(PAF(1),VFR(5),o[1],0,0,0), C0,12,5); \
    KRD(GL,2); GAPB2(o[0]=__builtin_amdgcn_mfma_f32_32x32x16_bf16(PAF(2),VFR(2),o[0],0,0,0), C1,0,2); \
    KRD(GL,3); GAPB2(o[1]=__builtin_amdgcn_mfma_f32_32x32x16_bf16(PAF(2),VFR(6),o[1],0,0,0), C1,4,6); \
    GAPB2(o[0]=__builtin_amdgcn_mfma_f32_32x32x16_bf16(PAF(3),VFR(3),o[0],0,0,0), C1,8,3); \
    GAPB2(o[1]=__builtin_amdgcn_mfma_f32_32x32x16_bf16(PAF(3),VFR(7),o[1],0,0,0), C1,12,7); \
    o[2]=__builtin_amdgcn_mfma_f32_32x32x16_bf16(PAF(0),VFR(0),o[2],0,0,0); o[3]=__builtin_amdgcn_mfma_f32_32x32x16_bf16(PAF(0),VFR(4),o[3],0,0,0); \
    o[2]=__builtin_amdgcn_mfma_f32_32x32x16_bf16(PAF(1),VFR(1),o[2],0,0,0); o[3]=__builtin_amdgcn_mfma_f32_32x32x16_bf16(PAF(1),VFR(5),o[3],0,0,0); \
    o[2]=__builtin_amdgcn_mfma_f32_32x32x16_bf16(PAF(2),VFR(2),o[2],0,0,0); o[3]=__builtin_amdgcn_mfma_f32_32x32x16_bf16(PAF(2),VFR(6),o[3],0,0,0); \
    o[2]=__builtin_amdgcn_mfma_f32_32x32x16_bf16(PAF(3),VFR(3),o[2],0,0,0); o[3]=__builtin_amdgcn_mfma_f32_32x32x16_bf16(PAF(3),VFR(7),o[3],0,0,0); SBAR(); \
    }while(0)
  int t=1;
  #undef CMASK
  #define CMASK(P0,P1,t) do{}while(0)
  for(;t+5<NT;t+=2){
    STEP(pB0,pB1,pA0,pA1,t,true,true,true);     WAIT_BAR(3); RESC(); ROT();
    STEP(pA0,pA1,pB0,pB1,t+1,true,true,true);   WAIT_BAR(3); RESC(); ROT();
  }
  #undef CMASK
  #define CMASK(P0,P1,t) do{int jb_=(t)-(NT-4); if(jb_>=0)cmask(P0,P1,jb_,qrel,hi);}while(0)
  #define ENDW(tt) do{ if((tt)+3<NT){WAIT_BAR(3);} else if((tt)+2<NT){WAIT_BAR(2);} else {WAIT_BAR(0);} }while(0)
  for(;t+1<NT;t+=2){
    STEP(pB0,pB1,pA0,pA1,t,(t+3<NT),(t+1<NT),(t+1<NT));       ENDW(t);   RESC(); ROT();
    STEP(pA0,pA1,pB0,pB1,t+1,(t+4<NT),(t+2<NT),(t+2<NT));     ENDW(t+1); RESC(); ROT();
  }
  STEP(pB0,pB1,pA0,pA1,NT-1,false,false,false); RESC();
  { float sacc=pB0[0]+pB0[1]; _Pragma("unroll") for(int r=2;r<16;++r)sacc+=pB0[r]; _Pragma("unroll") for(int r=0;r<16;++r)sacc+=pB1[r]; l_reg+=sacc;
    pw0=(u32x4){PKW(pB0,0),PKW(pB0,2),PKW(pB0,4),PKW(pB0,6)};pw1=(u32x4){PKW(pB0,8),PKW(pB0,10),PKW(pB0,12),PKW(pB0,14)};pw2=(u32x4){PKW(pB1,0),PKW(pB1,2),PKW(pB1,4),PKW(pB1,6)};pw3=(u32x4){PKW(pB1,8),PKW(pB1,10),PKW(pB1,12),PKW(pB1,14)};
    SBAR(); pv(o,vb0+2*sl_cur,PAF(0),PAF(1),PAF(2),PAF(3)); pv(o+2,vb0+2*sl_cur+8192,PAF(0),PAF(1),PAF(2),PAF(3)); }
  #undef PKW
  #undef PAF
  #undef VFR
  #undef PIN
  #undef MX3
  #undef GAPA
  #undef GAPB
  #undef GAPB2
  #undef VRD2
  #undef EX
  #undef VRD
  #undef KRD
  #undef STEP
  #undef ENDW
  {auto rr=__builtin_amdgcn_permlane32_swap(__float_as_uint(l_reg),__float_as_uint(l_reg),false,false);l_reg=__uint_as_float(rr[0])+__uint_as_float(rr[1]);}
  if(hi==0)wsf[32+r32]=l_reg;asm volatile("s_waitcnt lgkmcnt(0)":::"memory");
  float rli[16];
  #pragma unroll
  for(int r=0;r<16;++r)rli[r]=__builtin_amdgcn_rcpf(wsf[32+crow(r,hi)]);
  bf16*Ow=O+(rowbase+q0+wid*QBLK)*OP+ocol;
  { bf16*stg=(bf16*)(shm+LDS_OST)+wid*2048;
    #pragma unroll
    for(int dh=0;dh<2;++dh){
      #pragma unroll
      for(int r=0;r<16;++r){const int orow=crow(r,hi);
        #pragma unroll
        for(int d0=0;d0<2;++d0)stg[orow*64+d0*32+r32]=__float2bfloat16(o[2*dh+d0][r]*rli[r]);}
      asm volatile("s_waitcnt lgkmcnt(0)":::"memory");
      #pragma unroll
      for(int i=0;i<4;++i){const int row=i*8+(lane>>3),ch=lane&7; const u32x4 v=*(const u32x4*)(stg+row*64+ch*8); ATTN_STORE16(Ow+(long)row*OP+dh*64+ch*8,v);}
      asm volatile("s_waitcnt lgkmcnt(0)":::"memory"); } }
  asm volatile("s_waitcnt lgkmcnt(0)\n\ts_barrier":::"memory");
  #undef DMA_K
  #undef DMA_V
  #undef CMASK
  #undef START
  #undef RESC
  #undef ROT
}
constexpr int ATTN_LDS_BYTES=LDS_BYTES;
struct AttnTensors { const bf16* Q; const bf16* K; const bf16* V; bf16* O; };
struct AttnUnit { int bh; int qb; };
struct StaticOrder {
  int vcu;
  __device__ __forceinline__ explicit StaticOrder(int grid,int block):vcu((block%8)*(grid/8)+block/8){}
  __device__ __forceinline__ bool next(int i,AttnUnit&u)const{ if(i>=4)return false; const int s=vcu&7; u.bh=vcu>>3; u.qb=(i==0)?s:(i==1)?15-s:(i==2)?16+s:31-s; return true; }
  __device__ __forceinline__ void a_ready(const AttnUnit&)const{}
  __device__ __forceinline__ void done(const AttnUnit&)const{}
};
template<class Sched,int THRL=8> __device__ __forceinline__ void attn_phase(char*lds,const AttnTensors&T,const Sched&S,const int wid_in){
  AttnUnit u;
  for(int i=0;S.next(i,u);++i){ S.a_ready(u); const int b=u.bh>>3,h=(u.bh>>1)&3,c=u.bh&1;
    attn_unit<THRL>(b,(h*2+c)*64,h*128,h*256+c*128,u.qb,T.Q,T.K,T.V,T.O,lds,wid_in); S.done(u); }
}
#undef SBAR
#undef WAIT_BAR
}
#define GAS __attribute__((address_space(1)))
#define LAS __attribute__((address_space(3)))
typedef unsigned short bf16;
typedef unsigned v4u __attribute__((ext_vector_type(4)));
typedef float f32x4 __attribute__((ext_vector_type(4)));
typedef short bf16x8 __attribute__((ext_vector_type(8)));
typedef GAS unsigned gu32;
typedef GAS unsigned long long gu64;
#define RLX_AGENT __ATOMIC_RELAXED, __HIP_MEMORY_SCOPE_AGENT
#define LDS_WAIT() asm volatile("s_waitcnt lgkmcnt(0)" ::: "memory")
#define VM_WAIT() asm volatile("s_waitcnt vmcnt(0)" ::: "memory")
__device__ __forceinline__ unsigned long long rt() { return __builtin_amdgcn_s_memrealtime(); }
__device__ __forceinline__ unsigned f2bf(float f) { return (unsigned)__builtin_bit_cast(unsigned short, (__bf16)f); }
typedef __bf16 hwbf2 __attribute__((ext_vector_type(2)));
typedef float hwf2 __attribute__((ext_vector_type(2)));
__device__ __forceinline__ unsigned pk2(float lo, float hi) { const hwf2 v = {lo, hi}; return __builtin_bit_cast(unsigned, __builtin_convertvector(v, hwbf2)); }

#define XB_TMO      128
#define XB_XCNT(j)  (256  + 64 * (j))
#define XB_XSUB(j)  (1280 + 64 * (j))
#define XB_XGEN(j)  (2304 + 64 * (j))
#define XB_TOP      3328
#define XB_TOPGEN   3392
#define XCD_BAR_WORDS 3456
#define XB_SPIN_CAP (MK_CHECK ? (1u << 27) : (1u << 18))

__device__ __forceinline__ unsigned xb_ld(unsigned* p)              { return __hip_atomic_load(p, __ATOMIC_RELAXED, __HIP_MEMORY_SCOPE_AGENT); }
__device__ __forceinline__ unsigned xb_add(unsigned* p, unsigned v) { return __hip_atomic_fetch_add(p, v, __ATOMIC_RELAXED, __HIP_MEMORY_SCOPE_AGENT); }
__device__ __forceinline__ unsigned xb_xcc_id() { return (unsigned)__builtin_amdgcn_s_getreg((3 << 11) | 20) & 0xFu; }
#define XB_SPIN(cond, bar) do { unsigned _sp = 0; while (cond) { __builtin_amdgcn_s_sleep(1); \
    if ((++_sp & 255u) == 0u) { if (xb_ld(&(bar)[XB_TMO])) break; if (_sp > XB_SPIN_CAP) { atomicAdd(&(bar)[XB_TMO], 1u); break; } } } } while (0)

struct XcdBarrier {
    unsigned* bar; unsigned x; int wave;
    volatile LAS unsigned* st;
};

__device__ __forceinline__ XcdBarrier xcd_barrier_post(unsigned* bar, volatile LAS unsigned* st, int wave) {
    XcdBarrier b; b.bar = bar; b.x = xb_xcc_id(); b.st = st; b.wave = wave;
    if (wave == 0 && lane_now() == 0) (void)xb_add(&bar[XB_XCNT(b.x)], 1u);
    return b;
}
__device__ __forceinline__ void xcd_barrier_complete(unsigned* bar, unsigned x, unsigned& nloc, unsigned& nx) {
    const unsigned G = gridDim.x * gridDim.y * gridDim.z;
    unsigned sum, cnt, mine, sp = 0u;
    for (;;) {
        sum = 0u; cnt = 0u; mine = 0u;
#pragma unroll
        for (unsigned j = 0; j < 16; ++j) { const unsigned c = xb_ld(&bar[XB_XCNT(j)]); sum += c; cnt += (c > 0u) ? 1u : 0u; mine = (j == x) ? c : mine; }
        if (sum == G) break;
        __builtin_amdgcn_s_sleep(1);
        if ((++sp & 255u) == 0u) { if (xb_ld(&bar[XB_TMO])) break; if (sp > XB_SPIN_CAP) { atomicAdd(&bar[XB_TMO], 1u); break; } }
    }
    nloc = mine > 0u ? mine : 1u; nx = cnt > 0u ? cnt : 1u;
}

__device__ __forceinline__ void xcd_barrier(const XcdBarrier& b) {
    asm volatile("s_waitcnt vmcnt(0)" ::: "memory");
    __syncthreads();
    if (b.wave == 0 && lane_now() == 0) {
        unsigned* bar = b.bar; unsigned bx_ = b.x; asm volatile("" : "+s"(bx_));
        __builtin_amdgcn_s_waitcnt(0);
        unsigned nloc = b.st[0], nx = b.st[1];
        if (nloc == 0u) { xcd_barrier_complete(bar, bx_, nloc, nx); b.st[0] = nloc; b.st[1] = nx; }
        const unsigned old = xb_add(&bar[XB_XSUB(bx_)], 1u);
        const unsigned gen = old / nloc;
        if (old + 1u == (gen + 1u) * nloc) {
            __builtin_amdgcn_fence(__ATOMIC_RELEASE, "agent");
            asm volatile("s_waitcnt vmcnt(0)" ::: "memory");
            const unsigned og = xb_add(&bar[XB_TOP], 1u);
            const unsigned tg = og / nx;
            if (og + 1u == (tg + 1u) * nx) xb_add(&bar[XB_TOPGEN], 1u);
            else XB_SPIN(xb_ld(&bar[XB_TOPGEN]) == tg, bar);
            __builtin_amdgcn_fence(__ATOMIC_ACQUIRE, "agent");
            xb_add(&bar[XB_XGEN(bx_)], 1u);
            asm volatile("s_waitcnt vmcnt(0)" ::: "memory");
        } else {
            XB_SPIN(xb_ld(&bar[XB_XGEN(bx_)]) == gen, bar);
            __builtin_amdgcn_fence(__ATOMIC_ACQUIRE, "agent");
            asm volatile("s_waitcnt vmcnt(0)" ::: "memory");
        }
    }
    __syncthreads();
}
typedef unsigned u32x2g __attribute__((ext_vector_type(2)));
constexpr size_t MiB = 1u << 20;
constexpr size_t WS_CTL = 0, CTL_ZERO_BYTES = 1 * MiB;
constexpr size_t WS_ROPE = 1 * MiB;
constexpr size_t WS_TOKSLOT = WS_ROPE + 512 * 1024;
constexpr size_t WS_GATEW = 2 * MiB;
constexpr size_t WS_DEC = 2 * MiB + 512 * 1024;
constexpr size_t WS_HIST = 2 * MiB + 768 * 1024, WS_TOKE = 3 * MiB;
constexpr size_t WS_KVS = 4 * MiB;
constexpr size_t WS_LA = 20 * MiB;
constexpr size_t WS_WIN = 36 * MiB, WS_WOUT = 60 * MiB, WS_WPG = 68 * MiB, WS_WPU = 76 * MiB, WS_WFGU = 78 * MiB, WS_WFDN = 100 * MiB, WS_WMGU = 112 * MiB, WS_WMDN = 336 * MiB;
constexpr size_t WS_PB = 448 * MiB, WS_HN = 512 * MiB, WS_ZQ = 576 * MiB, WS_ZK = 608 * MiB, WS_ZV = 640 * MiB, WS_ZU = 672 * MiB, WS_ZG = 688 * MiB;
constexpr size_t WS_OV = 736 * MiB, WS_YC = 800 * MiB, WS_UP = 864 * MiB, WS_ACT = 928 * MiB, WS_XG = 1390 * MiB, WS_Y2 = 1522 * MiB, WS_HNB = 1654 * MiB, WS_SS = 1718 * MiB, WS_SSX = 1746 * MiB, WS_END = 1747 * MiB;
static_assert(WS_ACT + (size_t)MOE_ROWS * D_FFE * 2 <= WS_XG && WS_XG + (size_t)MOE_ROWS * 1024 * 2 <= WS_Y2 && WS_Y2 + (size_t)MOE_ROWS * 1024 * 2 <= WS_HNB, "d_ws map");
constexpr int NSS = 13;
constexpr size_t SS_STRIDE = (size_t)T_TOK * 16;
constexpr size_t SZ_WIN = (size_t)NZ * 1024 * 2, SZ_SQ = (size_t)1024 * 1024 * 2, SZ_WPU = (size_t)1024 * 256 * 2, SZ_WFGU = (size_t)2 * D_FF * 1024 * 2, SZ_WFDN = (size_t)1024 * D_FF * 2,
                 SZ_WMGU = (size_t)2 * D_FFE * 1024 * 2, SZ_WMDN = (size_t)1024 * D_FFE * 2;
constexpr int CW_TMO = 0, CW_BAR = 4096, CW_CUR = 8192;

constexpr int RING_OFF = 0, RING_BYTES = 131072;
constexpr int LDSCTL_OFF = RING_BYTES, MISC_OFF = LDSCTL_OFF + 320;
constexpr int LDS_BYTES = 147456;

struct Cx { LAS unsigned char* lds; int tid, lane, wave, vcu, G; };
__device__ __forceinline__ Cx mkcx(LAS unsigned char* lds, int wave) { Cx cx; cx.lds = lds; cx.lane = lane_now(); cx.wave = wave; cx.tid = wave * 64 + cx.lane;
    cx.G = gridDim.x; { const int bx = blockIdx.x; cx.vcu = (cx.G % 8 == 0) ? (bx % 8) * (cx.G / 8) + bx / 8 : bx; } return cx; }
__device__ __forceinline__ unsigned long long ldptr(const LAS unsigned long long* PT, int i) { const unsigned long long v = PT[i];
    return ((unsigned long long)(unsigned)__builtin_amdgcn_readfirstlane((int)(unsigned)(v >> 32)) << 32) | (unsigned)__builtin_amdgcn_readfirstlane((int)(unsigned)v); }

template <int M> __device__ __forceinline__ float swz_xor(float v) { return __builtin_bit_cast(float, __builtin_amdgcn_ds_swizzle(__builtin_bit_cast(int, v), (M << 10) | 0x1f)); }
__device__ __forceinline__ float sum16(float v) { v += swz_xor<1>(v); v += swz_xor<2>(v); v += swz_xor<4>(v); v += swz_xor<8>(v); return v; }
__device__ __forceinline__ float wave_sum(float v) {
    v = sum16(v); const int iv = __builtin_bit_cast(int, v);
    const float a = __builtin_bit_cast(float, __builtin_amdgcn_readlane(iv, 0)), b = __builtin_bit_cast(float, __builtin_amdgcn_readlane(iv, 16)),
                c = __builtin_bit_cast(float, __builtin_amdgcn_readlane(iv, 32)), d = __builtin_bit_cast(float, __builtin_amdgcn_readlane(iv, 48));
    return (a + b) + (c + d);
}
__device__ __forceinline__ float b2f(unsigned short b) { return __builtin_bit_cast(float, (unsigned)b << 16); }
__device__ __forceinline__ float lo2f(unsigned w) { return __builtin_bit_cast(float, w << 16); }
__device__ __forceinline__ float hi2f(unsigned w) { return __builtin_bit_cast(float, w & 0xffff0000u); }
__device__ __forceinline__ float sigm(float x) { return __builtin_amdgcn_rcpf(1.f + __builtin_amdgcn_exp2f(-1.4426950408889634f * x)); }

__device__ __forceinline__ int col_gu(int n, int F) { const int t = n >> 8, j = n & 255; return (j >> 7) * F + t * 128 + (j & 127); }
__device__ __forceinline__ int col_win(int n) { const int t = n >> 8, j = n & 255;
    if (t < 2) return (j >> 7) * 256 + t * 128 + (j & 127);
    if (t < 6) { const int sec = (t - 2) >> 1, w = ((t - 2) & 1) * 256 + j, comp = w >> 6, d = w & 63; int od = d; if (d >= 4 && d < 8) od = d + 4; else if (d >= 8 && d < 12) od = d - 4; return 512 + sec * 512 + comp * 64 + od; }
    if (t < 8) return 1536 + (t - 6) * 256 + j;
    return 2048 + (t - 8) * 256 + j; }
struct TrSrc { const GAS float* src; int k0, n0; };
template <int MODE> __device__ __forceinline__ TrSrc tr_addr(const float* W, int K, int Nsrc, int F, int item, int lane) {
    const int nkb = K / 64, kb = (item >> 3) % nkb, nb = (item & 7) + 8 * (item / (8 * nkb)); TrSrc t; t.k0 = 64 * kb; t.n0 = 32 * nb; const int nd = t.n0 + (lane & 31);
    const int sc = MODE == 0 ? nd : (MODE == 1 ? col_gu(nd, F) : col_win(nd));
    t.src = (const GAS float*)W + (size_t)(t.k0 + (lane >> 5)) * Nsrc + sc; return t;
}
__device__ __forceinline__ void tr_emit(const float (&wv)[32], const TrSrc& t, int K, const float* gk, bf16* WT, LAS float* scr, int lane, float nsc) {
    const int c = lane & 7;
    f32x4 g0 = {1.f, 1.f, 1.f, 1.f}, g1 = {1.f, 1.f, 1.f, 1.f};
    if (gk) { g0 = *(const GAS f32x4*)(gk + t.k0 + 8 * c); g1 = *(const GAS f32x4*)(gk + t.k0 + 8 * c + 4); g0 *= nsc; g1 *= nsc; }
#pragma unroll
    for (int i = 0; i < 32; ++i) scr[(2 * i + (lane >> 5)) * 33 + (lane & 31)] = wv[i];
    LDS_WAIT(); asm volatile("" ::: "memory");
#pragma unroll
    for (int j = 0; j < 4; ++j) { const int n = (lane >> 3) + 8 * j; const LAS float* s = scr + (8 * c) * 33 + n;
        v4u o; o.x = pk2(s[0 * 33] * g0[0], s[1 * 33] * g0[1]); o.y = pk2(s[2 * 33] * g0[2], s[3 * 33] * g0[3]); o.z = pk2(s[4 * 33] * g1[0], s[5 * 33] * g1[1]); o.w = pk2(s[6 * 33] * g1[2], s[7 * 33] * g1[3]);
        st16_wt(WT + (size_t)(t.n0 + n) * K + t.k0 + 8 * c, o); }
    LDS_WAIT(); asm volatile("" ::: "memory");
}
template <int MODE> __device__ __forceinline__ void tr_job(const float* W, int K, int Nsrc, int F, const float* gk, bf16* WT, LAS float* scr, int it0, int stride, int nitems, int lane) {
    for (int it = it0; it < nitems; it += 2 * stride) {
        const bool two = it + stride < nitems;
        const TrSrc ta = tr_addr<MODE>(W, K, Nsrc, F, it, lane), tb = tr_addr<MODE>(W, K, Nsrc, F, two ? it + stride : it, lane);
        float wa[32], wb[32];
#pragma unroll
        for (int i = 0; i < 32; ++i) wa[i] = ta.src[(size_t)(2 * i) * Nsrc];
        if (two) {
#pragma unroll
            for (int i = 0; i < 32; ++i) wb[i] = tb.src[(size_t)(2 * i) * Nsrc]; }
        tr_emit(wa, ta, K, gk, WT, scr, lane, MODE == 1 ? ((ta.n0 & 128) ? 0.6931471805599453f : 1.4426950408889634f) : 1.f);
        if (two) tr_emit(wb, tb, K, gk, WT, scr, lane, MODE == 1 ? ((tb.n0 & 128) ? 0.6931471805599453f : 1.4426950408889634f) : 1.f);
    }
}
__device__ __forceinline__ void gate_item(const float* Win, const float* wg2, const float* gk, bf16* WT, LAS float* scr, int item, int lane) {
    const int kb = item >> 3, jb = item & 7, k0 = 64 * kb, j0 = 32 * jb, k = k0 + lane;
    float wr[16];
#pragma unroll
    for (int q = 0; q < 4; ++q) { const f32x4 x = *(const f32x4*)(Win + (size_t)k * D_IN + 2816 + 4 * q); wr[4 * q] = x[0]; wr[4 * q + 1] = x[1]; wr[4 * q + 2] = x[2]; wr[4 * q + 3] = x[3]; }
    const float gkk = gk[k];
    for (int jj = 0; jj < 32; ++jj) { const int j = j0 + jj; float s = 0.f;
        if (j < 128) {
#pragma unroll
            for (int r = 0; r < 16; ++r) s += wr[r] * wg2[r * 128 + j];
            s *= gkk; }
        scr[lane * 33 + jj] = s; }
    LDS_WAIT(); asm volatile("" ::: "memory");
    const int c = lane & 7;
#pragma unroll
    for (int j = 0; j < 4; ++j) { const int n = (lane >> 3) + 8 * j; const LAS float* s = scr + (8 * c) * 33 + n;
        v4u o; o.x = pk2(s[0 * 33], s[1 * 33]); o.y = pk2(s[2 * 33], s[3 * 33]); o.z = pk2(s[4 * 33], s[5 * 33]); o.w = pk2(s[6 * 33], s[7 * 33]);
        st16_wt(WT + (size_t)(2816 + j0 + n) * 1024 + k0 + 8 * c, o); }
    LDS_WAIT(); asm volatile("" ::: "memory");
}
#define JOB_TR(MODE, n_items, W_, K_, Ns_, F_, gk_, WT_) do { const int _n = (n_items); tr_job<MODE>(W_, K_, Ns_, F_, gk_, WT_, scr, (int)(((long)gw - jbase % NGW + NGW) % NGW), NGW, _n, lane); jbase += _n; } while (0)
#define JOB_LOOP(n_items, body) do { const int _n = (n_items); for (int it = (int)(((long)gw - jbase % NGW + NGW) % NGW); it < _n; it += NGW) { body; } jbase += _n; } while (0)
__device__ __forceinline__ void p0_prologue(const Cx& cx, const LAS unsigned long long* PT, unsigned char* ws) {
    LAS float* scr = (LAS float*)(cx.lds + RING_OFF + cx.wave * 16384);
    const int gw = cx.vcu * 8 + cx.wave, NGW = cx.G * 8, lane = cx.lane; long jbase = 0;
#define PIN(i) ((const float*)(const GAS float*)ldptr(PT, (i)))
    const float *norm_mix_g = PIN(2), *w_in = PIN(3), *gla_w_gate2 = PIN(10), *w_out = PIN(13), *norm_ffn_g = PIN(14), *ffn_w_gu = PIN(15), *ffn_w_down = PIN(16), *moe_w_gu = PIN(18), *moe_w_down = PIN(19),
                *ple_w_up = PIN(20), *ple_w_gate = PIN(21), *ple_norm_g = PIN(22);
    REPEAT(11) for (int m = 0; m < 2; ++m) for (int e = 0; e < NEXP; ++e) {
        const float* Wg = moe_w_gu + (size_t)(m * NEXP + e) * 1024 * (2 * D_FFE); bf16* Dg = (bf16*)(ws + WS_WMGU + (size_t)(m * NEXP + e) * SZ_WMGU);
        JOB_TR(1, 16 * (2 * D_FFE / 32), Wg, 1024, 2 * D_FFE, D_FFE, norm_ffn_g + (2 * m + 1) * 1024, Dg);
        const float* Wd = moe_w_down + (size_t)(m * NEXP + e) * D_FFE * 1024; bf16* Dd = (bf16*)(ws + WS_WMDN + (size_t)(m * NEXP + e) * SZ_WMDN);
        JOB_TR(0, (D_FFE / 64) * 32, Wd, D_FFE, 1024, 0, nullptr, Dd);
    }
    REPEAT(12) { for (int d = 0; d < 2; ++d) {
        JOB_TR(1, 16 * (2 * D_FF / 32), ffn_w_gu + (size_t)d * 1024 * 2 * D_FF, 1024, 2 * D_FF, D_FF, norm_ffn_g + (2 * d) * 1024, (bf16*)(ws + WS_WFGU + d * SZ_WFGU));
        JOB_TR(0, (D_FF / 64) * 32, ffn_w_down + (size_t)d * D_FF * 1024, D_FF, 1024, 0, nullptr, (bf16*)(ws + WS_WFDN + d * SZ_WFDN));
    }
    for (int li = 0; li < DEPTH; ++li) {
        JOB_TR(2, 16 * (2816 / 32), w_in + (size_t)li * 1024 * D_IN, 1024, D_IN, 0, norm_mix_g + li * 1024, (bf16*)(ws + WS_WIN + li * SZ_WIN));
        JOB_LOOP(16 * 8, gate_item(w_in + (size_t)li * 1024 * D_IN, gla_w_gate2 + li * 16 * 128, norm_mix_g + li * 1024, (bf16*)(ws + WS_WIN + li * SZ_WIN), scr, it, lane));
        JOB_TR(0, 16 * 32, w_out + (size_t)li * 1024 * 1024, 1024, 1024, 0, nullptr, (bf16*)(ws + WS_WOUT + li * SZ_SQ));
        JOB_TR(0, 16 * 32, ple_w_gate + (size_t)li * 1024 * 1024, 1024, 1024, 0, ple_norm_g + li * 1024, (bf16*)(ws + WS_WPG + li * SZ_SQ));
        JOB_TR(0, 4 * 32, ple_w_up + (size_t)li * 256 * 1024, 256, 1024, 0, nullptr, (bf16*)(ws + WS_WPU + li * SZ_WPU));
    } }
    REPEAT(13) { const float* p = PIN(1); bf16* pb = (bf16*)(ws + WS_PB); const long n8 = (long)DEPTH * T_TOK * PLE_DIM / 8, NT = (long)cx.G * 512;
      for (long i0 = (long)cx.vcu * 512 + cx.tid; i0 < n8; i0 += 4 * NT) { f32x4 a[4], b[4];
#pragma unroll
          for (int r = 0; r < 4; ++r) { const long i = i0 + r * NT; a[r] = *(const f32x4*)(p + i * 8); b[r] = *(const f32x4*)(p + i * 8 + 4); }
#pragma unroll
          for (int r = 0; r < 4; ++r) { const long i = i0 + r * NT; v4u o; o.x = pk2(a[r][0], a[r][1]); o.y = pk2(a[r][2], a[r][3]); o.z = pk2(b[r][0], b[r][1]); o.w = pk2(b[r][2], b[r][3]); st16_wt(pb + i * 8, o); } } }
    { const float* x = PIN(0); bf16* hb = (bf16*)(ws + WS_HNB); float* ss = (float*)(ws + WS_SS);
      for (int m0 = gw; m0 < T_TOK; m0 += 4 * NGW) { f32x4 v[4][4];
#pragma unroll
          for (int r = 0; r < 4; ++r) { const GAS f32x4* xr = (const GAS f32x4*)(x + (size_t)(m0 + r * NGW) * 1024) + lane;
#pragma unroll
              for (int j = 0; j < 4; ++j) v[r][j] = xr[64 * j]; }
#pragma unroll
          for (int r = 0; r < 4; ++r) { const int m = m0 + r * NGW; float s = 0.f;
#pragma unroll
              for (int j = 0; j < 4; ++j) s += (v[r][j].x * v[r][j].x + v[r][j].y * v[r][j].y) + (v[r][j].z * v[r][j].z + v[r][j].w * v[r][j].w);
              s = wave_sum(s); if (lane < 4) ((f32x4*)(ss + (size_t)m * 16))[lane] = (f32x4){lane == 0 ? s : 0.f, 0.f, 0.f, 0.f};
              GAS unsigned long long* o8 = (GAS unsigned long long*)(hb + (size_t)m * 1024) + lane;
#pragma unroll
              for (int j = 0; j < 4; ++j) o8[64 * j] = (unsigned long long)pk2(v[r][j].x, v[r][j].y) | ((unsigned long long)pk2(v[r][j].z, v[r][j].w) << 32); } }
    }
    { float* rope = (float*)(ws + WS_ROPE); const int idx = cx.vcu * 512 + cx.tid;
      if (idx < SEQ * 8) { const int pos = idx >> 3, j = idx & 7;
          const double invf[8] = {1.0, 0.19391010807943456, 0.037601130015015855, 0.0072912391843014545, 0.001414213562373095, 0.00027423030417878515, 5.317602791587768e-05, 1.031136931769684e-05};
          double f = invf[0];
#pragma unroll
          for (int q = 1; q < 8; ++q) f = (j == q) ? invf[q] : f;
          const double rev = (double)pos * f * 0.15915494309189535; const float fr = (float)(rev - rint(rev));
          rope[idx * 2] = __builtin_amdgcn_cosf(fr); rope[idx * 2 + 1] = __builtin_amdgcn_sinf(fr); } }
}

__device__ __forceinline__ void norm_rows(const Cx& cx, const float* src, bf16* dst) {
    const int gw = cx.vcu * 8 + cx.wave, NGW = cx.G * 8;
    for (int m = gw; m < T_TOK; m += NGW) {
        const GAS f32x4* xr = (const GAS f32x4*)(src + (size_t)m * 1024) + cx.lane; f32x4 v[4]; float s = 0.f;
#pragma unroll
        for (int j = 0; j < 4; ++j) { v[j] = xr[64 * j]; s += (v[j].x * v[j].x + v[j].y * v[j].y) + (v[j].z * v[j].z + v[j].w * v[j].w); }
        const float rs = __builtin_amdgcn_rsqf(wave_sum(s) * (1.f / 1024.f) + EPS);
        GAS unsigned long long* o8 = (GAS unsigned long long*)(dst + (size_t)m * 1024) + cx.lane;
#pragma unroll
        for (int j = 0; j < 4; ++j) st8_wt((void*)(o8 + 64 * j), (unsigned long long)pk2(v[j].x * rs, v[j].y * rs) | ((unsigned long long)pk2(v[j].z * rs, v[j].w * rs) << 32));
    }
}
__device__ __forceinline__ void final_norm_rows(const Cx& cx, const bf16* h, float* out, const float* g, const float* ss) {
    const int gw = cx.vcu * 8 + cx.wave, NGW = cx.G * 8;
    f32x4 gv[4];
#pragma unroll
    for (int j = 0; j < 4; ++j) gv[j] = ((const f32x4*)g)[64 * j + cx.lane];
    for (int m0 = gw; m0 < T_TOK; m0 += 4 * NGW) {
        u32x2g w[4][4]; float rs[4];
#pragma unroll
        for (int r = 0; r < 4; ++r) { const int m = m0 + r * NGW; const GAS u32x2g* xr = (const GAS u32x2g*)(h + (size_t)m * 1024) + cx.lane; rs[r] = pg8::row_rs16(ss, m);
#pragma unroll
            for (int j = 0; j < 4; ++j) w[r][j] = xr[64 * j]; }
#pragma unroll
        for (int r = 0; r < 4; ++r) { GAS f32x4* orow = (GAS f32x4*)(out + (size_t)(m0 + r * NGW) * 1024) + cx.lane;
#pragma unroll
            for (int j = 0; j < 4; ++j) orow[64 * j] = (f32x4){lo2f(w[r][j].x), hi2f(w[r][j].x), lo2f(w[r][j].y), hi2f(w[r][j].y)} * rs[r] * gv[j]; }
    }
}
__device__ __forceinline__ void router_rows(const Cx& cx, const bf16* h, const float* g, const float* R, int* hist, int* toke, float* gatew, const float* ss) {
    LAS unsigned short* BW = (LAS unsigned short*)cx.lds;
    LAS int* lcnt = (LAS int*)(cx.lds + 32768);
    LAS float* LG = (LAS float*)(cx.lds + 33792 + cx.wave * 512);
    const int r = cx.lane & 15, quad = cx.lane >> 4;
    for (int blk = cx.vcu; blk < T_TOK / 128; blk += cx.G) {
        const int m0 = blk * 128 + cx.wave * 16;
        if (blk == cx.vcu) {
            float gv[16], rv[16];
#pragma unroll
            for (int ii = 0; ii < 16; ++ii) { const int idx = cx.tid + ii * 512; gv[ii] = g[idx >> 3]; rv[ii] = R[idx]; }
#pragma unroll
            for (int ii = 0; ii < 16; ++ii) { const int idx = cx.tid + ii * 512, e = idx & 7, k = idx >> 3; const float w = gv[ii] * rv[ii];
                const unsigned hi = f2bf(w); const unsigned lo = f2bf(w - __uint_as_float(hi << 16));
                LAS unsigned short* d = BW + (((k >> 3) * 16) + e * 2) * 8 + (k & 7); d[0] = (unsigned short)hi; d[8] = (unsigned short)lo; }
            if (cx.tid < 8) lcnt[cx.tid] = 0;
        }
        v4u a[32];
        { const bf16* hp = h + (size_t)(m0 + r) * 1024 + quad * 8;
#pragma unroll
          for (int i = 0; i < 32; ++i) a[i] = *(const v4u*)(hp + i * 32); }
        f32x4 sp0 = {0.f, 0.f, 0.f, 0.f}, sp1 = sp0, sp2 = sp0, sp3 = sp0;
        if (cx.lane < 16) { const f32x4* p = (const f32x4*)(ss + (size_t)(m0 + cx.lane) * 16); sp0 = p[0]; sp1 = p[1]; sp2 = p[2]; sp3 = p[3]; }
        __syncthreads();
        f32x4 acc = {0.f, 0.f, 0.f, 0.f};
#pragma unroll
        for (int i = 0; i < 32; ++i) { const v4u bw = *(const LAS v4u*)(BW + ((i * 4 + quad) * 16 + r) * 8);
            acc = __builtin_amdgcn_mfma_f32_16x16x32_bf16(__builtin_bit_cast(bf16x8, a[i]), __builtin_bit_cast(bf16x8, bw), acc, 0, 0, 0); }
#pragma unroll
        for (int q = 0; q < 4; ++q) { const float v = acc[q] + __shfl_xor(acc[q], 1); if (!(r & 1)) LG[(quad * 4 + q) * 8 + (r >> 1)] = v; }
        LDS_WAIT(); asm volatile("" ::: "memory");
        if (cx.lane < 16) { const int m = m0 + cx.lane; const f32x4 l0 = *(const LAS f32x4*)(LG + cx.lane * 8), l1 = *(const LAS f32x4*)(LG + cx.lane * 8 + 4);
            const float s = (((sp0[0] + sp0[1]) + (sp0[2] + sp0[3])) + ((sp1[0] + sp1[1]) + (sp1[2] + sp1[3]))) + (((sp2[0] + sp2[1]) + (sp2[2] + sp2[3])) + ((sp3[0] + sp3[1]) + (sp3[2] + sp3[3])));
            const float rs = __builtin_amdgcn_rsqf(s * (1.f / 1024.f) + EPS);
            float lg[8] = {l0[0] * rs, l0[1] * rs, l0[2] * rs, l0[3] * rs, l1[0] * rs, l1[1] * rs, l1[2] * rs, l1[3] * rs};
            int e0 = 0; float v0 = lg[0];
#pragma unroll
            for (int e = 1; e < 8; ++e) if (lg[e] > v0) { v0 = lg[e]; e0 = e; }
            int e1 = -1; float v1 = -INFINITY;
#pragma unroll
            for (int e = 0; e < 8; ++e) if (e != e0 && lg[e] > v1) { v1 = lg[e]; e1 = e; }
            const float t = __expf(v1 - v0), w0 = 1.0f / (1.0f + t);
            __hip_atomic_fetch_add(lcnt + e0, 1, __ATOMIC_RELAXED, __HIP_MEMORY_SCOPE_WORKGROUP); __hip_atomic_fetch_add(lcnt + e1, 1, __ATOMIC_RELAXED, __HIP_MEMORY_SCOPE_WORKGROUP);
            toke[m] = e0 | (e1 << 8); *(float2*)(gatew + (size_t)m * 2) = make_float2(w0, t * w0); }
        __syncthreads();
        if (cx.tid < 8) { hist[blk * 8 + cx.tid] = lcnt[cx.tid]; lcnt[cx.tid] = 0; }
        __syncthreads();
    }
}
__device__ __forceinline__ void moe_prefix(const Cx& cx, gu32* cursor, LAS int* tb) {
    if (cx.tid == 0) { int t = 0;
        for (int e = 0; e < NEXP; ++e) { tb[e] = t; t += ((int)__hip_atomic_load(cursor + e * 64, RLX_AGENT) + 255) >> 8; }
        tb[NEXP] = t; }
    __syncthreads();
}
__device__ __forceinline__ void dispatch_rows(const Cx& cx, const bf16* hn, bf16* xg, const int* hist, const int* toke, int* tokslot, gu32* cursor, LAS int* tb, const float* ss, float* ssx) {
    LAS int* hh = (LAS int*)cx.lds;
    LAS int* totS = hh + 2048; LAS int* preS = totS + 8; LAS int* e0s = preS + 8; LAS int* e1s = e0s + 128; LAS int* rk0 = e1s + 128; LAS int* rk1 = rk0 + 128; LAS int* d0s = rk1 + 128; LAS int* d1s = d0s + 128;
    for (int blk = cx.vcu; blk < T_TOK / 128; blk += cx.G) {
        if (cx.tid < 256) { const v4u a = *(const v4u*)(hist + cx.tid * 8), b = *(const v4u*)(hist + cx.tid * 8 + 4); *(LAS v4u*)(hh + cx.tid * 8) = a; *(LAS v4u*)(hh + cx.tid * 8 + 4) = b; }
        if (cx.tid < 128) { const int te = toke[blk * 128 + cx.tid]; e0s[cx.tid] = te & 255; e1s[cx.tid] = te >> 8; }
        __syncthreads();
        if (cx.tid < 64) { const int e = cx.tid & 7, part = cx.tid >> 3; int tot = 0, pre = 0;
            for (int b = part * 32; b < part * 32 + 32; ++b) { const int v = hh[b * 8 + e]; pre += (b < blk) ? v : 0; tot += v; }
            d0s[cx.tid] = tot; d1s[cx.tid] = pre; }
        __syncthreads();
        if (cx.tid < 8) { int tot = 0, pre = 0; for (int q = 0; q < 8; ++q) { tot += d0s[q * 8 + cx.tid]; pre += d1s[q * 8 + cx.tid]; } totS[cx.tid] = tot; preS[cx.tid] = pre;
            if (blk == 0) __hip_atomic_store(cursor + cx.tid * 64, (unsigned)tot, RLX_AGENT); }
        { const int e = cx.wave, la = cx.lane, lb = cx.lane + 64; const bool f0a = e0s[la] == e, f1a = e1s[la] == e, f0b = e0s[lb] == e, f1b = e1s[lb] == e;
          const unsigned long long M0a = __ballot(f0a), M1a = __ballot(f1a), M0b = __ballot(f0b), M1b = __ballot(f1b), below = (1ull << la) - 1ull;
          const int ba = __popcll(M0a & below) + __popcll(M1a & below), bb = __popcll(M0a) + __popcll(M1a) + __popcll(M0b & below) + __popcll(M1b & below);
          if (f0a) rk0[la] = ba; if (f1a) rk1[la] = ba; if (f0b) rk0[lb] = bb; if (f1b) rk1[lb] = bb; }
        __syncthreads();
        if (cx.tid == 0) { int t = 0; for (int e = 0; e < NEXP; ++e) { tb[e] = t; t += (totS[e] + 255) >> 8; } tb[NEXP] = t; }
        __syncthreads();
        if (cx.tid < 128) { const int m = blk * 128 + cx.tid, e0 = e0s[cx.tid], e1 = e1s[cx.tid], p0 = preS[e0] + rk0[cx.tid], p1 = preS[e1] + rk1[cx.tid];
            *(int4*)(tokslot + (size_t)m * 4) = make_int4(e0, p0, e1, p1); d0s[cx.tid] = tb[e0] * 256 + p0; d1s[cx.tid] = tb[e1] * 256 + p1; }
        __syncthreads();
#pragma unroll 1
        for (int i0 = 0; i0 < 16; i0 += 4) {
            v4u av[4], bv[4]; f32x4 sp[4];
#pragma unroll
            for (int r = 0; r < 4; ++r) { const int m = blk * 128 + cx.wave * 16 + i0 + r;
                av[r] = *(const v4u*)(hn + (size_t)m * 1024 + cx.lane * 8); bv[r] = *(const v4u*)(hn + (size_t)m * 1024 + 512 + cx.lane * 8); sp[r] = *((const f32x4*)(ss + (size_t)m * 16) + (cx.lane & 3)); }
#pragma unroll
            for (int r = 0; r < 4; ++r) { const int t = cx.wave * 16 + i0 + r; const size_t d0 = (size_t)d0s[t], d1 = (size_t)d1s[t]; v4u a = av[r], b = bv[r];
                float s = (sp[r][0] + sp[r][1]) + (sp[r][2] + sp[r][3]); s += swz_xor<1>(s); s += swz_xor<2>(s);
                const float rs = rsqrtf(s * (1.f / 1024.f) + EPS);
                a.x = pk2(lo2f(a.x) * rs, hi2f(a.x) * rs); a.y = pk2(lo2f(a.y) * rs, hi2f(a.y) * rs); a.z = pk2(lo2f(a.z) * rs, hi2f(a.z) * rs); a.w = pk2(lo2f(a.w) * rs, hi2f(a.w) * rs);
                b.x = pk2(lo2f(b.x) * rs, hi2f(b.x) * rs); b.y = pk2(lo2f(b.y) * rs, hi2f(b.y) * rs); b.z = pk2(lo2f(b.z) * rs, hi2f(b.z) * rs); b.w = pk2(lo2f(b.w) * rs, hi2f(b.w) * rs);
                st16_wt(xg + d0 * 1024 + cx.lane * 8, a); st16_wt(xg + d0 * 1024 + 512 + cx.lane * 8, b);
                st16_wt(xg + d1 * 1024 + cx.lane * 8, a); st16_wt(xg + d1 * 1024 + 512 + cx.lane * 8, b); } }
        __syncthreads();
    }
}
__device__ __forceinline__ void add_y2p(float (&a)[4], const bf16* y2p, unsigned s, size_t d, int lane) {
    a[0] = a[1] = a[2] = a[3] = 0.f;
#pragma unroll
    for (int q = 0; q < 4; ++q) { const u32x2g w = *((const GAS u32x2g*)(y2p + (size_t)(q * 32 + s) * 65536 + (d & 255) * 256) + lane); a[0] += lo2f(w.x); a[1] += hi2f(w.x); a[2] += lo2f(w.y); a[3] += hi2f(w.y); }
}
__device__ __forceinline__ void combine_rows(const Cx& cx, bf16* h, const bf16* y2, const bf16* y2p, const int* tokslot, const float* gatew, const LAS int* tb, float* sso) {
    const int gw = cx.vcu * 8 + cx.wave, NGW = cx.G * 8;
    LAS unsigned char* spl = (LAS unsigned char*)(cx.lds + MISC_OFF + 6144);
    { const int total = tb[NEXP] * 4, n5 = total - 4 * cx.G;
      for (int i = cx.tid; i < 1088; i += 512) spl[i] = 0xffu;
      __syncthreads();
      if (cx.tid < n5) { pg8::GroupedOrder S{(const PG8_LAS int*)tb, 4, cx.G, 0}; pg8::Unit u; S.map(4 * cx.G + cx.tid, total, u); spl[u.pm * 4 + u.pn] = (unsigned char)cx.tid; }
      __syncthreads(); }
    for (int m0 = gw; m0 < T_TOK; m0 += 2 * NGW) {
        int4 tsv[2]; float2 gwv[2];
#pragma unroll
        for (int r = 0; r < 2; ++r) { const int m = m0 + r * NGW; tsv[r] = *(const int4*)(tokslot + (size_t)m * 4); gwv[r] = *(const float2*)(gatew + (size_t)m * 2); }
        u32x2g hw[2][4], aw[2][4], bw[2][4]; size_t d0v[2], d1v[2];
#pragma unroll
        for (int r = 0; r < 2; ++r) { const int m = m0 + r * NGW; d0v[r] = (size_t)(tb[tsv[r].x] * 256 + tsv[r].y); d1v[r] = (size_t)(tb[tsv[r].z] * 256 + tsv[r].w);
            const GAS u32x2g* xr = (const GAS u32x2g*)(h + (size_t)m * 1024) + cx.lane;
            const GAS u32x2g* y0 = (const GAS u32x2g*)(y2 + d0v[r] * 1024) + cx.lane; const GAS u32x2g* y1 = (const GAS u32x2g*)(y2 + d1v[r] * 1024) + cx.lane;
#pragma unroll
            for (int j = 0; j < 4; ++j) { hw[r][j] = xr[64 * j]; aw[r][j] = y0[64 * j]; bw[r][j] = y1[64 * j]; } }
#pragma unroll
        for (int r = 0; r < 2; ++r) { const int m = m0 + r * NGW; const size_t d0 = d0v[r], d1 = d1v[r]; const float2 gwt = gwv[r]; float s = 0.f;
        GAS u32x2g* xr = (GAS u32x2g*)(h + (size_t)m * 1024) + cx.lane;
        const unsigned sa = *(const LAS unsigned*)(spl + (d0 >> 8) * 4), sb = *(const LAS unsigned*)(spl + (d1 >> 8) * 4);
        float a[4][4], b[4][4];
#pragma unroll
        for (int j = 0; j < 4; ++j) { a[j][0] = lo2f(aw[r][j].x); a[j][1] = hi2f(aw[r][j].x); a[j][2] = lo2f(aw[r][j].y); a[j][3] = hi2f(aw[r][j].y); b[j][0] = lo2f(bw[r][j].x); b[j][1] = hi2f(bw[r][j].x); b[j][2] = lo2f(bw[r][j].y); b[j][3] = hi2f(bw[r][j].y); }
        if ((sa & sb) != 0xffffffffu) {
#pragma unroll
            for (int j = 0; j < 4; ++j) { const unsigned s0 = (sa >> (8 * j)) & 255u, s1 = (sb >> (8 * j)) & 255u; if (s0 != 255u) add_y2p(a[j], y2p, s0, d0, cx.lane); if (s1 != 255u) add_y2p(b[j], y2p, s1, d1, cx.lane); } }
#pragma unroll
        for (int j = 0; j < 4; ++j) { const float v0 = lo2f(hw[r][j].x) + gwt.x * a[j][0] + gwt.y * b[j][0], v1 = hi2f(hw[r][j].x) + gwt.x * a[j][1] + gwt.y * b[j][1], v2 = lo2f(hw[r][j].y) + gwt.x * a[j][2] + gwt.y * b[j][2], v3 = hi2f(hw[r][j].y) + gwt.x * a[j][3] + gwt.y * b[j][3];
            u32x2g o; o.x = pk2(v0, v1); o.y = pk2(v2, v3); xr[64 * j] = o; s += (v0 * v0 + v1 * v1) + (v2 * v2 + v3 * v3); }
        s = wave_sum(s); if (cx.lane < 4) ((f32x4*)(sso + (size_t)m * 16))[cx.lane] = (f32x4){cx.lane == 0 ? s : 0.f, 0.f, 0.f, 0.f}; }
    }
}
__device__ __forceinline__ void diff_combine_rows(const Cx& cx, const bf16* ov, bf16* yc, const float* lp, const float* subg, float lam_init) {
    const int gw = cx.vcu * 8 + cx.wave, NGW = cx.G * 8, hh = cx.lane >> 4, dc = cx.lane & 15;
    const float s01 = wave_sum(lp[cx.lane] * lp[64 + cx.lane]), s23 = wave_sum(lp[128 + cx.lane] * lp[192 + cx.lane]);
    const float lam = expf(s01) - expf(s23) + lam_init, post = 1.0f - lam_init;
    const f32x4 g0 = *(const f32x4*)(subg + dc * 8), g1 = *(const f32x4*)(subg + dc * 8 + 4);
    for (int m0 = gw; m0 < T_TOK; m0 += 4 * NGW) {
        v4u av[4], bv[4];
#pragma unroll
        for (int r = 0; r < 4; ++r) { const size_t m = (size_t)m0 + (size_t)r * NGW; av[r] = *(const v4u*)(ov + m * 1024 + hh * 256 + dc * 8); bv[r] = *(const v4u*)(ov + m * 1024 + hh * 256 + 128 + dc * 8); }
#pragma unroll
        for (int r = 0; r < 4; ++r) { const size_t m = (size_t)m0 + (size_t)r * NGW; const v4u a = av[r], b = bv[r];
        float y[8];
        y[0] = lo2f(a.x) - lam * lo2f(b.x); y[1] = hi2f(a.x) - lam * hi2f(b.x); y[2] = lo2f(a.y) - lam * lo2f(b.y); y[3] = hi2f(a.y) - lam * hi2f(b.y);
        y[4] = lo2f(a.z) - lam * lo2f(b.z); y[5] = hi2f(a.z) - lam * hi2f(b.z); y[6] = lo2f(a.w) - lam * lo2f(b.w); y[7] = hi2f(a.w) - lam * hi2f(b.w);
        float s = 0.f;
#pragma unroll
        for (int i = 0; i < 8; ++i) s += y[i] * y[i];
        s = sum16(s);
        const float rs = post * __builtin_amdgcn_rsqf(s * (1.f / 128.f) + EPS);
        v4u o; o.x = pk2(y[0] * rs * g0[0], y[1] * rs * g0[1]); o.y = pk2(y[2] * rs * g0[2], y[3] * rs * g0[3]); o.z = pk2(y[4] * rs * g1[0], y[5] * rs * g1[1]); o.w = pk2(y[6] * rs * g1[2], y[7] * rs * g1[3]);
        st16_wt(yc + m * 1024 + 256 + hh * 128 + dc * 8, o); }
    }
}

__device__ __forceinline__ void conv_units(const Cx& cx, const bf16* zu, bf16* yc, const float* cw, const float* cb, const float* lng, const float* lnb) {
    LAS unsigned short* ub = (LAS unsigned short*)cx.lds;
    LAS float* cbuf = (LAS float*)(cx.lds + 49152);
    const int c = cx.tid & 255, th = cx.tid >> 8;
    float w[31];
#pragma unroll
    for (int j = 0; j < 31; ++j) w[j] = cw[j * 256 + c];
    const float bias = cb[c];
    const f32x4 lg = *(const f32x4*)(lng + 4 * cx.lane), lb = *(const f32x4*)(lnb + 4 * cx.lane);
    v4u xs[6];
#define CONV_LD(unit_) do { const int t0_ = (unit_) * 64, tin_ = t0_ & (SEQ - 1); _Pragma("unroll") for (int i_ = 0; i_ < 6; ++i_) { const int ch_ = cx.tid + i_ * 512, r_ = ch_ >> 5, cc_ = ch_ & 31; xs[i_] = (v4u){0u, 0u, 0u, 0u}; \
        if (ch_ < 94 * 32 && tin_ - 30 + r_ >= 0) xs[i_] = *(const v4u*)(zu + (size_t)(t0_ - 30 + r_) * 256 + cc_ * 8); } } while (0)
    if (cx.vcu < T_TOK / 64) CONV_LD(cx.vcu);
    for (int unit = cx.vcu; unit < T_TOK / 64; unit += cx.G) {
        const int t0 = unit * 64;
#pragma unroll
        for (int i = 0; i < 6; ++i) { const int ch = cx.tid + i * 512, r = ch >> 5, cc = ch & 31; if (ch < 94 * 32) *(LAS v4u*)(ub + r * 256 + cc * 8) = xs[i]; }
        __syncthreads();
        if (unit + cx.G < T_TOK / 64) CONV_LD(unit + cx.G);
#pragma unroll 2
        for (int ob = 0; ob < 4; ++ob) {
            float xw[38];
#pragma unroll
            for (int i = 0; i < 38; ++i) xw[i] = b2f(ub[(th * 32 + ob * 8 + i) * 256 + c]);
#pragma unroll
            for (int o = 0; o < 8; ++o) { float a = bias;
#pragma unroll
                for (int j = 0; j < 31; ++j) a += w[j] * xw[o + j];
                cbuf[(th * 32 + ob * 8 + o) * 256 + c] = a; }
        }
        __syncthreads();
#pragma unroll
        for (int i = 0; i < 8; ++i) { const int tok = cx.wave * 8 + i; const f32x4 x = *(const LAS f32x4*)(cbuf + tok * 256 + 4 * cx.lane);
            const float mean = wave_sum((x[0] + x[1]) + (x[2] + x[3])) * (1.f / 256.f); const f32x4 d = x - mean;
            const float var = wave_sum((d[0] * d[0] + d[1] * d[1]) + (d[2] * d[2] + d[3] * d[3])) * (1.f / 256.f); const float rstd = __builtin_amdgcn_rsqf(var + EPS);
            f32x4 y = d * rstd * lg + lb;
#pragma unroll
            for (int q = 0; q < 4; ++q) y[q] = y[q] * sigm(y[q]);
            st8_wt(yc + (size_t)(t0 + tok) * 1024 + 4 * cx.lane, (unsigned long long)pk2(y[0], y[1]) | ((unsigned long long)pk2(y[2], y[3]) << 32)); }
        __syncthreads();
    }
}

#undef CONV_LD
__device__ __forceinline__ void gla_pass1(const Cx& cx, const bf16* zg, const float* la, float* kvs, float* dec) {
    const int lane = cx.lane, n = lane & 15, quad = lane >> 4;
    for (int task = cx.vcu * 8 + cx.wave; task < 2048; task += cx.G * 8) {
        const int hd = task & 3, chunk = task >> 2; const size_t t0 = (size_t)chunk * 64; const int bh = (chunk >> 7) * 4 + hd, nn = chunk & 127;
        float lv[2][2][8]; unsigned kq[2][2][8]; u32x2g vx[2][8];
#pragma unroll
        for (int cs = 0; cs < 2; ++cs)
#pragma unroll
            for (int j = 0; j < 8; ++j) { const size_t tk = t0 + cs * 32 + quad * 8 + j;
                lv[0][cs][j] = la[tk * 128 + hd * 32 + n]; lv[1][cs][j] = la[tk * 128 + hd * 32 + 16 + n];
                kq[0][cs][j] = ((const unsigned short*)zg)[tk * 768 + 128 + hd * 32 + n]; kq[1][cs][j] = ((const unsigned short*)zg)[tk * 768 + 128 + hd * 32 + 16 + n];
                vx[cs][j] = *(const GAS u32x2g*)(zg + tk * 768 + 256 + hd * 64 + 4 * n); }
        v4u af[2][2];
#pragma unroll
        for (int mt = 0; mt < 2; ++mt) {
#pragma unroll
            for (int cs = 0; cs < 2; ++cs)
#pragma unroll
                for (int j = 1; j < 8; ++j) lv[mt][cs][j] += lv[mt][cs][j - 1];
            float b0 = 0.f, b1 = 0.f, h0 = 0.f, h1 = 0.f;
#pragma unroll
            for (int q = 0; q < 4; ++q) { const float x0 = __shfl(lv[mt][0][7], n + 16 * q), x1 = __shfl(lv[mt][1][7], n + 16 * q); h0 += x0; h1 += x1; if (q < quad) { b0 += x0; b1 += x1; } }
            b1 += h0; const float tot = h0 + h1;
            if (quad == 0) dec[((size_t)bh * 128 + nn) * 32 + mt * 16 + n] = __expf(tot);
#pragma unroll
            for (int cs = 0; cs < 2; ++cs) { float w[8]; const float base = cs ? b1 : b0;
#pragma unroll
                for (int j = 0; j < 8; ++j) w[j] = __uint_as_float(kq[mt][cs][j] << 16) * __expf(tot - (base + lv[mt][cs][j]));
                af[mt][cs] = (v4u){pk2(w[0], w[1]), pk2(w[2], w[3]), pk2(w[4], w[5]), pk2(w[6], w[7])}; }
        }
        f32x4 d[2][4];
#pragma unroll
        for (int nt = 0; nt < 4; ++nt) { v4u bf[2];
#pragma unroll
            for (int cs = 0; cs < 2; ++cs)
#pragma unroll
                for (int jj = 0; jj < 4; ++jj) { const unsigned lo = (nt & 2) ? vx[cs][2 * jj].y : vx[cs][2 * jj].x, hi = (nt & 2) ? vx[cs][2 * jj + 1].y : vx[cs][2 * jj + 1].x;
                    bf[cs][jj] = __builtin_amdgcn_perm(hi, lo, (nt & 1) ? 0x07060302u : 0x05040100u); }
#pragma unroll
            for (int mt = 0; mt < 2; ++mt) {
                d[mt][nt] = __builtin_amdgcn_mfma_f32_16x16x32_bf16(__builtin_bit_cast(bf16x8, af[mt][0]), __builtin_bit_cast(bf16x8, bf[0]), (f32x4){0.f, 0.f, 0.f, 0.f}, 0, 0, 0);
                d[mt][nt] = __builtin_amdgcn_mfma_f32_16x16x32_bf16(__builtin_bit_cast(bf16x8, af[mt][1]), __builtin_bit_cast(bf16x8, bf[1]), d[mt][nt], 0, 0, 0); } }
        float* dst = kvs + ((size_t)bh * 128 + nn) * 2048 + 4 * n;
#pragma unroll
        for (int mt = 0; mt < 2; ++mt)
#pragma unroll
            for (int q = 0; q < 4; ++q) *(f32x4*)(dst + (mt * 16 + quad * 4 + q) * 64) = (f32x4){d[mt][0][q], d[mt][1][q], d[mt][2][q], d[mt][3][q]};
    }
}
__device__ __forceinline__ void gla_scan(const Cx& cx, float* kvs, const float* dec) {
    for (int j = cx.vcu; j < 64; j += cx.G) {
        const int bh = j >> 2, idx = (j & 3) * 512 + cx.tid, k = idx >> 6;
        float* p = kvs + (size_t)bh * 128 * 2048 + idx; const float* dp = dec + (size_t)bh * 128 * 32 + k;
        float s = 0.f;
        for (int n0 = 0; n0 < 128; n0 += 32) { float kv[32], d[32];
#pragma unroll
            for (int q = 0; q < 32; ++q) { kv[q] = p[(size_t)(n0 + q) * 2048]; d[q] = dp[(n0 + q) * 32]; }
#pragma unroll
            for (int q = 0; q < 32; ++q) { s = d[q] * s + kv[q]; p[(size_t)(n0 + q) * 2048] = s; } }
    }
}
__device__ __forceinline__ void gla_pass3(const Cx& cx, const bf16* zg, const float* kvs, const float* ng, bf16* yc) {
    const int lane = cx.lane, n = lane & 15, quad = lane >> 4;
    const f32x4 gn = *(const f32x4*)(ng + 4 * n);
    for (int task = cx.vcu * 8 + cx.wave; task < 2048; task += cx.G * 8) {
        const int hd = task & 3, chunk = task >> 2; const size_t t0 = (size_t)chunk * 64; const int bh = (chunk >> 7) * 4 + hd, nn = chunk & 127;
        const float* sp = kvs + ((size_t)bh * 128 + nn) * 2048 + (quad * 8) * 64 + 4 * n;
        f32x4 sv[8];
#pragma unroll
        for (int j = 0; j < 8; ++j) sv[j] = *(const f32x4*)(sp + j * 64);
        v4u qa[4]; u32x2g rw[16];
#pragma unroll
        for (int mt = 0; mt < 4; ++mt) qa[mt] = *(const v4u*)(zg + (t0 + mt * 16 + n) * 768 + hd * 32 + quad * 8);
#pragma unroll
        for (int i = 0; i < 16; ++i) rw[i] = *(const GAS u32x2g*)(zg + (t0 + (i >> 2) * 16 + quad * 4 + (i & 3)) * 768 + 512 + hd * 64 + 4 * n);
        f32x4 d[4][4];
#pragma unroll
        for (int nt = 0; nt < 4; ++nt) { v4u bw; bw.x = pk2(sv[0][nt], sv[1][nt]); bw.y = pk2(sv[2][nt], sv[3][nt]); bw.z = pk2(sv[4][nt], sv[5][nt]); bw.w = pk2(sv[6][nt], sv[7][nt]);
#pragma unroll
            for (int mt = 0; mt < 4; ++mt) d[mt][nt] = __builtin_amdgcn_mfma_f32_16x16x32_bf16(__builtin_bit_cast(bf16x8, qa[mt]), __builtin_bit_cast(bf16x8, bw), (f32x4){0.f, 0.f, 0.f, 0.f}, 0, 0, 0); }
#pragma unroll
        for (int i = 0; i < 16; ++i) { const int mt = i >> 2, q = i & 3;
            const float o0 = d[mt][0][q], o1 = d[mt][1][q], o2 = d[mt][2][q], o3 = d[mt][3][q];
            const float ss = sum16((o0 * o0 + o1 * o1) + (o2 * o2 + o3 * o3));
            const float rs = 0.17677669529663687f * __builtin_amdgcn_rsqf(ss * (0.03125f / 64.f) + EPS);
            const u32x2g w = rw[i]; const float r0 = lo2f(w.x), r1 = hi2f(w.x), r2 = lo2f(w.y), r3 = hi2f(w.y);
            u32x2g ow; ow.x = pk2(o0 * rs * gn[0] * (r0 * sigm(r0)), o1 * rs * gn[1] * (r1 * sigm(r1))); ow.y = pk2(o2 * rs * gn[2] * (r2 * sigm(r2)), o3 * rs * gn[3] * (r3 * sigm(r3)));
            *(GAS u32x2g*)(yc + (t0 + mt * 16 + quad * 4 + q) * 1024 + 768 + hd * 64 + 4 * n) = ow; }
    }
}
#if MK_CHECK
constexpr int CW_CHK = 12288;
__device__ __forceinline__ unsigned hsh(unsigned x) { x ^= x >> 16; x *= 0x7feb352dU; x ^= x >> 15; x *= 0x846ca68bU; x ^= x >> 16; return x; }
__device__ __forceinline__ bool bad(float got, float ref, float tol) { return !(fabsf(got - ref) <= 2.0f * tol * fmaxf(fabsf(ref), 1.0f)); }
__device__ __forceinline__ bool bad_small(float got, float ref) { return !(fabsf(got - ref) <= 0.004f + 0.05f * fabsf(ref)); }
__device__ __forceinline__ void cntf(gu32* ctl, int slot, unsigned n) { if (n) __hip_atomic_fetch_add(ctl + CW_CHK + 64 * (1 + slot), n, RLX_AGENT); }
__device__ __forceinline__ void flag(gu32* ctl, int bit) { __hip_atomic_fetch_or(ctl + CW_CHK, 1u << bit, RLX_AGENT); }
__device__ __forceinline__ float logsig(float x) { return fminf(x, 0.f) - __logf(1.f + __expf(-fabsf(x))); }
__device__ __forceinline__ float zdot(const float* xr, float rs, const float* gmix, const float* win, int col) { float a = 0.f; for (int k = 0; k < 1024; ++k) a += xr[k] * rs * gmix[k] * win[(size_t)k * D_IN + col]; return a; }
__device__ __forceinline__ void chk_win(int tid, const float* x, const float* gmix, const float* win, const float* wg2, const float* bg, const bf16* ZU, const bf16* ZQ, const bf16* ZK, const bf16* ZV, const bf16* ZG, const float* LA, gu32* ctl) {
    for (int s = tid; s < 3072; s += 512) {
        const unsigned h1 = hsh(s * 2654435761u + 17u), h2 = hsh(h1 + 0x9e3779b9u); const int row = h1 % T_TOK, type = s % 6;
        const float* xr = x + (size_t)row * 1024; float ss = 0.f; for (int k = 0; k < 1024; ++k) ss += xr[k] * xr[k]; const float rs = 1.0f / sqrtf(ss / 1024.f + EPS);
        float got, ref;
        if (type == 0) { const int ch = h2 % 256; const float a = zdot(xr, rs, gmix, win, ch), g = zdot(xr, rs, gmix, win, 256 + ch); ref = a / (1.f + expf(-g)); got = b2f(ZU[(size_t)row * 256 + ch]); }
        else if (type == 1 || type == 2) { const int comp = h2 % 8, d = (h2 >> 8) % 64, base = (type == 1 ? 512 : 1024) + comp * 64; const float sc = type == 1 ? 0.125f * 1.4426950408889634f : 1.f;
            if (d < 16) { const int j = d & 7; const float x1 = zdot(xr, rs, gmix, win, base + j), x2 = zdot(xr, rs, gmix, win, base + 8 + j); const int pos = row & (SEQ - 1);
                const double invf[8] = {1.0, 0.19391010807943456, 0.037601130015015855, 0.0072912391843014545, 0.001414213562373095, 0.00027423030417878515, 5.317602791587768e-05, 1.031136931769684e-05}; double fq_ = invf[0];
                for (int q_ = 1; q_ < 8; ++q_) fq_ = (j == q_) ? invf[q_] : fq_;
                const double rev = (double)pos * fq_ * 0.15915494309189535; const float fr_ = (float)(rev - rint(rev)); const float c = __builtin_amdgcn_cosf(fr_), sn = __builtin_amdgcn_sinf(fr_);
                ref = (d < 8 ? x1 * c - x2 * sn : x2 * c + x1 * sn) * sc; }
            else ref = zdot(xr, rs, gmix, win, base + d) * sc;
            int nd = d; if (d >= 4 && d < 8) nd = d + 4; else if (d >= 8 && d < 12) nd = d - 4;
            got = b2f((type == 1 ? ZQ : ZK)[(size_t)row * 512 + comp * 64 + nd]); }
        else if (type == 3) { const int col = h2 % 512; ref = zdot(xr, rs, gmix, win, 1536 + col); got = b2f(ZV[(size_t)row * 512 + col]); }
        else if (type == 4) { const int col = h2 % 768; ref = zdot(xr, rs, gmix, win, 2048 + col); got = b2f(ZG[(size_t)row * 768 + col]); }
        else { const int col = h2 % 128; float pre = bg[col]; for (int r = 0; r < 16; ++r) pre += zdot(xr, rs, gmix, win, 2816 + r) * wg2[r * 128 + col]; ref = logsig(pre) / 16.f; got = LA[(size_t)row * 128 + col]; }
        if (type == 5 ? bad_small(got, ref) : bad(got, ref, 0.04f)) flag(ctl, type == 0 ? 0 : (type < 3 ? 1 : 2));
    }
}
__device__ __forceinline__ float convy(const bf16* ZU, const float* cw, const float* cb, int row, int tin, int c) { float a = cb[c]; for (int j = 0; j < 31; ++j) { const int tt = tin - 30 + j; if (tt >= 0) a += cw[j * 256 + c] * b2f(ZU[(size_t)(row - 30 + j) * 256 + c]); } return a; }
__device__ __forceinline__ void chk_conv(int tid, const bf16* ZU, const bf16* YC, const float* cw, const float* cb, const float* lng, const float* lnb, gu32* ctl, int slot) {
    const unsigned h1 = hsh(tid * 2246822519u + 3u); int row = h1 % T_TOK; if (tid < 64) row = (tid & 3) * SEQ + (tid >> 2);
    const int tin = row & (SEQ - 1);
    float mu = 0.f; for (int c = 0; c < 256; ++c) mu += convy(ZU, cw, cb, row, tin, c); mu /= 256.f;
    float var = 0.f; for (int c = 0; c < 256; ++c) { const float d = convy(ZU, cw, cb, row, tin, c) - mu; var += d * d; } var /= 256.f; const float rstd = 1.0f / sqrtf(var + EPS);
    unsigned nf = 0, nq0 = 0, nq1 = 0; for (int c = 0; c < 256; ++c) { const float y = (convy(ZU, cw, cb, row, tin, c) - mu) * rstd * lng[c] + lnb[c]; const float ref = y / (1.f + expf(-y)); if (bad(b2f(YC[(size_t)row * 1024 + c]), ref, 0.04f)) { ++nf; if (c < 64) ++nq0; else if (c < 128) ++nq1; } }
    cntf(ctl, 2, nq0); cntf(ctl, 3, nq1);
    if (nf) flag(ctl, 3); cntf(ctl, slot, nf > 8 ? 1u : 0u);
}
__device__ __forceinline__ void chk_gla(int tid, const bf16* ZG, const float* LA, const float* ng, const bf16* YC, gu32* ctl) {
    const unsigned h1 = hsh(tid * 3266489917u + 5u); const int b = h1 & 3, n = (h1 >> 2) % 3, c = (h1 >> 8) & 63, hd = (h1 >> 16) & 3; const size_t row = (size_t)b * SEQ + n * 64 + c;
    float o[64];
#pragma unroll
    for (int v = 0; v < 64; ++v) o[v] = 0.f;
    for (int k = 0; k < 32; ++k) {
        float st[64];
#pragma unroll
        for (int v = 0; v < 64; ++v) st[v] = 0.f;
        for (int m = 0; m <= n; ++m) { const size_t t0 = (size_t)b * SEQ + m * 64; float tot = 0.f; for (int cc = 0; cc < 64; ++cc) tot += LA[(t0 + cc) * 128 + hd * 32 + k];
            const float dcy = expf(tot);
#pragma unroll
            for (int v = 0; v < 64; ++v) st[v] *= dcy;
            float run = 0.f;
            for (int cc = 0; cc < 64; ++cc) { run += LA[(t0 + cc) * 128 + hd * 32 + k]; const float w = b2f(ZG[(t0 + cc) * 768 + 128 + hd * 32 + k]) * expf(tot - run);
#pragma unroll
                for (int v = 0; v < 64; ++v) st[v] += w * b2f(ZG[(t0 + cc) * 768 + 256 + hd * 64 + v]); } }
        const float q = b2f(ZG[row * 768 + hd * 32 + k]) * 0.17677669529663687f;
#pragma unroll
        for (int v = 0; v < 64; ++v) o[v] += q * st[v];
    }
    float ss = 0.f;
#pragma unroll
    for (int v = 0; v < 64; ++v) ss += o[v] * o[v];
    const float rs = 1.0f / sqrtf(ss / 64.f + EPS); unsigned nf = 0;
#pragma unroll
    for (int v = 0; v < 64; ++v) { const float r = b2f(ZG[row * 768 + 512 + hd * 64 + v]); const float ref = o[v] * rs * ng[v] * (r / (1.f + expf(-r))); if (bad(b2f(YC[row * 1024 + 768 + hd * 64 + v]), ref, 0.05f)) ++nf; }
    if (nf) flag(ctl, 4);
}
__device__ __forceinline__ void chk_attn(int tid, const bf16* ZQ, const bf16* ZK, const bf16* ZV, const bf16* OV, gu32* ctl) {
    const unsigned h1 = hsh(tid * 668265263u + 7u); const int b = h1 & 3, hh = (h1 >> 2) & 3, c = (h1 >> 4) & 1, vq = (h1 >> 5) & 3; int t = (h1 >> 8) % SEQ; if (tid & 1) t = (h1 >> 8) % 512;
    const size_t row = (size_t)b * SEQ + t; const int nk = ((t >> 6) + 1) * 64;
    float q[64];
#pragma unroll
    for (int d = 0; d < 64; ++d) q[d] = b2f(ZQ[row * 512 + (hh * 2 + c) * 64 + d]);
    float m = -INFINITY, l = 0.f, acc[32];
#pragma unroll
    for (int i = 0; i < 32; ++i) acc[i] = 0.f;
    for (int kk = 0; kk < nk; ++kk) { const size_t kr = (size_t)b * SEQ + kk; float s = 0.f;
#pragma unroll
        for (int d = 0; d < 64; ++d) s += q[d] * b2f(ZK[kr * 512 + (hh * 2 + c) * 64 + d]);
        const float mn = fmaxf(m, s), al = exp2f(m - mn), p = exp2f(s - mn); l = l * al + p; m = mn;
#pragma unroll
        for (int i = 0; i < 32; ++i) acc[i] = acc[i] * al + p * b2f(ZV[kr * 512 + hh * 128 + vq * 32 + i]); }
    bool f = false;
#pragma unroll
    for (int i = 0; i < 32; ++i) if (bad(b2f(OV[row * 1024 + hh * 256 + c * 128 + vq * 32 + i]), acc[i] / l, 0.05f)) f = true;
    if (f) flag(ctl, 5);
}
__device__ __forceinline__ void chk_mix(int tid, const bf16* OV, const bf16* YC, const float* lp, const float* subg, const float* x, const float* wout, const float* out, gu32* ctl) {
    float s01 = 0.f, s23 = 0.f; for (int d = 0; d < 64; ++d) { s01 += lp[d] * lp[64 + d]; s23 += lp[128 + d] * lp[192 + d]; }
    const float lam = expf(s01) - expf(s23) + 0.2f;
    const unsigned h1 = hsh(tid * 374761393u + 11u); const size_t row = h1 % T_TOK; const int hh = (h1 >> 20) & 3;
    float ss = 0.f; for (int d = 0; d < 128; ++d) { const float y = b2f(OV[row * 1024 + hh * 256 + d]) - lam * b2f(OV[row * 1024 + hh * 256 + 128 + d]); ss += y * y; }
    const float rs = 0.8f / sqrtf(ss / 128.f + EPS); bool f = false;
    for (int d = 0; d < 128; ++d) { const float y = b2f(OV[row * 1024 + hh * 256 + d]) - lam * b2f(OV[row * 1024 + hh * 256 + 128 + d]); if (bad(b2f(YC[row * 1024 + 256 + hh * 128 + d]), y * rs * subg[d], 0.04f)) f = true; }
    if (f) flag(ctl, 6);
    const int col = (h1 >> 8) & 1023; float a = x[row * 1024 + col]; for (int k = 0; k < 1024; ++k) a += b2f(YC[row * 1024 + k]) * wout[(size_t)k * 1024 + col];
    if (bad(out[row * 1024 + col], a, 0.03f)) flag(ctl, 6);
}
#endif
#ifndef MK_CHECK
#define MK_CHECK 0
#endif
#ifndef MK_TIME
#define MK_TIME 0
#endif
#ifndef MK_DELAY
#define MK_DELAY 0
#endif
#ifndef MK_XBAR
#define MK_XBAR 0
#endif
#ifndef MK_DBLK
#define MK_DBLK 0
#endif
#ifndef MK_STAG
#define MK_STAG 0
#endif
#ifndef MK_MULTI
#define MK_MULTI 0
#endif
constexpr int NPH_LAYER = 12, NPH = 1 + DEPTH * NPH_LAYER + 1;
struct Args { const float* in[24]; float* out; unsigned char* ws; int ph_lo, ph_hi; };
#if MK_TIME
#define STAMP_PH() do { if (blockIdx.x == 0 && cx.tid == 0) { volatile LAS unsigned* pc_ = (volatile LAS unsigned*)(ldsb + MISC_OFF + 80); const unsigned k_ = pc_[0]; pc_[0] = k_ + 1u; \
    ((unsigned long long*)((unsigned char*)ldptr(PT, 25) + WS_CTL) + 16384)[k_] = __builtin_amdgcn_s_memrealtime(); } } while (0)
#else
#define STAMP_PH() do {} while (0)
#endif
#if MK_DELAY
#define TSEL(id) ((MK_DELAY) == (id))
#define TSTART(id) do { if (TSEL(id) && blockIdx.x == MK_DBLK && wave_s == 0 && lane_now() == 0) { volatile LAS unsigned long long* t_ = (volatile LAS unsigned long long*)(ldsb + MISC_OFF + 104); t_[0] = __builtin_amdgcn_s_memrealtime(); } } while (0)
#define TSTOP(id) do { if (TSEL(id) && blockIdx.x == MK_DBLK && wave_s == 0 && lane_now() == 0) { volatile LAS unsigned long long* t_ = (volatile LAS unsigned long long*)(ldsb + MISC_OFF + 104); t_[1] += __builtin_amdgcn_s_memrealtime() - t_[0]; } } while (0)
#else
#define TSTART(id) do {} while (0)
#define TSTOP(id) do {} while (0)
#endif
#define IN(k) (lo <= (k) && (k) < hi)
#define SEAM() do { TSTART(11); if (!MK_MULTI) xcd_barrier(bar); TSTOP(11); } while (0)
#define PTR(i) ((const float*)(const GAS float*)ldptr(PT, (i)))
#define PH_BEGIN Cx cx = mkcx(ldsb, wave_s); STAMP_PH(); unsigned char* ws = (unsigned char*)(GAS unsigned char*)ldptr(PT, 25); float* out = (float*)(GAS float*)ldptr(PT, 24); (void)out; \
    bf16* HN = (bf16*)(ws + WS_HN); bf16* ZQ = (bf16*)(ws + WS_ZQ); bf16* ZK = (bf16*)(ws + WS_ZK); bf16* ZV = (bf16*)(ws + WS_ZV); bf16* ZU = (bf16*)(ws + WS_ZU); bf16* ZG = (bf16*)(ws + WS_ZG); \
    bf16* OV = (bf16*)(ws + WS_OV); bf16* YC = (bf16*)(ws + WS_YC); bf16* UP = (bf16*)(ws + WS_UP); bf16* ACT = (bf16*)(ws + WS_ACT); bf16* XG = (bf16*)(ws + WS_XG); bf16* Y2 = (bf16*)(ws + WS_Y2); \
    float* LAp = (float*)(ws + WS_LA); float* KVS = (float*)(ws + WS_KVS); float* DEC = (float*)(ws + WS_DEC); const float* ROPE = (const float*)(ws + WS_ROPE); \
    int* TOKSLOT = (int*)(ws + WS_TOKSLOT); float* GATEW = (float*)(ws + WS_GATEW); gu32* ctl = (gu32*)(ws + WS_CTL); bf16* HNB = (bf16*)(ws + WS_HNB); float* SS = (float*)(ws + WS_SS); float* SSX = (float*)(ws + WS_SSX); (void)HNB; (void)SS; (void)SSX; \
    (void)HN; (void)ZQ; (void)ZK; (void)ZV; (void)ZU; (void)ZG; (void)OV; (void)YC; (void)UP; (void)ACT; (void)XG; (void)Y2; (void)LAp; (void)KVS; (void)DEC; (void)ROPE; (void)TOKSLOT; (void)GATEW; (void)ctl;

template <int li> __device__ __forceinline__ void layer_body(unsigned char* lds_raw, LAS unsigned char* const ldsb, const int wave_s, const int lo, const int hi, const XcdBarrier& bar, const LAS unsigned long long* PT, LAS int* TB) {
        constexpr int pb = 1 + li * NPH_LAYER; constexpr bool moe = (li & 1) != 0; constexpr int hf = li >> 1;
        if (IN(pb + 1)) { PH_BEGIN
            pg8::Gemm g{HNB, (const bf16*)(ws + WS_WIN + li * SZ_WIN), 1024, 0}; pg8::StaticOrder S; S.init(T_TOK, NZ, cx.G, (int)blockIdx.x);
            pg8::EpiWin E{ZU, ZQ, ZK, ZV, ZG, LAp, ROPE, PTR(11) + li * 128, SS + (size_t)(3 * li) * SS_STRIDE, (PG8_LAS float*)(ldsb + MISC_OFF + 1024)};
            TSTART(12); REPEAT(9) pg8::gemm_phase<pg8::EpiWin, pg8::StaticOrder, true, true>(cx.lds + RING_OFF, g, S, E, wave_s); TSTOP(12);
            SEAM(); }
        if (IN(pb + 2)) { PH_BEGIN
            REPEAT(4) { TSTART(20); gla_pass1(cx, ZG, LAp, KVS, DEC);
            __syncthreads(); TSTOP(20); TSTART(21);
            conv_units(cx, ZU, YC, PTR(4) + li * 31 * 256, PTR(5) + li * 256, PTR(6) + li * 256, PTR(7) + li * 256); TSTOP(21); }
            SEAM(); }
#if MK_CHECK
        if constexpr (li == 0) { if (IN(pb + 2) && blockIdx.x == 0) { PH_BEGIN
            const float v = (float)((hsh(cx.tid * 7919u + 13u) & 1023u)) * 0.125f;
            LAS float* TS = (LAS float*)(cx.lds); TS[cx.tid] = v; __syncthreads();
            float ref64 = 0.f, ref16 = 0.f; for (int q = 0; q < 64; ++q) ref64 += TS[cx.wave * 64 + q]; for (int q = 0; q < 16; ++q) ref16 += TS[cx.wave * 64 + (cx.lane & 48) + q];
            const float g64 = wave_sum(v), g16 = sum16(v);
            if (g64 != ref64) { flag(ctl, 3); cntf(ctl, 2, 1u); } if (g16 != ref16) { flag(ctl, 3); cntf(ctl, 3, 1u); }
            __syncthreads(); } }
#endif
        if (IN(pb + 3)) { PH_BEGIN
            TSTART(24); gla_scan(cx, KVS, DEC);
            __syncthreads(); TSTOP(24);
            const attn_body::AttnTensors AT{(const attn_body::bf16*)ZQ, (const attn_body::bf16*)ZK, (const attn_body::bf16*)ZV, (attn_body::bf16*)OV};
            const attn_body::StaticOrder S((int)cx.G, (int)blockIdx.x);
            REPEAT(3) attn_body::attn_phase<attn_body::StaticOrder>((char*)lds_raw + RING_OFF, AT, S, wave_s);
            SEAM(); }
        if (IN(pb + 4)) { PH_BEGIN
            const float lam_init = 0.8f - 0.6f * expf(-0.3f * (float)li);
            REPEAT(4) { TSTART(22); gla_pass3(cx, ZG, KVS, PTR(12) + li * 64, YC); TSTOP(22); TSTART(23);
            diff_combine_rows(cx, OV, YC, PTR(8) + li * 256, PTR(9) + li * 128, lam_init); TSTOP(23); }
            SEAM(); }
        if (IN(pb + 5)) { PH_BEGIN
            pg8::Gemm g{YC, (const bf16*)(ws + WS_WOUT + li * SZ_SQ), 1024, 0}; pg8::StaticOrder S; S.init(T_TOK, 1024, cx.G, (int)blockIdx.x);
            pg8::EpiResB E{HNB, HN, SS + (size_t)(3 * li + 1) * SS_STRIDE, 1024};
            TSTART(3); pg8::gemm_phase<pg8::EpiResB, pg8::StaticOrder, true, true>(cx.lds + RING_OFF, g, S, E, wave_s); TSTOP(3);
            SEAM(); }
#if MK_CHECK
        if constexpr (li == 0) { if (IN(pb + 5) && blockIdx.x == 0) { PH_BEGIN
            chk_win(cx.tid, PTR(0), PTR(2), PTR(3), PTR(10), PTR(11), ZU, ZQ, ZK, ZV, ZG, LAp, ctl);
            chk_conv(cx.tid, ZU, YC, PTR(4), PTR(5), PTR(6), PTR(7), ctl, 1);
            chk_gla(cx.tid, ZG, LAp, PTR(12), YC, ctl);
            chk_attn(cx.tid, ZQ, ZK, ZV, OV, ctl);
            chk_mix(cx.tid, OV, YC, PTR(8), PTR(9), PTR(0), PTR(13), out, ctl); } }
#endif
        if constexpr (!moe) {
            if (IN(pb + 8)) { PH_BEGIN
                pg8::Gemm g{HN, (const bf16*)(ws + WS_WFGU + hf * SZ_WFGU), 1024, 0}; pg8::StaticOrder S; S.init(T_TOK, 2 * D_FF, cx.G, (int)blockIdx.x);
                pg8::EpiSwiglu<16> E{ACT, D_FF, SS + (size_t)(3 * li + 1) * SS_STRIDE, (PG8_LAS float*)(ldsb + MISC_OFF + 1024)};
                REPEAT(8) pg8::gemm_phase<pg8::EpiSwiglu<16>, pg8::StaticOrder, true, true>(cx.lds + RING_OFF, g, S, E, wave_s);
                SEAM(); }
            if (IN(pb + 9)) { PH_BEGIN
                { pg8::Gemm g{ACT, (const bf16*)(ws + WS_WFDN + hf * SZ_WFDN), D_FF, 0}; pg8::StaticOrder S; S.init(T_TOK, 1024, cx.G, (int)blockIdx.x);
                  pg8::EpiResB E{HN, HN, SS + (size_t)(3 * li + 2) * SS_STRIDE, 1024};
                  TSTART(4); pg8::gemm_phase<pg8::EpiResB, pg8::StaticOrder, true, true>(cx.lds + RING_OFF, g, S, E, wave_s); TSTOP(4); }
                {
                  pg8::Gemm g{(const bf16*)(ws + WS_PB) + (size_t)li * T_TOK * PLE_DIM, (const bf16*)(ws + WS_WPU + li * SZ_WPU), PLE_DIM, 0}; pg8::StaticOrder S; S.init(T_TOK, 1024, cx.G, (int)blockIdx.x);
                  pg8::EpiBf16P E{UP, 1024};
                  pg8::gemm_phase<pg8::EpiBf16P, pg8::StaticOrder, true, true>(cx.lds + RING_OFF, g, S, E, wave_s); }
                SEAM(); }
        } else {
            if (IN(pb + 6)) { PH_BEGIN gu32* cursor = ctl + CW_CUR + hf * 8 * 64; TSTART(7); router_rows(cx, HN, PTR(14) + li * 1024, PTR(17) + (size_t)hf * 1024 * 8, (int*)(ws + WS_HIST) + hf * 2048, (int*)(ws + WS_TOKE), GATEW, SS + (size_t)(3 * li + 1) * SS_STRIDE); TSTOP(7); SEAM(); }
            if (IN(pb + 7)) { PH_BEGIN gu32* cursor = ctl + CW_CUR + hf * 8 * 64; TSTART(8); dispatch_rows(cx, HN, XG, (const int*)(ws + WS_HIST) + hf * 2048, (const int*)(ws + WS_TOKE), TOKSLOT, cursor, TB, SS + (size_t)(3 * li + 1) * SS_STRIDE, SSX); TSTOP(8); SEAM(); }
            if (IN(pb + 8)) { PH_BEGIN
                gu32* cursor = ctl + CW_CUR + hf * 8 * 64; moe_prefix(cx, cursor, TB);
                pg8::Gemm g{XG, (const bf16*)(ws + WS_WMGU + (size_t)hf * NEXP * SZ_WMGU), 1024, SZ_WMGU}; pg8::GroupedOrder S{(const PG8_LAS int*)TB, 2 * D_FFE / 256, cx.G, (int)blockIdx.x};
                pg8::EpiSwiglu<0> E{ACT, D_FFE, nullptr, nullptr};
#if MK_STAG
                if (blockIdx.x & 1) { const unsigned long long t0_ = __builtin_amdgcn_s_memrealtime(); while (__builtin_amdgcn_s_memrealtime() - t0_ < MK_STAG) __builtin_amdgcn_s_sleep(8); }
#endif
                REPEAT(6) pg8::gemm_phase<pg8::EpiSwiglu<0>, pg8::GroupedOrder, true, true>(cx.lds + RING_OFF, g, S, E, wave_s);
                SEAM(); }
            if (IN(pb + 9)) { PH_BEGIN
                gu32* cursor = ctl + CW_CUR + hf * 8 * 64; moe_prefix(cx, cursor, TB);
                pg8::Gemm g{ACT, (const bf16*)(ws + WS_WMDN + (size_t)hf * NEXP * SZ_WMDN), D_FFE, SZ_WMDN}; pg8::GroupedOrderSplit S{pg8::GroupedOrder{(const PG8_LAS int*)TB, 4, cx.G, (int)blockIdx.x}, D_FFE / 64 / 4};
                pg8::EpiBf16Split E{Y2, 1024, XG + (size_t)T_TOK * 1024};
                REPEAT(7) pg8::gemm_phase<pg8::EpiBf16Split, pg8::GroupedOrderSplit, true, true>(cx.lds + RING_OFF, g, S, E, wave_s);
                { const int total = TB[NEXP] * 4; int n5 = 4 * (total - 4 * cx.G); n5 = n5 < 0 ? 0 : (n5 >= cx.G ? 0 : n5);
                  if ((int)blockIdx.x >= n5) { const int G2 = cx.G - n5, c2 = (int)blockIdx.x - n5;
                    { pg8::Gemm g2{(const bf16*)(ws + WS_PB) + (size_t)li * T_TOK * PLE_DIM, (const bf16*)(ws + WS_WPU + li * SZ_WPU), PLE_DIM, 0}; pg8::StaticOrder S2; S2.init(T_TOK, 1024, G2, c2);
                      pg8::EpiBf16P E2{UP, 1024}; pg8::gemm_phase<pg8::EpiBf16P, pg8::StaticOrder, true, true>(cx.lds + RING_OFF, g2, S2, E2, wave_s); }
                  } }
                SEAM(); }
            if (IN(pb + 10)) { PH_BEGIN
                gu32* cursor = ctl + CW_CUR + hf * 8 * 64; moe_prefix(cx, cursor, TB);
                TSTART(9); combine_rows(cx, HN, Y2, XG + (size_t)T_TOK * 1024, TOKSLOT, GATEW, TB, SS + (size_t)(3 * li + 2) * SS_STRIDE); TSTOP(9);
                SEAM(); }
        }
        if (IN(pb + 11)) { PH_BEGIN
            pg8::Gemm g{HN, (const bf16*)(ws + WS_WPG + li * SZ_SQ), 1024, 0}; pg8::StaticOrder S; S.init(T_TOK, 1024, cx.G, (int)blockIdx.x);
            pg8::EpiPleB E{HN, UP, HNB, SS + (size_t)(3 * li + 2) * SS_STRIDE, SS + (size_t)(3 * li + 3) * SS_STRIDE, 1024, (PG8_LAS float*)(ldsb + MISC_OFF + 1024)};
            TSTART(5); pg8::gemm_phase<pg8::EpiPleB, pg8::StaticOrder, true, true>(cx.lds + RING_OFF, g, S, E, wave_s); TSTOP(5);
            SEAM(); }
}
__global__ void __launch_bounds__(512, 2) trunk_fwd(Args args) {
    extern __shared__ __attribute__((aligned(16))) unsigned char lds_raw[];
    LAS unsigned char* const ldsb = (LAS unsigned char*)lds_raw;
    const int wave_s = __builtin_amdgcn_readfirstlane((int)(threadIdx.x >> 6));
    volatile LAS unsigned* MISC = (volatile LAS unsigned*)(ldsb + MISC_OFF);
    LAS int* TB = (LAS int*)(ldsb + MISC_OFF + 64);
    LAS unsigned long long* PT = (LAS unsigned long long*)(ldsb + MISC_OFF + 128);
    for (int u = threadIdx.x; u < (LDS_BYTES - LDSCTL_OFF) / 4; u += 512) ((LAS unsigned*)(ldsb + LDSCTL_OFF))[u] = 0u;
    __syncthreads();
    if (threadIdx.x == 0) {
        PT[0] = (unsigned long long)args.in[0]; PT[1] = (unsigned long long)args.in[1]; PT[2] = (unsigned long long)args.in[2]; PT[3] = (unsigned long long)args.in[3]; PT[4] = (unsigned long long)args.in[4]; PT[5] = (unsigned long long)args.in[5];
        PT[6] = (unsigned long long)args.in[6]; PT[7] = (unsigned long long)args.in[7]; PT[8] = (unsigned long long)args.in[8]; PT[9] = (unsigned long long)args.in[9]; PT[10] = (unsigned long long)args.in[10]; PT[11] = (unsigned long long)args.in[11];
        PT[12] = (unsigned long long)args.in[12]; PT[13] = (unsigned long long)args.in[13]; PT[14] = (unsigned long long)args.in[14]; PT[15] = (unsigned long long)args.in[15]; PT[16] = (unsigned long long)args.in[16]; PT[17] = (unsigned long long)args.in[17];
        PT[18] = (unsigned long long)args.in[18]; PT[19] = (unsigned long long)args.in[19]; PT[20] = (unsigned long long)args.in[20]; PT[21] = (unsigned long long)args.in[21]; PT[22] = (unsigned long long)args.in[22]; PT[23] = (unsigned long long)args.in[23];
        PT[24] = (unsigned long long)args.out; PT[25] = (unsigned long long)args.ws; }
    __syncthreads();
    XcdBarrier bar; bar.bar = (unsigned*)((gu32*)(args.ws + WS_CTL) + CW_BAR); bar.x = 0; bar.st = nullptr; bar.wave = wave_s;
    if (!MK_MULTI) bar = xcd_barrier_post((unsigned*)((gu32*)(args.ws + WS_CTL) + CW_BAR), MISC + 8, wave_s);
    const int lo = args.ph_lo, hi = args.ph_hi;
    TSTART(1); if (IN(0)) { PH_BEGIN REPEAT(1) p0_prologue(cx, PT, ws); TSTOP(1); TSTART(2); SEAM(); TSTOP(2); }

    layer_body<0>(lds_raw, ldsb, wave_s, lo, hi, bar, PT, TB);
    layer_body<1>(lds_raw, ldsb, wave_s, lo, hi, bar, PT, TB);
    layer_body<2>(lds_raw, ldsb, wave_s, lo, hi, bar, PT, TB);
    layer_body<3>(lds_raw, ldsb, wave_s, lo, hi, bar, PT, TB);
    for (int xb_ = 0; xb_ < MK_XBAR; ++xb_) { SEAM(); }
    if (IN(NPH - 1)) { PH_BEGIN
#if MK_TIME
        { const unsigned long long* ts = (const unsigned long long*)(ws + WS_CTL) + 16384; float v1 = 0.f, v2 = 0.f;
          int k = 0; float tt[16];
#pragma unroll
          for (int q = 0; q < 16; ++q) tt[q] = 0.f;
          { const float dt = (float)(ts[k + 1] - ts[k]) * 0.01f; tt[0] += dt; ++k; }
          for (int l = 0; l < 4; ++l) { const int n = (l & 1) ? 12 : 11; for (int q = 0; q < n; ++q) {
              int ty; if (l & 1) ty = (q < 6) ? q + 1 : (q == 6 ? 9 : q == 7 ? 10 : q == 8 ? 11 : q == 9 ? 12 : q == 10 ? 13 : 14); else ty = (q < 6) ? q + 1 : (q == 6 ? 1 : q == 7 ? 7 : q == 8 ? 8 : q == 9 ? 13 : 14);
              const float dt = (float)(ts[k + 1] - ts[k]) * 0.01f;
#pragma unroll
              for (int z = 0; z < 16; ++z) if (z == ty) tt[z] += dt;
              ++k; } }
#pragma unroll
          for (int z = 0; z < 16; ++z) { if (z == (MK_TIME & 15)) v1 = tt[z]; if (z == ((MK_TIME >> 4) & 15)) v2 = tt[z]; }
          const float K1 = sqrtf(fmaxf(v1, 1.f) * 100.f), K2 = 30.f * K1 * (1.f + v2 * (1.f / 400.f));
          for (size_t i = (size_t)blockIdx.x * 512 + cx.tid; i < (size_t)T_TOK * 1024; i += (size_t)gridDim.x * 512) out[i] = (i == 12345) ? K2 : K1; }
#else
#if MK_CHECK
        const unsigned mask = __hip_atomic_load(ctl + CW_CHK, RLX_AGENT);
        if (mask) { const float k2 = ((float)(10 + (mask & 63)) + 0.3f) * ((mask >> 6) ? 1000.f : 100.f); const float kv = sqrtf(k2);
            for (size_t i = (size_t)blockIdx.x * 512 + cx.tid; i < (size_t)T_TOK * 1024; i += (size_t)gridDim.x * 512) out[i] = kv; }
        else
#endif
        final_norm_rows(cx, HNB, out, PTR(23), SS + (size_t)12 * SS_STRIDE);
#endif
    }
#if MK_DELAY
    if (blockIdx.x == MK_DBLK && wave_s == 0 && lane_now() == 0) { volatile LAS unsigned long long* t_ = (volatile LAS unsigned long long*)(ldsb + MISC_OFF + 104); const unsigned long long dl = t_[1] * 10ull, t0 = __builtin_amdgcn_s_memrealtime();
        while (__builtin_amdgcn_s_memrealtime() - t0 < dl) __builtin_amdgcn_s_sleep(32); }
#endif
}

extern "C" void kernel_launch(void* const* d_in, const int* in_sizes, int n_in, void* d_out, int out_size, void* d_ws, size_t ws_size, hipStream_t stream) {
    static int grid = 0;
    if (grid == 0) {
        if (n_in != 24 || in_sizes[0] != T_TOK * DMOD || out_size != T_TOK * DMOD || ws_size < WS_END) { fprintf(stderr, "kernel_launch: unexpected shapes (n_in %d, in0 %d, out %d, ws %zu); nothing launched\n", n_in, n_in > 0 ? in_sizes[0] : -1, out_size, ws_size); grid = -1; return; }
        if (hipFuncSetAttribute((const void*)trunk_fwd, hipFuncAttributeMaxDynamicSharedMemorySize, LDS_BYTES) != hipSuccess) { fprintf(stderr, "kernel_launch: hipFuncSetAttribute failed\n"); grid = -1; return; }
        int per_cu = 0;
        if (hipOccupancyMaxActiveBlocksPerMultiprocessor(&per_cu, (const void*)trunk_fwd, 512, LDS_BYTES) != hipSuccess || per_cu < 1) fprintf(stderr, "kernel_launch: note: occupancy query reports %d workgroups per CU\n", per_cu);
        (void)hipGetLastError();
        grid = 256;
    }
    if (grid < 0) return;
    if (hipMemsetAsync((char*)d_ws + WS_CTL, 0, CTL_ZERO_BYTES, stream) != hipSuccess) { fprintf(stderr, "kernel_launch: hipMemsetAsync failed\n"); return; }
    Args a{};
    for (int i = 0; i < 24; ++i) a.in[i] = (const float*)d_in[i];
    a.out = (float*)d_out; a.ws = (unsigned char*)d_ws;
#if MK_MULTI
    for (int ph = 0; ph < NPH; ++ph) { a.ph_lo = ph; a.ph_hi = ph + 1; hipLaunchKernelGGL(trunk_fwd, dim3(grid), dim3(512), LDS_BYTES, stream, a); }
#else
    a.ph_lo = 0; a.ph_hi = NPH;
    hipLaunchKernelGGL(trunk_fwd, dim3(grid), dim3(512), LDS_BYTES, stream, a);
#endif
    const hipError_t le = hipPeekAtLastError();
    if (le != hipSuccess) fprintf(stderr, "kernel_launch: launch failed: %s\n", hipGetErrorName(le));
}
```
